# Optimizing an MI355X kernel written in HIP

```python
import jax, jax.numpy as jnp
from jax import lax
import numpy as np

D_MODEL = 2048
BATCH = 16
SEQ = 256
DEPTH = 2
DEC_BATCH = 8
DEC_SEQ = 4096
PAST_LEN = 512

GRID_W = 64
D_CONV = D_MODEL // 2
CONV_W = 3
GLA_HEADS = 4
D_K = D_MODEL // 2
D_V = D_MODEL
DK_HEAD = D_K // GLA_HEADS
DV_HEAD = D_V // GLA_HEADS
GK_RANK = 16
GATE_NORM = 16.0
LOG_DECAY_MIN = -1.0
GLA_CHUNK = 64
N_KEYS = 128
N_EXPERTS = N_KEYS * N_KEYS
PEER_HEADS = 8
PEER_DK = 256
PEER_TOPK = 16
PEER_BLOCK = 128
N_ADA = 6
D_IN = 3 * D_CONV + 2 * D_K + 2 * D_V + 2 * GK_RANK + 2 * D_MODEL
ALPHA = (2.0 * DEPTH) ** 0.25
BETA = (8.0 * DEPTH) ** -0.25
LN_EPS = 1e-5

kernel_name = 'hybrid_conv_gla_peer_diffusion_step'


def layer_norm(x, gain=None, bias=None):
    xf = x.astype(jnp.float32)
    mu = jnp.mean(xf, axis=-1, keepdims=True)
    var = jnp.mean(jnp.square(xf - mu), axis=-1, keepdims=True)
    y = (xf - mu) * lax.rsqrt(var + LN_EPS)
    if gain is not None:
        y = y * gain.astype(jnp.float32) + bias.astype(jnp.float32)
    return y.astype(x.dtype)


def conv3(u, w, axis):
    n = u.shape[axis]
    pad = [(1, 1) if a == axis else (0, 0) for a in range(u.ndim)]
    up = jnp.pad(u, pad)
    return (lax.slice_in_dim(up, 0, n, axis=axis) * w[0]
            + lax.slice_in_dim(up, 1, n + 1, axis=axis) * w[1]
            + lax.slice_in_dim(up, 2, n + 2, axis=axis) * w[2])


def conv_latent(u, w):
    B, T, C = u.shape
    rows = T // GRID_W
    g = u.reshape(B, rows, GRID_W, C)
    half = C // 2
    gh = conv3(g[..., :half], w[:, :half], axis=2)
    gv = conv3(g[..., half:], w[:, half:], axis=1)
    return jnp.concatenate([gh, gv], axis=-1).reshape(B, T, C)


def to_heads(t):
    B, T, W = t.shape
    return t.reshape(B, T, GLA_HEADS, W // GLA_HEADS).transpose(0, 2, 1, 3)


def gla_chunked(q, k, v, g, s0):
    out_dtype = v.dtype
    B, H, T, dk = q.shape
    dv = v.shape[-1]
    n = T // GLA_CHUNK
    f32 = jnp.float32
    q = q.astype(f32).reshape(B, H, n, GLA_CHUNK, dk)
    k = k.astype(f32).reshape(B, H, n, GLA_CHUNK, dk)
    v = v.astype(f32).reshape(B, H, n, GLA_CHUNK, dv)
    b = jnp.cumsum(g.astype(f32).reshape(B, H, n, GLA_CHUNK, dk), axis=3)
    b_last = b[:, :, :, -1:, :]
    qe = q * jnp.exp(b)
    ke = k * jnp.exp(-b)
    kd = k * jnp.exp(b_last - b)
    tril = jnp.tril(jnp.ones((GLA_CHUNK, GLA_CHUNK), dtype=bool))
    att = jnp.where(tril, jnp.einsum('bhncd,bhnsd->bhncs', qe, ke), 0.0)
    o_intra = jnp.einsum('bhncs,bhnse->bhnce', att, v)
    decay = jnp.exp(b_last[:, :, :, 0, :])

    def step(S, xs):
        qe_c, kd_c, v_c, dl = xs
        o_c = jnp.einsum('bhcd,bhde->bhce', qe_c, S)
        S = S * dl[..., :, None] + jnp.einsum('bhcd,bhce->bhde', kd_c, v_c)
        return S, o_c

    xs = (jnp.moveaxis(qe, 2, 0), jnp.moveaxis(kd, 2, 0), jnp.moveaxis(v, 2, 0), jnp.moveaxis(decay, 2, 0))
    S, o_inter = lax.scan(step, s0.astype(f32), xs)
    o = (o_intra + jnp.moveaxis(o_inter, 0, 2)).reshape(B, H, T, dv)
    return o.astype(out_dtype), S


def parallel_mixer(h, latent, s_f0, s_b0, w_in, w_conv, w_a, w_gk_up, b_gk, w_gla_norm, w_b, w_o):
    B, T, _ = h.shape
    z = h @ w_in
    sizes = (D_CONV, D_CONV, D_CONV, D_K, D_K, D_V, D_V, GK_RANK, GK_RANK, D_MODEL, D_MODEL)
    cb, cc, cx, q, k, v, r, lf, lb, ga, gb = jnp.split(z, np.cumsum(sizes)[:-1].tolist(), axis=-1)
    u = cc * cx
    u = conv_latent(u, w_conv) if latent else conv3(u, w_conv, axis=1)
    y_a = (cb * u) @ w_a
    g_f = jnp.maximum(jax.nn.log_sigmoid((lf @ w_gk_up[0] + b_gk[0]).astype(jnp.float32)) / GATE_NORM, LOG_DECAY_MIN)
    g_b = jnp.maximum(jax.nn.log_sigmoid((lb @ w_gk_up[1] + b_gk[1]).astype(jnp.float32)) / GATE_NORM, LOG_DECAY_MIN)
    qh = to_heads(q * (DK_HEAD ** -0.5))
    kh = to_heads(k)
    vh = to_heads(v)
    o_f, s_f = gla_chunked(qh, kh, vh, to_heads(g_f), s_f0)
    flip = lambda t: jnp.flip(t, axis=2)
    o_b, s_b = gla_chunked(flip(qh), flip(kh), flip(vh), flip(to_heads(g_b)), s_b0)
    o = (o_f + flip(o_b)).astype(jnp.float32)
    o = o * lax.rsqrt(jnp.mean(jnp.square(o), axis=-1, keepdims=True) + LN_EPS)
    o = o * w_gla_norm.reshape(GLA_HEADS, 1, DV_HEAD).astype(jnp.float32)
    o = o.astype(h.dtype).transpose(0, 2, 1, 3).reshape(B, T, D_V) * jax.nn.silu(r)
    y_b = o @ w_b
    y = jax.nn.sigmoid(ga) * y_a + jax.nn.sigmoid(gb) * y_b
    return y @ w_o, s_f, s_b


def peer_ffn(h, w_pq, sub_keys, w_u, w_v):
    B, T, D = h.shape
    xb = h.reshape(-1, PEER_BLOCK, D)

    def block(x):
        qq = (x @ w_pq).reshape(PEER_BLOCK, PEER_HEADS, 2, PEER_DK // 2)
        s1 = jnp.einsum('phd,nd->phn', qq[:, :, 0], sub_keys[0])
        s2 = jnp.einsum('phd,nd->phn', qq[:, :, 1], sub_keys[1])
        v1, i1 = lax.top_k(s1, PEER_TOPK)
        v2, i2 = lax.top_k(s2, PEER_TOPK)
        cand = (v1[..., :, None] + v2[..., None, :]).reshape(PEER_BLOCK, PEER_HEADS, PEER_TOPK * PEER_TOPK)
        sv, si = lax.top_k(cand, PEER_TOPK)
        e1 = jnp.take_along_axis(i1, si // PEER_TOPK, axis=-1)
        e2 = jnp.take_along_axis(i2, si % PEER_TOPK, axis=-1)
        idx = e1 * N_KEYS + e2
        gate = jax.nn.softmax(sv.astype(jnp.float32), axis=-1).astype(x.dtype)
        act = jax.nn.gelu(jnp.einsum('pd,phkd->phk', x, w_u[idx]))
        return jnp.einsum('phk,phkd->pd', gate * act, w_v[idx])

    return lax.map(block, xb).reshape(B, T, D)


def trunk_layer(x, cond, latent, s_f0, s_b0, w_in, w_conv, w_a, w_gk_up, b_gk, w_gla_norm, w_b, w_o,
                w_ada, b_ada, ln_g, ln_b, w_pq, peer_keys, peer_u, peer_v):
    mod = jax.nn.silu(cond) @ w_ada + b_ada
    sh1, sc1, g1, sh2, sc2, g2 = jnp.split(mod[:, None, :], N_ADA, axis=-1)
    h = layer_norm(x) * (1.0 + sc1) + sh1
    m, s_f, s_b = parallel_mixer(h, latent, s_f0, s_b0, w_in, w_conv, w_a, w_gk_up, b_gk, w_gla_norm, w_b, w_o)
    x = layer_norm(ALPHA * x + g1 * m, ln_g[0], ln_b[0])
    h = layer_norm(x) * (1.0 + sc2) + sh2
    f = peer_ffn(h, w_pq, peer_keys, peer_u, peer_v)
    x = layer_norm(ALPHA * x + g2 * f, ln_g[1], ln_b[1])
    return x, s_f, s_b


def setup_inputs(seed: int = 0) -> dict:
    key = jax.random.key(seed)
    ks = jax.random.split(key, 24)
    f32 = jnp.float32

    def nrm(k, shape, s):
        return jax.random.normal(k, shape, f32) * s

    return {
        'x_prompt': nrm(ks[0], (BATCH, SEQ, D_MODEL), 1.0),
        'x_sample': nrm(ks[1], (DEC_BATCH, DEC_SEQ, D_MODEL), 1.0),
        'state_gla': nrm(ks[2], (DEC_BATCH, DEPTH, 2, GLA_HEADS, DK_HEAD, DV_HEAD), 0.5),
        'c': nrm(ks[3], (DEC_BATCH, D_MODEL), 1.0),
        'c_ctx': nrm(ks[4], (D_MODEL,), 1.0),
        'w_in': nrm(ks[5], (DEPTH, D_MODEL, D_IN), D_MODEL ** -0.5),
        'w_conv': nrm(ks[6], (DEPTH, CONV_W, D_CONV), CONV_W ** -0.5),
        'w_a': nrm(ks[7], (DEPTH, D_CONV, D_MODEL), D_CONV ** -0.5),
        'w_gk_up': nrm(ks[8], (DEPTH, 2, GK_RANK, D_K), GK_RANK ** -0.5),
        'b_gk': nrm(ks[9], (DEPTH, 2, D_K), 0.1),
        'w_gla_norm': 1.0 + nrm(ks[10], (DEPTH, D_V), 0.02),
        'w_b': nrm(ks[11], (DEPTH, D_V, D_MODEL), D_V ** -0.5),
        'w_o': nrm(ks[12], (DEPTH, D_MODEL, D_MODEL), BETA * D_MODEL ** -0.5),
        'w_ada': nrm(ks[13], (DEPTH, D_MODEL, N_ADA * D_MODEL), 0.5 * D_MODEL ** -0.5),
        'b_ada': nrm(ks[14], (DEPTH, N_ADA * D_MODEL), 0.02),
        'ln_g': 1.0 + nrm(ks[15], (DEPTH, 2, D_MODEL), 0.02),
        'ln_b': nrm(ks[16], (DEPTH, 2, D_MODEL), 0.02),
        'w_pq': nrm(ks[17], (DEPTH, D_MODEL, PEER_HEADS * PEER_DK), D_MODEL ** -0.5),
        'peer_keys': nrm(ks[18], (DEPTH, 2, N_KEYS, PEER_DK // 2), (PEER_DK // 2) ** -0.5),
        'peer_u': nrm(ks[19], (DEPTH, N_EXPERTS, D_MODEL), D_MODEL ** -0.5),
        'peer_v': nrm(ks[20], (DEPTH, N_EXPERTS, D_MODEL), BETA * 0.3),
    }


def reference(x_prompt, x_sample, state_gla, c, c_ctx, w_in, w_conv, w_a, w_gk_up, b_gk, w_gla_norm, w_b, w_o,
              w_ada, b_ada, ln_g, ln_b, w_pq, peer_keys, peer_u, peer_v):
    xp = x_prompt
    xs = x_sample
    zero_state = jnp.zeros((x_prompt.shape[0], GLA_HEADS, DK_HEAD, DV_HEAD), jnp.float32)
    cond_ctx = c_ctx[None, :]
    ctx_states = []
    for l in range(DEPTH):
        lw = (w_in[l], w_conv[l], w_a[l], w_gk_up[l], b_gk[l], w_gla_norm[l], w_b[l], w_o[l],
              w_ada[l], b_ada[l], ln_g[l], ln_b[l], w_pq[l], peer_keys[l], peer_u[l], peer_v[l])
        xp, s_f, s_b = trunk_layer(xp, cond_ctx, False, zero_state, zero_state, *lw)
        ctx_states.append(jnp.stack([s_f, s_b], axis=1))
        xs, _, _ = trunk_layer(xs, c, True, state_gla[:, l, 0], state_gla[:, l, 1], *lw)
    new_state_gla = jnp.stack(ctx_states, axis=1).astype(x_prompt.dtype)
    return (xp, xs, new_state_gla)
```

```cpp
#include <hip/hip_runtime.h>
#include <cstdio>
#include <cstdint>

#ifndef STORE_POLICY
#define STORE_POLICY 1
#endif
#ifndef MK_ONE_LAUNCH
#define MK_ONE_LAUNCH 1
#endif

#define LAS __attribute__((address_space(3)))
typedef unsigned short bf16_t;
typedef short bf16x8 __attribute__((ext_vector_type(8)));
typedef float f32x4 __attribute__((ext_vector_type(4)));
typedef unsigned u32x4 __attribute__((ext_vector_type(4)));
typedef int i32x4 __attribute__((ext_vector_type(4)));
typedef unsigned u32x2 __attribute__((ext_vector_type(2)));
typedef __bf16 bf16x2_t __attribute__((ext_vector_type(2)));

constexpr int D = 2048, TCTX = 4096, TLAT = 32768, T = TCTX + TLAT;
constexpr int NINP = 13568;
constexpr int NADA = 12288;
constexpr float ALPHA = 1.41421356237f;
constexpr float LN_EPS = 1e-5f;
constexpr int LDS_TOTAL = 155648;
constexpr int MISC_OFF = LDS_TOTAL - 64;

constexpr size_t al256(size_t x) { return (x + 255) & ~(size_t)255; }
constexpr size_t WS_BAR = 0;
constexpr size_t WS_MOD = 16384;
constexpr size_t WS_WIN = WS_MOD + 1048576;
constexpr size_t WS_WA = WS_WIN + (size_t)2 * NINP * 2048 * 2;
constexpr size_t WS_WB = WS_WA + (size_t)2 * 2048 * 1024 * 2;
constexpr size_t WS_WO = WS_WB + (size_t)2 * 2048 * 2048 * 2;
constexpr size_t WS_WPQ = WS_WO + (size_t)2 * 2048 * 2048 * 2;
constexpr size_t WS_H = WS_WPQ + (size_t)2 * 2048 * 2048 * 2;
constexpr size_t WS_Z1 = WS_H + (size_t)T * 2048 * 2;
constexpr size_t WS_Z2 = WS_Z1 + (size_t)T * 3072 * 2;
constexpr size_t WS_Z3 = WS_Z2 + (size_t)T * 4096 * 2;
constexpr size_t WS_Z4 = WS_Z3 + (size_t)T * 2048 * 2;
constexpr size_t WS_U16 = WS_Z4;
constexpr size_t WS_V8 = WS_U16 + (size_t)16384 * 2048 * 2;
constexpr size_t WS_VS = WS_V8 + (size_t)16384 * 2048;
constexpr size_t WS_Z5 = WS_Z4 + (size_t)T * 4096 * 2;
constexpr size_t WS_END0 = WS_Z5 + (size_t)T * 32 * 4;
constexpr size_t WS_H8IN = al256(WS_END0);
constexpr size_t WS_W8IN = WS_H8IN + (size_t)T * 2048;
constexpr size_t WS_CSIN = WS_W8IN + (size_t)2 * NINP * 2048;
constexpr size_t WS_HSIN = WS_CSIN + (size_t)2 * NINP * 4;
constexpr size_t WS_END = WS_HSIN + (size_t)T * 4;

__device__ __forceinline__ unsigned cvt_pk_bf16(float lo, float hi) { unsigned r; asm("v_cvt_pk_bf16_f32 %0, %1, %2" : "=v"(r) : "v"(lo), "v"(hi)); return r; }
__device__ __forceinline__ bf16_t f2bf(float x) { return (bf16_t)(cvt_pk_bf16(x, 0.f) & 0xffffu); }
__device__ __forceinline__ float bf_lo(unsigned w) { return __uint_as_float(w << 16); }
__device__ __forceinline__ float bf_hi(unsigned w) { return __uint_as_float(w & 0xffff0000u); }
__device__ __forceinline__ float bf1(bf16_t u) { return __uint_as_float((unsigned)u << 16); }
__device__ __forceinline__ float wmax(float v) {
#pragma unroll
    for (int sh = 32; sh >= 1; sh >>= 1) v = fmaxf(v, __shfl_xor(v, sh));
    return v; }
__device__ __forceinline__ unsigned pack_i8(float a, float b, float c, float d) { const int q0 = __float2int_rn(a), q1 = __float2int_rn(b), q2 = __float2int_rn(c), q3 = __float2int_rn(d);
    return ((unsigned)q0 & 255u) | (((unsigned)q1 & 255u) << 8) | (((unsigned)q2 & 255u) << 16) | ((unsigned)q3 << 24); }
__device__ __forceinline__ float wsum(float v) {
#pragma unroll
    for (int m = 32; m >= 1; m >>= 1) v += __shfl_xor(v, m);
    return v;
}
__device__ __forceinline__ float sigmoidf_(float x) { return __builtin_amdgcn_rcpf(1.f + __expf(-x)); }
__device__ __forceinline__ float siluf_(float x) { return x * sigmoidf_(x); }
__device__ __forceinline__ float gelu_tanh(float x) {
    const float y = 0.7978845608028654f * (x + 0.044715f * x * x * x);
    const float e = __expf(2.f * y);
    const float th = 1.f - 2.f * __builtin_amdgcn_rcpf(e + 1.f);
    return 0.5f * x * (1.f + th);
}
__device__ __forceinline__ float dot2bf(unsigned a, unsigned b, float acc) { return __builtin_amdgcn_fdot2_f32_bf16(__builtin_bit_cast(bf16x2_t, a), __builtin_bit_cast(bf16x2_t, b), acc, false); }

#define XB_TMO      128
#define XB_XCNT(j)  (256  + 64 * (j))
#define XB_XSUB(j)  (1280 + 64 * (j))
#define XB_XGEN(j)  (2304 + 64 * (j))
#define XB_TOP      3328
#define XB_TOPGEN   3392
#define XCD_BAR_WORDS 3456
#define XB_SPIN_CAP (1u << 18)
__device__ __forceinline__ unsigned xb_ld(unsigned* p)              { return __hip_atomic_load(p, __ATOMIC_RELAXED, __HIP_MEMORY_SCOPE_AGENT); }
__device__ __forceinline__ unsigned xb_add(unsigned* p, unsigned v) { return __hip_atomic_fetch_add(p, v, __ATOMIC_RELAXED, __HIP_MEMORY_SCOPE_AGENT); }
__device__ __forceinline__ unsigned xb_xcc_id() { return (unsigned)__builtin_amdgcn_s_getreg((3 << 11) | 20) & 0xFu; }
#define XB_SPIN(cond, bar) do { unsigned _sp = 0; while (cond) { __builtin_amdgcn_s_sleep(1); \
    if ((++_sp & 255u) == 0u) { if (xb_ld(&(bar)[XB_TMO])) break; if (_sp > XB_SPIN_CAP) { atomicAdd(&(bar)[XB_TMO], 1u); break; } } } } while (0)
struct XcdBarrier { unsigned* bar; unsigned x; volatile LAS unsigned* st; };
__device__ __forceinline__ XcdBarrier xcd_barrier_post(unsigned* bar, volatile LAS unsigned* st) {
    XcdBarrier b; b.bar = bar; b.x = xb_xcc_id(); b.st = st;
    if (threadIdx.x == 0) (void)xb_add(&bar[XB_XCNT(b.x)], 1u);
    return b;
}
__device__ __forceinline__ void xcd_barrier_complete(unsigned* bar, unsigned x, unsigned& nloc, unsigned& nx) {
    const unsigned G = gridDim.x * gridDim.y * gridDim.z;
    unsigned sum, cnt, mine, sp = 0u;
    for (;;) {
        sum = 0u; cnt = 0u; mine = 0u;
#pragma unroll
        for (unsigned j = 0; j < 16; ++j) { const unsigned c = xb_ld(&bar[XB_XCNT(j)]); sum += c; cnt += (c > 0u) ? 1u : 0u; mine = (j == x) ? c : mine; }
        if (sum == G) break;
        __builtin_amdgcn_s_sleep(1);
        if ((++sp & 255u) == 0u) { if (xb_ld(&bar[XB_TMO])) break; if (sp > XB_SPIN_CAP) { atomicAdd(&bar[XB_TMO], 1u); break; } }
    }
    nloc = mine > 0u ? mine : 1u; nx = cnt > 0u ? cnt : 1u;
}
__device__ __forceinline__ void xcd_barrier(const XcdBarrier& b) {
    asm volatile("s_waitcnt vmcnt(0)" ::: "memory");
    __syncthreads();
    if (threadIdx.x == 0) {
        unsigned* bar = b.bar;
        __builtin_amdgcn_s_waitcnt(0);
        unsigned nloc = b.st[0], nx = b.st[1];
        if (nloc == 0u) { xcd_barrier_complete(bar, b.x, nloc, nx); b.st[0] = nloc; b.st[1] = nx; }
        const unsigned old = xb_add(&bar[XB_XSUB(b.x)], 1u);
        const unsigned gen = old / nloc;
        if (old + 1u == (gen + 1u) * nloc) {
            __builtin_amdgcn_fence(__ATOMIC_RELEASE, "agent");
            asm volatile("s_waitcnt vmcnt(0)" ::: "memory");
            const unsigned og = xb_add(&bar[XB_TOP], 1u);
            const unsigned tg = og / nx;
            if (og + 1u == (tg + 1u) * nx) xb_add(&bar[XB_TOPGEN], 1u);
            else XB_SPIN(xb_ld(&bar[XB_TOPGEN]) == tg, bar);
            __builtin_amdgcn_fence(__ATOMIC_ACQUIRE, "agent");
            xb_add(&bar[XB_XGEN(b.x)], 1u);
            asm volatile("s_waitcnt vmcnt(0)" ::: "memory");
        } else {
            XB_SPIN(xb_ld(&bar[XB_XGEN(b.x)]) == gen, bar);
            __builtin_amdgcn_fence(__ATOMIC_ACQUIRE, "agent");
            asm volatile("s_waitcnt vmcnt(0)" ::: "memory");
        }
    }
    __syncthreads();
}

namespace pg8 {
#define PG8_LAS __attribute__((address_space(3)))
constexpr int BM = 256, BK = 64, HALF = 128, HTB = HALF * BK * 2, STAGE_BYTES = 8 * HTB, NXCD = 8, WGM = 8;
__host__ __device__ __forceinline__ int lds_byte(int r, int c) { const int st = (r >> 4) * 2 + (c >> 5), rr = r & 15, cc = c & 31, ob = rr * 64 + cc * 2; return st * 1024 + (ob ^ (((ob >> 9) & 1) << 5)); }
__host__ __device__ __forceinline__ void stage_rc(int b, int& R, int& C) { const int st = b / 1024, sb = b % 1024, swz = sb ^ (((sb >> 9) & 1) << 5); R = (st >> 1) * 16 + swz / 64; C = (st & 1) * 32 + (swz % 64) / 2; }
__host__ __device__ __forceinline__ int perm32(int rho) { const int n = rho >> 4, i = rho & 15; return 8 * (i >> 2) + 4 * n + (i & 3); }
struct Unit { int pm, pn; };
struct Gemm { const bf16_t* A; const bf16_t* Bt; int M, N, K; };
struct StaticOrder {
    int nM, nN, nwg, G, c;
    __host__ __device__ void init(int M, int N, int G_, int c_) { nM = M / BM; nN = N / BM; nwg = nM * nN; G = G_; c = c_; }
    __host__ __device__ bool next(int i, Unit& u) const {
        const long L = (long)i * G + c; if (L >= nwg) return false;
        int wgid = (int)L; { const int q = nwg / NXCD, r = nwg % NXCD, xcd = wgid % NXCD, off = wgid / NXCD; wgid = (xcd < r ? xcd * (q + 1) : r * (q + 1) + (xcd - r) * q) + off; }
        const int nig = WGM * nN, gid = wgid / nig, fm = gid * WGM, gsz = (nM - fm) < WGM ? (nM - fm) : WGM;
        u.pm = fm + ((wgid % nig) % gsz); u.pn = (wgid % nig) / gsz; return true;
    }
    __device__ __forceinline__ void a_ready(const Unit&) const {}
    __device__ __forceinline__ void done(const Unit&) const {}
};

template <bool I8> struct AccT { typedef f32x4 type; };
template <> struct AccT<true> { typedef i32x4 type; };
template <class Epi, class Sched, bool ALIGN_EPI = false, bool SP2 = false, bool I8 = false>
__device__ __forceinline__ void gemm_phase(PG8_LAS unsigned char* lds, const Gemm g, const Sched& S, const Epi& E) {
    int tid_ = threadIdx.x; asm volatile("" : "+v"(tid_));
    const int tid = tid_, wid = __builtin_amdgcn_readfirstlane(tid >> 6), lane = tid & 63, wr = wid >> 2, wc = wid & 3, fr = lane & 15, fq = lane >> 4;
    const int K = g.K, nt = I8 ? K / (2 * BK) : K / BK; const unsigned KB = I8 ? (unsigned)K : 2u * (unsigned)K;
    typedef typename AccT<I8>::type acc_t;
    unsigned voffA[2], voffB[2];
#pragma unroll
    for (int i = 0; i < 2; ++i) { int R, C; stage_rc(tid * 16 + i * 8192, R, C); const int Rb = 64 * (R >> 5) + (Epi::PERM ? perm32(R & 31) : (R & 31));
        voffA[i] = (unsigned)R * KB + (unsigned)C * 2u; voffB[i] = (unsigned)Rb * KB + (unsigned)C * 2u; }
    const size_t kstep = (size_t)(BK * 2);
    const size_t hstep = (size_t)HALF * KB;
    const size_t hstepB = (size_t)32 * KB;
    const size_t tstep = 2 * hstep;
    const unsigned ldsw = (unsigned)wid * 1024u;
    const int aoff = lds_byte(wr * 64 + fr, fq * 8), boff = lds_byte(wc * 32 + fr, fq * 8);
#define PG8_SA(b, h) (((b) * 2 + (h)) * HTB)
#define PG8_SB(b, h) ((4 + (b) * 2 + (h)) * HTB)
#define PG8_STAGE(bufoff, gbase, voff) do { _Pragma("unroll") for (int _i = 0; _i < 2; ++_i) \
        __builtin_amdgcn_global_load_lds((const unsigned*)((const char*)(gbase) + (voff)[_i]), (PG8_LAS unsigned*)(lds + (bufoff) + ldsw + _i * 8192), 16, 0, 0); } while (0)
#define PG8_LDA(dst, b, h) do { _Pragma("unroll") for (int m = 0; m < 4; ++m) _Pragma("unroll") for (int k = 0; k < 2; ++k) dst[m][k] = *(const PG8_LAS bf16x8*)(lds + PG8_SA(b, h) + aoff + m * 2048 + k * 1024); } while (0)
#define PG8_LDB(dst, b, h) do { _Pragma("unroll") for (int n = 0; n < 2; ++n) _Pragma("unroll") for (int k = 0; k < 2; ++k) dst[n][k] = *(const PG8_LAS bf16x8*)(lds + PG8_SB(b, h) + boff + n * 2048 + k * 1024); } while (0)
#define PG8_MMA(ai, bj, At, Bt) do { __builtin_amdgcn_s_setprio(1); _Pragma("unroll") for (int m = 0; m < 4; ++m) _Pragma("unroll") for (int n = 0; n < 2; ++n) _Pragma("unroll") for (int k = 0; k < 2; ++k) \
        { if constexpr (I8) acc[ai][bj][m][n] = __builtin_amdgcn_mfma_i32_16x16x64_i8(__builtin_bit_cast(i32x4, Bt[n][k]), __builtin_bit_cast(i32x4, At[m][k]), acc[ai][bj][m][n], 0, 0, 0); \
          else acc[ai][bj][m][n] = __builtin_amdgcn_mfma_f32_16x16x32_bf16(Bt[n][k], At[m][k], acc[ai][bj][m][n], 0, 0, 0); } __builtin_amdgcn_s_setprio(0); } while (0)
#define PG8_WAIT_V(n) asm volatile("s_waitcnt vmcnt(" #n ")" ::: "memory")
#define PG8_WAIT_L(n) asm volatile("s_waitcnt lgkmcnt(" #n ")" ::: "memory")
#define PG8_BAR __builtin_amdgcn_s_barrier()
#define PG8_SCHED __builtin_amdgcn_sched_barrier(0)
    Unit cur, nxt; int ui = 0;
    if (!S.next(0, cur)) return;
    acc_t acc[2][2][4][2];
#pragma unroll
    for (int a = 0; a < 2; ++a)
#pragma unroll
        for (int b = 0; b < 2; ++b)
#pragma unroll
            for (int m = 0; m < 4; ++m)
#pragma unroll
                for (int n = 0; n < 2; ++n) acc[a][b][m][n] = (acc_t){0, 0, 0, 0};
    bf16x8 At[4][2], B0[2][2], B1[2][2];
    const char* cA = (const char*)g.A + (size_t)cur.pm * tstep; const char* cB = (const char*)g.Bt + (size_t)cur.pn * tstep;
    S.a_ready(cur);
    if constexpr (SP2) {
        PG8_STAGE(PG8_SB(0, 0), cB, voffB); PG8_STAGE(PG8_SB(0, 1), cB + hstepB, voffB); PG8_STAGE(PG8_SA(0, 0), cA, voffA); PG8_STAGE(PG8_SA(0, 1), cA + hstep, voffA);
        if (wr == 1) PG8_BAR;
        PG8_WAIT_V(2); PG8_BAR;
        PG8_STAGE(PG8_SB(1, 0), cB + kstep, voffB); PG8_STAGE(PG8_SA(1, 0), cA + kstep, voffA); PG8_STAGE(PG8_SB(1, 1), cB + hstepB + kstep, voffB);
        PG8_WAIT_V(6); PG8_BAR;
    } else {
        PG8_STAGE(PG8_SB(0, 0), cB, voffB); PG8_STAGE(PG8_SA(0, 0), cA, voffA); PG8_STAGE(PG8_SB(0, 1), cB + hstepB, voffB); PG8_STAGE(PG8_SA(0, 1), cA + hstep, voffA);
        if (wr == 1) PG8_BAR;
        PG8_WAIT_V(4); PG8_BAR;
        PG8_STAGE(PG8_SB(1, 0), cB + kstep, voffB); PG8_STAGE(PG8_SA(1, 0), cA + kstep, voffA); PG8_STAGE(PG8_SB(1, 1), cB + hstepB + kstep, voffB);
        PG8_WAIT_V(6); PG8_BAR;
    }
    for (;;) {
        const bool has_next = S.next(ui + 1, nxt);
        const char* nA = has_next ? (const char*)g.A + (size_t)nxt.pm * tstep : cA; const char* nB = has_next ? (const char*)g.Bt + (size_t)nxt.pn * tstep : cB;
        for (int t = 0; t < nt; t += 2) {
            const bool last = (t == nt - 2);
            const char* a1 = cA + (size_t)(t + 1) * kstep;
            const char* a2 = last ? nA : cA + (size_t)(t + 2) * kstep; const char* b2 = last ? nB : cB + (size_t)(t + 2) * kstep;
            const char* a3 = a2 + kstep; const char* b3 = b2 + kstep;
            if (last && has_next) S.a_ready(nxt);
            if constexpr (SP2) {
            PG8_LDB(B0, 0, 0); PG8_LDB(B1, 0, 1); PG8_SCHED; PG8_LDA(At, 0, 0); PG8_STAGE(PG8_SA(1, 1), a1 + hstep, voffA);
            PG8_WAIT_V(8); PG8_WAIT_L(0); PG8_BAR; PG8_MMA(0, 0, At, B0); PG8_MMA(0, 1, At, B1); PG8_BAR; PG8_SCHED;
            PG8_LDA(At, 0, 1); PG8_STAGE(PG8_SB(0, 0), b2, voffB); PG8_STAGE(PG8_SB(0, 1), b2 + hstepB, voffB); PG8_STAGE(PG8_SA(0, 0), a2, voffA);
            PG8_WAIT_V(8); PG8_WAIT_L(0); PG8_BAR; PG8_MMA(1, 0, At, B0); PG8_MMA(1, 1, At, B1); PG8_BAR; PG8_SCHED;
            PG8_LDB(B0, 1, 0); PG8_LDB(B1, 1, 1); PG8_SCHED; PG8_LDA(At, 1, 0); PG8_STAGE(PG8_SA(0, 1), a2 + hstep, voffA);
            PG8_WAIT_V(8); PG8_WAIT_L(0); PG8_BAR; PG8_MMA(0, 0, At, B0); PG8_MMA(0, 1, At, B1); PG8_BAR; PG8_SCHED;
            PG8_LDA(At, 1, 1); PG8_STAGE(PG8_SB(1, 0), b3, voffB); PG8_STAGE(PG8_SB(1, 1), b3 + hstepB, voffB); PG8_STAGE(PG8_SA(1, 0), a3, voffA);
            PG8_WAIT_V(8); PG8_WAIT_L(0); PG8_BAR; PG8_MMA(1, 0, At, B0); PG8_MMA(1, 1, At, B1); PG8_BAR; PG8_SCHED;
            } else {
            PG8_LDB(B0, 0, 0); PG8_SCHED; PG8_LDA(At, 0, 0); PG8_STAGE(PG8_SA(1, 1), a1 + hstep, voffA);
            PG8_WAIT_L(8); PG8_BAR; PG8_WAIT_L(0); PG8_MMA(0, 0, At, B0); PG8_BAR; PG8_SCHED;
            PG8_LDB(B1, 0, 1); PG8_STAGE(PG8_SB(0, 0), b2, voffB);
            PG8_BAR; PG8_WAIT_L(0); PG8_MMA(0, 1, At, B1); PG8_BAR;
            PG8_LDA(At, 0, 1); PG8_STAGE(PG8_SA(0, 0), a2, voffA);
            PG8_BAR; PG8_WAIT_L(0); PG8_MMA(1, 0, At, B0); PG8_BAR; PG8_SCHED;
            PG8_STAGE(PG8_SB(0, 1), b2 + hstepB, voffB);
            PG8_WAIT_V(6); PG8_BAR; PG8_MMA(1, 1, At, B1); PG8_BAR;
            PG8_LDB(B0, 1, 0); PG8_SCHED; PG8_LDA(At, 1, 0); PG8_STAGE(PG8_SA(0, 1), a2 + hstep, voffA);
            PG8_WAIT_L(8); PG8_BAR; PG8_WAIT_L(0); PG8_MMA(0, 0, At, B0); PG8_BAR; PG8_SCHED;
            PG8_LDB(B1, 1, 1); PG8_STAGE(PG8_SB(1, 0), b3, voffB);
            PG8_BAR; PG8_WAIT_L(0); PG8_MMA(0, 1, At, B1); PG8_BAR;
            PG8_LDA(At, 1, 1); PG8_STAGE(PG8_SA(1, 0), a3, voffA);
            PG8_BAR; PG8_WAIT_L(0); PG8_MMA(1, 0, At, B0); PG8_BAR; PG8_SCHED;
            PG8_STAGE(PG8_SB(1, 1), b3 + hstepB, voffB);
            PG8_WAIT_V(6); PG8_BAR; PG8_MMA(1, 1, At, B1); PG8_BAR;
            }
        }
        if constexpr (ALIGN_EPI) { if (wr == 0) PG8_BAR; }
        E(acc, cur, wr, wc, fr, fq); S.done(cur);
        if (!has_next) break;
#pragma unroll
        for (int a = 0; a < 2; ++a)
#pragma unroll
            for (int b = 0; b < 2; ++b)
#pragma unroll
                for (int m = 0; m < 4; ++m)
#pragma unroll
                    for (int n = 0; n < 2; ++n) acc[a][b][m][n] = (acc_t){0, 0, 0, 0};
        cur = nxt; cA = nA; cB = nB; ++ui;
        if constexpr (ALIGN_EPI) { if (wr == 1) PG8_BAR; }
    }
    PG8_WAIT_V(0);
    if constexpr (!ALIGN_EPI) { if (wr == 0) PG8_BAR; }
    PG8_BAR;
#undef PG8_SA
#undef PG8_SB
#undef PG8_STAGE
#undef PG8_LDA
#undef PG8_LDB
#undef PG8_MMA
#undef PG8_WAIT_V
#undef PG8_WAIT_L
#undef PG8_BAR
#undef PG8_SCHED
}
}

struct Args { const float* in[21]; float* out; unsigned char* ws; int ph_lo, ph_hi, rep, pad; };
struct Frame0 { LAS unsigned char* lds; };
struct Frame {
    LAS unsigned char* lds; int tid, lane, wave, bid, nb;
    const float *x_prompt, *x_sample, *state, *cvec, *cctx, *w_in, *w_conv, *w_a, *w_gk, *b_gk, *w_gn, *w_b, *w_o, *w_ada, *b_ada, *ln_g, *ln_b, *w_pq, *pkeys, *peer_u, *peer_v;
    float* out; unsigned char* ws;
    float* MOD; bf16_t *WIN, *WA, *WB, *WO, *WPQ, *U16; unsigned char* V8; float* VS; float* XA; bf16_t *H, *Z1, *Z2, *Z3, *Z4; float* Z5;
};
typedef const __attribute__((address_space(4))) Args* KArgs;
__device__ __forceinline__ void fill_frame(Frame& F, const Frame0& F0) {
    auto kp = __builtin_amdgcn_kernarg_segment_ptr();
    asm volatile("" : "+s"(kp));
    KArgs A = (KArgs)kp;
    int t_ = threadIdx.x; asm volatile("" : "+v"(t_));
    F.lds = F0.lds; F.tid = t_; F.lane = t_ & 63; F.wave = __builtin_amdgcn_readfirstlane(t_ >> 6); F.bid = blockIdx.x; F.nb = gridDim.x;
    F.x_prompt = A->in[0]; F.x_sample = A->in[1]; F.state = A->in[2]; F.cvec = A->in[3]; F.cctx = A->in[4]; F.w_in = A->in[5]; F.w_conv = A->in[6]; F.w_a = A->in[7];
    F.w_gk = A->in[8]; F.b_gk = A->in[9]; F.w_gn = A->in[10]; F.w_b = A->in[11]; F.w_o = A->in[12]; F.w_ada = A->in[13]; F.b_ada = A->in[14]; F.ln_g = A->in[15]; F.ln_b = A->in[16];
    F.w_pq = A->in[17]; F.pkeys = A->in[18]; F.peer_u = A->in[19]; F.peer_v = A->in[20];
    F.out = A->out; unsigned char* ws = A->ws; F.ws = ws;
    F.MOD = (float*)(ws + WS_MOD); F.WIN = (bf16_t*)(ws + WS_WIN); F.WA = (bf16_t*)(ws + WS_WA); F.WB = (bf16_t*)(ws + WS_WB); F.WO = (bf16_t*)(ws + WS_WO); F.WPQ = (bf16_t*)(ws + WS_WPQ);
    F.U16 = (bf16_t*)(ws + WS_U16); F.V8 = ws + WS_V8; F.VS = (float*)(ws + WS_VS); F.XA = A->out; F.H = (bf16_t*)(ws + WS_H);
    F.Z1 = (bf16_t*)(ws + WS_Z1); F.Z2 = (bf16_t*)(ws + WS_Z2); F.Z3 = (bf16_t*)(ws + WS_Z3); F.Z4 = (bf16_t*)(ws + WS_Z4); F.Z5 = (float*)(ws + WS_Z5);
}
#define PHASE_IDS(F0_) Frame F; fill_frame(F, F0_)
__device__ __forceinline__ const float* xrow_in(const Frame& F, int l, int row) {
    if (l == 0) return row < TCTX ? F.x_prompt + (size_t)row * D : F.x_sample + (size_t)(row - TCTX) * D;
    return F.out + (size_t)row * D;
}
__device__ __forceinline__ int cond_of(int row) { return row < TCTX ? 8 : ((row - TCTX) >> 12); }

__device__ __forceinline__ void phase_mod(const Frame0& F0) {
    PHASE_IDS(F0);
    LAS float* sl = (LAS float*)F.lds;
    LAS float* red = (LAS float*)(F.lds + 73728);
    for (int i = F.tid; i < 9 * 2048; i += 512) { const int ci = i >> 11, dd = i & 2047; const float c = ci < 8 ? F.cvec[ci * 2048 + dd] : F.cctx[dd]; sl[i] = siluf_(c); }
    __syncthreads();
    const int cg = F.tid & 15, ks = F.tid >> 4;
    for (int u = F.bid; u < 2 * 192; u += F.nb) {
        const int l = u / 192, c0 = (u % 192) * 64;
        float acc[9][4];
#pragma unroll
        for (int ci = 0; ci < 9; ++ci)
#pragma unroll
            for (int j = 0; j < 4; ++j) acc[ci][j] = 0.f;
        const float* wp = F.w_ada + ((size_t)l * 2048 + ks * 64) * NADA + c0 + cg * 4;
#pragma unroll 4
        for (int r = 0; r < 64; ++r) {
            const float4 w = *(const float4*)(wp + (size_t)r * NADA);
#pragma unroll
            for (int ci = 0; ci < 9; ++ci) { const float s = sl[ci * 2048 + ks * 64 + r]; acc[ci][0] += s * w.x; acc[ci][1] += s * w.y; acc[ci][2] += s * w.z; acc[ci][3] += s * w.w; }
        }
#pragma unroll
        for (int ci = 0; ci < 9; ++ci)
#pragma unroll
            for (int j = 0; j < 4; ++j) { float v = acc[ci][j]; v += __shfl_xor(v, 16); v += __shfl_xor(v, 32); acc[ci][j] = v; }
        if (F.lane < 16) {
#pragma unroll
            for (int ci = 0; ci < 9; ++ci)
#pragma unroll
                for (int j = 0; j < 4; ++j) red[(F.wave * 9 + ci) * 64 + cg * 4 + j] = acc[ci][j];
        }
        __syncthreads();
        for (int i = F.tid; i < 576; i += 512) { const int ci = i >> 6, c = i & 63; float s = 0.f;
#pragma unroll
            for (int w = 0; w < 8; ++w) s += red[(w * 9 + ci) * 64 + c];
            F.MOD[(size_t)(l * 9 + ci) * NADA + c0 + c] = s + F.b_ada[l * NADA + c0 + c]; }
        __syncthreads();
    }
}
template <class Map>
__device__ __forceinline__ void tr_convert(const Frame0& F0, const float* src, int ldsrc, bf16_t* dst, int K, int N, Map map) {
    PHASE_IDS(F0);
    LAS bf16_t* tile = (LAS bf16_t*)F.lds;
    const int ntn = N / 64, ntk = K / 256;
    for (int u = F.bid; u < ntn * ntk; u += F.nb) {
        const int n0 = (u / ntk) * 64, k0 = (u % ntk) * 256;
        const int nn = F.tid & 63, kq = F.tid >> 6;
        const int sc = map(n0 + nn);
        float vals[32];
#pragma unroll
        for (int i = 0; i < 32; ++i) { const int kk = i * 8 + kq; vals[i] = sc >= 0 ? src[(size_t)(k0 + kk) * ldsrc + sc] : 0.f; }
#pragma unroll
        for (int i = 0; i < 32; ++i) tile[nn * 258 + i * 8 + kq] = f2bf(vals[i]);
        __syncthreads();
#pragma unroll
        for (int i = 0; i < 4; ++i) { const int id = F.tid + 512 * i, r = id >> 5, kc = id & 31; const LAS unsigned* p = (const LAS unsigned*)(tile + r * 258 + kc * 8);
            uint4 o; o.x = p[0]; o.y = p[1]; o.z = p[2]; o.w = p[3];
            *(uint4*)(dst + (size_t)(n0 + r) * K + k0 + kc * 8) = o; }
        __syncthreads();
    }
}
template <class Map>
__device__ __forceinline__ void tr_convert8(const Frame0& F0, const float* src, int ldsrc, unsigned char* dst, float* scales, int K, int N, Map map) {
    PHASE_IDS(F0);
    LAS unsigned char* tile = (LAS unsigned char*)F.lds;
    LAS float* red = (LAS float*)(F.lds + 64 * 272);
    const int nn = F.tid & 63, kq = F.tid >> 6;
    for (int u = F.bid; u < N / 64; u += F.nb) {
        const int n0 = u * 64;
        const int sc = map(n0 + nn);
        float m = 0.f;
        for (int i0 = 0; i0 < K / 8; i0 += 32) {
            float vals[32];
#pragma unroll
            for (int i = 0; i < 32; ++i) vals[i] = sc >= 0 ? src[(size_t)((i0 + i) * 8 + kq) * ldsrc + sc] : 0.f;
#pragma unroll
            for (int i = 0; i < 32; ++i) m = fmaxf(m, fabsf(vals[i]));
        }
        __syncthreads();
        red[kq * 64 + nn] = m;
        __syncthreads();
        if (F.tid < 64) { float mm = 0.f;
#pragma unroll
            for (int q = 0; q < 8; ++q) mm = fmaxf(mm, red[q * 64 + F.tid]);
            const float scl = mm > 0.f ? mm * (1.f / 127.f) : 1.f; scales[n0 + F.tid] = scl; red[512 + F.tid] = 1.f / scl; }
        __syncthreads();
        const float inv = red[512 + nn];
        for (int k0 = 0; k0 < K; k0 += 256) {
            float vals[32];
#pragma unroll
            for (int i = 0; i < 32; ++i) vals[i] = sc >= 0 ? src[(size_t)(k0 + i * 8 + kq) * ldsrc + sc] : 0.f;
#pragma unroll
            for (int i = 0; i < 32; ++i) tile[nn * 272 + i * 8 + kq] = (unsigned char)(__float2int_rn(vals[i] * inv) & 255);
            __syncthreads();
#pragma unroll
            for (int i = 0; i < 2; ++i) { const int id = F.tid + 512 * i, r = id >> 4, kc = id & 15; const u32x4 o = *(const LAS u32x4*)(tile + r * 272 + kc * 16);
                *(u32x4*)(dst + (size_t)(n0 + r) * K + k0 + kc * 16) = o; }
            __syncthreads();
        }
    }
}
struct MapId { __device__ __forceinline__ int operator()(int n) const { return n; } };
struct MapInOff { int off; __device__ __forceinline__ int operator()(int n) const { n += off; return n < 9216 ? n : (n < 13312 ? n + 32 : (n < 13344 ? n - 13312 + 9216 : -1)); } };
struct MapIn { __device__ __forceinline__ int operator()(int n) const { return n < 9216 ? n : (n < 13312 ? n + 32 : (n < 13344 ? n - 13312 + 9216 : -1)); } };
__device__ __forceinline__ void conv_tables(const Frame0& F0, int l) {
    PHASE_IDS(F0);
    for (int e = F.bid * 8 + F.wave; e < 16384; e += F.nb * 8) {
        const float* s = F.peer_v + ((size_t)l * 16384 + e) * 2048;
        float4 v[8]; float m = 0.f;
#pragma unroll
        for (int i = 0; i < 8; ++i) { v[i] = *(const float4*)(s + i * 256 + F.lane * 4); m = fmaxf(m, fmaxf(fmaxf(fabsf(v[i].x), fabsf(v[i].y)), fmaxf(fabsf(v[i].z), fabsf(v[i].w)))); }
#pragma unroll
        for (int sh = 32; sh >= 1; sh >>= 1) m = fmaxf(m, __shfl_xor(m, sh));
        const float sc = m > 0.f ? m * (1.f / 127.f) : 1.f, inv = 1.f / sc;
#pragma unroll
        for (int i = 0; i < 8; ++i) *(unsigned*)(F.V8 + (size_t)e * 2048 + i * 256 + F.lane * 4) = pack_i8(v[i].x * inv, v[i].y * inv, v[i].z * inv, v[i].w * inv);
        if (F.lane == 0) F.VS[e] = sc;
    }
    for (int e = F.bid * 8 + F.wave; e < 16384; e += F.nb * 8) {
        const float* s = F.peer_u + ((size_t)l * 16384 + e) * 2048;
        float m = 0.f;
#pragma unroll
        for (int i = 0; i < 8; ++i) { const float4 v = *(const float4*)(s + i * 256 + F.lane * 4); m = fmaxf(m, fmaxf(fmaxf(fabsf(v.x), fabsf(v.y)), fmaxf(fabsf(v.z), fabsf(v.w)))); }
        m = wmax(m);
        if (F.lane == 0) F.VS[16384 + e] = m > 0.f ? m * (1.f / 127.f) : 1.f;
    }
}
__device__ __forceinline__ void phase_prologue(const Frame0& F0) {
    phase_mod(F0);
    for (int l = 0; l < 2; ++l) {
        Frame P; fill_frame(P, F0);
        tr_convert(F0, P.w_in + (size_t)l * 2048 * 13344, 13344, P.WIN + ((size_t)l * NINP + 4096) * 2048, 2048, 3072, MapInOff{4096});
        tr_convert(F0, P.w_in + (size_t)l * 2048 * 13344, 13344, P.WIN + ((size_t)l * NINP + 13312) * 2048, 2048, 256, MapInOff{13312});
        tr_convert8(F0, P.w_in + (size_t)l * 2048 * 13344, 13344, P.ws + WS_W8IN + (size_t)l * NINP * 2048, (float*)(P.ws + WS_CSIN) + (size_t)l * NINP, 2048, NINP, MapIn());
        tr_convert(F0, P.w_a + (size_t)l * 1024 * 2048, 2048, P.WA + (size_t)l * 2048 * 1024, 1024, 2048, MapId());
        tr_convert8(F0, P.w_b + (size_t)l * 2048 * 2048, 2048, (unsigned char*)P.WB + (size_t)l * 2048 * 2048, (float*)((unsigned char*)P.WB + (size_t)2 * 2048 * 2048) + l * 2048, 2048, 2048, MapId());
        tr_convert(F0, P.w_o + (size_t)l * 2048 * 2048, 2048, P.WO + (size_t)l * 2048 * 2048, 2048, 2048, MapId());
        tr_convert8(F0, P.w_pq + (size_t)l * 2048 * 2048, 2048, (unsigned char*)P.WPQ + (size_t)l * 2048 * 2048, (float*)((unsigned char*)P.WPQ + (size_t)2 * 2048 * 2048) + l * 2048, 2048, 2048, MapId());
    }
}

__device__ __forceinline__ void phase_lnmod(const Frame0& F0, int l) {
    PHASE_IDS(F0);
    const int stride = F.nb * 8;
    int row = F.bid * 8 + F.wave;
    float4 v[8], shv[8], scv[8]; int cci = -1;
    if (row < T) { const float* xr = xrow_in(F, l, row);
#pragma unroll
        for (int i = 0; i < 8; ++i) v[i] = *(const float4*)(xr + i * 256 + F.lane * 4); }
    for (; row < T; row += stride) {
        float4 vn[8];
        const int nrow = row + stride;
        if (nrow < T) { const float* xn = xrow_in(F, l, nrow);
#pragma unroll
            for (int i = 0; i < 8; ++i) vn[i] = *(const float4*)(xn + i * 256 + F.lane * 4); }
        else {
#pragma unroll
            for (int i = 0; i < 8; ++i) vn[i] = v[i]; }
        const int ci = cond_of(row);
        if (ci != cci) { const float* md = F.MOD + (size_t)(l * 9 + ci) * NADA; cci = ci;
#pragma unroll
            for (int i = 0; i < 8; ++i) { shv[i] = *(const float4*)(md + i * 256 + F.lane * 4); scv[i] = *(const float4*)(md + 2048 + i * 256 + F.lane * 4); } }
        float s = 0.f;
#pragma unroll
        for (int i = 0; i < 8; ++i) s += (v[i].x + v[i].y) + (v[i].z + v[i].w);
        const float mean = wsum(s) * (1.f / 2048.f);
        float q = 0.f;
#pragma unroll
        for (int i = 0; i < 8; ++i) { const float a = v[i].x - mean, b = v[i].y - mean, c = v[i].z - mean, d = v[i].w - mean; q += (a * a + b * b) + (c * c + d * d); }
        const float rstd = rsqrtf(wsum(q) * (1.f / 2048.f) + LN_EPS);
        float am = 0.f;
#pragma unroll
        for (int i = 0; i < 8; ++i) { const int col = i * 256 + F.lane * 4;
            const float4 sh = shv[i], sc = scv[i];
            const float y0 = (v[i].x - mean) * rstd * (1.f + sc.x) + sh.x, y1 = (v[i].y - mean) * rstd * (1.f + sc.y) + sh.y;
            const float y2 = (v[i].z - mean) * rstd * (1.f + sc.z) + sh.z, y3 = (v[i].w - mean) * rstd * (1.f + sc.w) + sh.w;
            if (row < TCTX) { u32x2 o; o.x = cvt_pk_bf16(y0, y1); o.y = cvt_pk_bf16(y2, y3); *(u32x2*)(F.H + (size_t)row * D + col) = o; }
            v[i].x = y0; v[i].y = y1; v[i].z = y2; v[i].w = y3; am = fmaxf(am, fmaxf(fmaxf(fabsf(y0), fabsf(y1)), fmaxf(fabsf(y2), fabsf(y3)))); }
        am = wmax(am);
        const float hs = am > 0.f ? am * (1.f / 127.f) : 1.f, hinv = 1.f / hs;
#pragma unroll
        for (int i = 0; i < 8; ++i) *(unsigned*)(F.ws + WS_H8IN + (size_t)row * D + i * 256 + F.lane * 4) = pack_i8(v[i].x * hinv, v[i].y * hinv, v[i].z * hinv, v[i].w * hinv);
        if (F.lane == 0) ((float*)(F.ws + WS_HSIN))[row] = hs;
#pragma unroll
        for (int i = 0; i < 8; ++i) v[i] = vn[i];
    }
}

__device__ __forceinline__ unsigned dpp_ror8(unsigned x) { return (unsigned)__builtin_amdgcn_update_dpp(0, (int)x, 0x128, 0xf, 0xf, true); }
__device__ __forceinline__ void store_rows128(bf16_t* base, size_t ld, int fr, int fq, const u32x4 w0, const u32x4 w1) {
    const bool lo = fr < 8;
    u32x4 a, b;
#pragma unroll
    for (int j = 0; j < 4; ++j) { const unsigned t0 = dpp_ror8(w0[j]), t1 = dpp_ror8(w1[j]); a[j] = lo ? w0[j] : t1; b[j] = lo ? t0 : w1[j]; }
    bf16_t* p = base + (size_t)(fr & 7) * ld + (lo ? 0 : 32) + 8 * fq;
#if STORE_POLICY == 1
    __builtin_nontemporal_store(a, (u32x4*)p); __builtin_nontemporal_store(b, (u32x4*)(p + 8 * ld));
#elif STORE_POLICY == 2
    asm volatile("global_store_dwordx4 %0, %1, off sc1" :: "v"(p), "v"(a) : "memory"); asm volatile("global_store_dwordx4 %0, %1, off sc1" :: "v"(p + 8 * ld), "v"(b) : "memory");
#elif STORE_POLICY == 3
    asm volatile("global_store_dwordx4 %0, %1, off sc0 sc1" :: "v"(p), "v"(a) : "memory"); asm volatile("global_store_dwordx4 %0, %1, off sc0 sc1" :: "v"(p + 8 * ld), "v"(b) : "memory");
#else
    *(u32x4*)p = a; *(u32x4*)(p + 8 * ld) = b;
#endif
}
__device__ __forceinline__ void store_rows128_f32(float* base, size_t ld, int fr, int fq, const f32x4 v0, const f32x4 v1) {
    const bool lo = fr < 8;
    f32x4 a, b;
#pragma unroll
    for (int j = 0; j < 4; ++j) { const float t0 = __uint_as_float(dpp_ror8(__float_as_uint(v0[j]))), t1 = __uint_as_float(dpp_ror8(__float_as_uint(v1[j]))); a[j] = lo ? v0[j] : t1; b[j] = lo ? t0 : v1[j]; }
    float* p = base + (size_t)(fr & 7) * ld + (lo ? 0 : 16) + 4 * fq;
    *(f32x4*)p = a; *(f32x4*)(p + 8 * ld) = b;
}
__device__ __forceinline__ float4 ld_bf4(const bf16_t* p) { const u32x2 w = *(const u32x2*)p; float4 r; r.x = __uint_as_float(w.x << 16); r.y = __uint_as_float(w.x & 0xffff0000u); r.z = __uint_as_float(w.y << 16); r.w = __uint_as_float(w.y & 0xffff0000u); return r; }
__device__ __forceinline__ u32x4 pack8(const f32x4 v0, const f32x4 v1) { u32x4 w; w.x = cvt_pk_bf16(v0[0], v0[1]); w.y = cvt_pk_bf16(v0[2], v0[3]); w.z = cvt_pk_bf16(v1[0], v1[1]); w.w = cvt_pk_bf16(v1[2], v1[3]); return w; }
struct EpiIn {
    static constexpr bool PERM = true;
    bf16_t *Z1, *ZQ, *ZK, *ZV, *Z3, *GA, *GB; float* Z5;
    __device__ __forceinline__ void operator()(const f32x4 (&acc)[2][2][4][2], const pg8::Unit& u, int wr, int wc, int fr0, int fq0) const {
        int fr = fr0, fq = fq0; asm volatile("" : "+v"(fr), "+v"(fq));
        const int rw = u.pm * 256 + wr * 64;
        if (u.pn < 52) {
            bf16_t* base; int ld, c;
            const int colt = u.pn * 256;
            if (u.pn < 12) { base = Z1; ld = 3072; c = colt; }
            else if (u.pn < 16) { base = ZQ; ld = 1024; c = colt - 3072; }
            else if (u.pn < 20) { base = ZK; ld = 1024; c = colt - 4096; }
            else if (u.pn < 28) { base = ZV; ld = 2048; c = colt - 5120; }
            else if (u.pn < 36) { base = Z3; ld = 2048; c = colt - 7168; }
            else if (u.pn < 44) { base = GA; ld = 2048; c = colt - 9216; }
            else { base = GB; ld = 2048; c = colt - 11264; }
#pragma unroll
            for (int ai = 0; ai < 2; ++ai)
#pragma unroll
                for (int m = 0; m < 4; ++m)
                    store_rows128(base + (size_t)(rw + ai * 128 + m * 16) * ld + c + wc * 64, (size_t)ld, fr, fq, pack8(acc[ai][0][m][0], acc[ai][0][m][1]), pack8(acc[ai][1][m][0], acc[ai][1][m][1]));
        } else if (wc == 0) {
#pragma unroll
            for (int ai = 0; ai < 2; ++ai)
#pragma unroll
                for (int m = 0; m < 4; ++m) { float* rowp = Z5 + (size_t)(rw + fr + ai * 128 + m * 16) * 32 + 8 * fq;
                    *(f32x4*)(rowp) = acc[ai][0][m][0]; *(f32x4*)(rowp + 4) = acc[ai][0][m][1]; }
        }
    }
};
struct SubsetOrder {
    int mode, G, c;
    __device__ __forceinline__ bool next(int i, pg8::Unit& u) const {
        const long L = (long)i * G + c;
        if (mode == 0) { if (L >= 208) return false; const int k = (int)L >> 4; u.pm = (int)L & 15; u.pn = k < 12 ? 16 + k : 52; return true; }
        if (L >= 7424) return false;
        const int w = ((int)L & 7) * 928 + ((int)L >> 3);
        if (w < 6784) { const int r = w % 424; u.pm = 16 + (w / 424) * 8 + (r & 7); u.pn = r >> 3; }
        else { const int v = w - 6784, q = v >> 4; u.pm = v & 15; u.pn = q < 16 ? q : q + 12; }
        return true;
    }
    __device__ __forceinline__ void a_ready(const pg8::Unit&) const {}
    __device__ __forceinline__ void done(const pg8::Unit&) const {}
};
struct EpiInS {
    static constexpr bool PERM = true;
    bf16_t *Z1, *ZQ, *ZK, *ZV, *Z3, *GA, *GB; float* Z5; const float* RS; const float* CS;
    __device__ __forceinline__ void operator()(const i32x4 (&acc)[2][2][4][2], const pg8::Unit& u, int wr, int wc, int fr0, int fq0) const {
        int fr = fr0, fq = fq0; asm volatile("" : "+v"(fr), "+v"(fq));
        const int rw = u.pm * 256 + wr * 64;
        const int colt = u.pn * 256;
        f32x4 cs[2][2];
#pragma unroll
        for (int bj = 0; bj < 2; ++bj)
#pragma unroll
            for (int n = 0; n < 2; ++n) cs[bj][n] = *(const f32x4*)(CS + colt + wc * 64 + bj * 32 + 8 * fq + 4 * n);
        if (u.pn < 52) {
            bf16_t* base; int ld, c;
            if (u.pn < 12) { base = Z1; ld = 3072; c = colt; }
            else if (u.pn < 16) { base = ZQ; ld = 1024; c = colt - 3072; }
            else if (u.pn < 20) { base = ZK; ld = 1024; c = colt - 4096; }
            else if (u.pn < 28) { base = ZV; ld = 2048; c = colt - 5120; }
            else if (u.pn < 36) { base = Z3; ld = 2048; c = colt - 7168; }
            else if (u.pn < 44) { base = GA; ld = 2048; c = colt - 9216; }
            else { base = GB; ld = 2048; c = colt - 11264; }
#pragma unroll
            for (int ai = 0; ai < 2; ++ai)
#pragma unroll
                for (int m = 0; m < 4; ++m) { const float rs = RS[rw + ai * 128 + m * 16 + fr]; f32x4 v[2][2];
#pragma unroll
                    for (int bj = 0; bj < 2; ++bj)
#pragma unroll
                        for (int n = 0; n < 2; ++n)
#pragma unroll
                            for (int j = 0; j < 4; ++j) v[bj][n][j] = (float)acc[ai][bj][m][n][j] * rs * cs[bj][n][j];
                    store_rows128(base + (size_t)(rw + ai * 128 + m * 16) * ld + c + wc * 64, (size_t)ld, fr, fq, pack8(v[0][0], v[0][1]), pack8(v[1][0], v[1][1])); }
        } else if (wc == 0) {
#pragma unroll
            for (int ai = 0; ai < 2; ++ai)
#pragma unroll
                for (int m = 0; m < 4; ++m) { const float rs = RS[rw + ai * 128 + m * 16 + fr]; float* rowp = Z5 + (size_t)(rw + fr + ai * 128 + m * 16) * 32 + 8 * fq; f32x4 v0, v1;
#pragma unroll
                    for (int j = 0; j < 4; ++j) { v0[j] = (float)acc[ai][0][m][0][j] * rs * cs[0][0][j]; v1[j] = (float)acc[ai][0][m][1][j] * rs * cs[0][1][j]; }
                    *(f32x4*)(rowp) = v0; *(f32x4*)(rowp + 4) = v1; }
        }
    }
};
struct EpiA {
    static constexpr bool PERM = true;
    const bf16_t* Z4; bf16_t* Y;
    __device__ __forceinline__ void operator()(const f32x4 (&acc)[2][2][4][2], const pg8::Unit& u, int wr, int wc, int fr0, int fq0) const {
        int fr = fr0, fq = fq0; asm volatile("" : "+v"(fr), "+v"(fq));
        const int rw = u.pm * 256 + wr * 64, cw = u.pn * 256 + wc * 64;
#pragma unroll
        for (int ai = 0; ai < 2; ++ai)
#pragma unroll
            for (int m = 0; m < 4; ++m) { const size_t row = (size_t)(rw + fr + ai * 128 + m * 16);
                u32x4 w[2];
#pragma unroll
                for (int bj = 0; bj < 2; ++bj) { const int col = cw + bj * 32 + 8 * fq;
                    const u32x4 g = *(const u32x4*)(Z4 + row * 2048 + col);
                    const f32x4 v0 = acc[ai][bj][m][0], v1 = acc[ai][bj][m][1];
                    w[bj].x = cvt_pk_bf16(sigmoidf_(bf_lo(g.x)) * v0[0], sigmoidf_(bf_hi(g.x)) * v0[1]);
                    w[bj].y = cvt_pk_bf16(sigmoidf_(bf_lo(g.y)) * v0[2], sigmoidf_(bf_hi(g.y)) * v0[3]);
                    w[bj].z = cvt_pk_bf16(sigmoidf_(bf_lo(g.z)) * v1[0], sigmoidf_(bf_hi(g.z)) * v1[1]);
                    w[bj].w = cvt_pk_bf16(sigmoidf_(bf_lo(g.w)) * v1[2], sigmoidf_(bf_hi(g.w)) * v1[3]); }
                store_rows128(Y + (size_t)(rw + ai * 128 + m * 16) * 2048 + cw, 2048, fr, fq, w[0], w[1]); }
    }
};
struct EpiB {
    static constexpr bool PERM = true;
    const bf16_t* Z4; bf16_t* Y;
    __device__ __forceinline__ void operator()(const f32x4 (&acc)[2][2][4][2], const pg8::Unit& u, int wr, int wc, int fr0, int fq0) const {
        int fr = fr0, fq = fq0; asm volatile("" : "+v"(fr), "+v"(fq));
        const int rw = u.pm * 256 + wr * 64, cw = u.pn * 256 + wc * 64;
#pragma unroll
        for (int ai = 0; ai < 2; ++ai)
#pragma unroll
            for (int m = 0; m < 4; ++m) { const size_t row = (size_t)(rw + fr + ai * 128 + m * 16);
                u32x4 w[2];
#pragma unroll
                for (int bj = 0; bj < 2; ++bj) { const int col = cw + bj * 32 + 8 * fq;
                    const u32x4 g = *(const u32x4*)(Z4 + row * 2048 + col);
                    const u32x4 y = *(const u32x4*)(Y + row * 2048 + col);
                    const f32x4 v0 = acc[ai][bj][m][0], v1 = acc[ai][bj][m][1];
                    w[bj].x = cvt_pk_bf16(bf_lo(y.x) + sigmoidf_(bf_lo(g.x)) * v0[0], bf_hi(y.x) + sigmoidf_(bf_hi(g.x)) * v0[1]);
                    w[bj].y = cvt_pk_bf16(bf_lo(y.y) + sigmoidf_(bf_lo(g.y)) * v0[2], bf_hi(y.y) + sigmoidf_(bf_hi(g.y)) * v0[3]);
                    w[bj].z = cvt_pk_bf16(bf_lo(y.z) + sigmoidf_(bf_lo(g.z)) * v1[0], bf_hi(y.z) + sigmoidf_(bf_hi(g.z)) * v1[1]);
                    w[bj].w = cvt_pk_bf16(bf_lo(y.w) + sigmoidf_(bf_lo(g.w)) * v1[2], bf_hi(y.w) + sigmoidf_(bf_hi(g.w)) * v1[3]); }
                store_rows128(Y + (size_t)(rw + ai * 128 + m * 16) * 2048 + cw, 2048, fr, fq, w[0], w[1]); }
    }
};
struct EpiO {
    static constexpr bool PERM = true;
    const float *xp, *xs, *xo; const float* MODl; bf16_t* T1; int l;
    __device__ __forceinline__ void operator()(const f32x4 (&acc)[2][2][4][2], const pg8::Unit& u, int wr, int wc, int fr0, int fq0) const {
        int fr = fr0, fq = fq0; asm volatile("" : "+v"(fr), "+v"(fq));
        const int cw = u.pn * 256 + wc * 64;
        const int rbase = u.pm * 256;
        const float* g1 = MODl + (size_t)cond_of(rbase) * NADA + 2 * 2048;
        const float* xb = (l == 0) ? (rbase < TCTX ? xp + (size_t)rbase * D : xs + (size_t)(rbase - TCTX) * D) : xo + (size_t)rbase * D;
#pragma unroll
        for (int ai = 0; ai < 2; ++ai)
#pragma unroll
            for (int m = 0; m < 4; ++m) { const int rl0 = wr * 64 + ai * 128 + m * 16, rl = rl0 + fr; u32x4 w[2];
#pragma unroll
                for (int bj = 0; bj < 2; ++bj) { f32x4 r[2]; const int col = cw + bj * 32 + 8 * fq;
#pragma unroll
                    for (int n = 0; n < 2; ++n) {
                        const f32x4 xv = *(const f32x4*)(xb + (size_t)rl * D + col + 4 * n);
                        const f32x4 gvv = *(const f32x4*)(g1 + col + 4 * n);
                        r[n] = xv * ALPHA + gvv * acc[ai][bj][m][n]; }
                    w[bj] = pack8(r[0], r[1]); }
                store_rows128(T1 + (size_t)(rbase + rl0) * D + cw, (size_t)D, fr, fq, w[0], w[1]);
                __builtin_amdgcn_sched_barrier(0); }
    }
};
struct EpiPlain {
    static constexpr bool PERM = true;
    bf16_t* O; int ld;
    __device__ __forceinline__ void operator()(const f32x4 (&acc)[2][2][4][2], const pg8::Unit& u, int wr, int wc, int fr0, int fq0) const {
        int fr = fr0, fq = fq0; asm volatile("" : "+v"(fr), "+v"(fq));
        const int rw = u.pm * 256 + wr * 64, cw = u.pn * 256 + wc * 64;
#pragma unroll
        for (int ai = 0; ai < 2; ++ai)
#pragma unroll
            for (int m = 0; m < 4; ++m)
                store_rows128(O + (size_t)(rw + ai * 128 + m * 16) * ld + cw, (size_t)ld, fr, fq, pack8(acc[ai][0][m][0], acc[ai][0][m][1]), pack8(acc[ai][1][m][0], acc[ai][1][m][1]));
    }
};
struct EpiPlainS {
    static constexpr bool PERM = true;
    bf16_t* O; int ld; const float* RS; const float* CS;
    __device__ __forceinline__ void operator()(const i32x4 (&acc)[2][2][4][2], const pg8::Unit& u, int wr, int wc, int fr0, int fq0) const {
        int fr = fr0, fq = fq0; asm volatile("" : "+v"(fr), "+v"(fq));
        const int rw = u.pm * 256 + wr * 64, cw = u.pn * 256 + wc * 64;
        f32x4 cs[2][2];
#pragma unroll
        for (int bj = 0; bj < 2; ++bj)
#pragma unroll
            for (int n = 0; n < 2; ++n) cs[bj][n] = *(const f32x4*)(CS + cw + bj * 32 + 8 * fq + 4 * n);
#pragma unroll
        for (int ai = 0; ai < 2; ++ai)
#pragma unroll
            for (int m = 0; m < 4; ++m) { const float rs = RS[rw + ai * 128 + m * 16 + fr]; f32x4 v[2][2];
#pragma unroll
                for (int bj = 0; bj < 2; ++bj)
#pragma unroll
                    for (int n = 0; n < 2; ++n)
#pragma unroll
                        for (int j = 0; j < 4; ++j) v[bj][n][j] = (float)acc[ai][bj][m][n][j] * rs * cs[bj][n][j];
                store_rows128(O + (size_t)(rw + ai * 128 + m * 16) * ld + cw, (size_t)ld, fr, fq, pack8(v[0][0], v[0][1]), pack8(v[1][0], v[1][1])); }
    }
};
struct EpiBS {
    static constexpr bool PERM = true;
    const bf16_t* Z4; bf16_t* Y; const float* RS; const float* CS;
    __device__ __forceinline__ void operator()(const i32x4 (&acc)[2][2][4][2], const pg8::Unit& u, int wr, int wc, int fr0, int fq0) const {
        int fr = fr0, fq = fq0; asm volatile("" : "+v"(fr), "+v"(fq));
        const int rw = u.pm * 256 + wr * 64, cw = u.pn * 256 + wc * 64;
        f32x4 cs[2][2];
#pragma unroll
        for (int bj = 0; bj < 2; ++bj)
#pragma unroll
            for (int n = 0; n < 2; ++n) cs[bj][n] = *(const f32x4*)(CS + cw + bj * 32 + 8 * fq + 4 * n);
#pragma unroll
        for (int ai = 0; ai < 2; ++ai)
#pragma unroll
            for (int m = 0; m < 4; ++m) { const size_t row = (size_t)(rw + fr + ai * 128 + m * 16); const float rs = RS[row];
                u32x4 w[2];
#pragma unroll
                for (int bj = 0; bj < 2; ++bj) { const int col = cw + bj * 32 + 8 * fq;
                    const u32x4 g = *(const u32x4*)(Z4 + row * 2048 + col);
                    const u32x4 y = *(const u32x4*)(Y + row * 2048 + col);
                    f32x4 v0, v1;
#pragma unroll
                    for (int j = 0; j < 4; ++j) { v0[j] = (float)acc[ai][bj][m][0][j] * rs * cs[bj][0][j]; v1[j] = (float)acc[ai][bj][m][1][j] * rs * cs[bj][1][j]; }
                    w[bj].x = cvt_pk_bf16(bf_lo(y.x) + sigmoidf_(bf_lo(g.x)) * v0[0], bf_hi(y.x) + sigmoidf_(bf_hi(g.x)) * v0[1]);
                    w[bj].y = cvt_pk_bf16(bf_lo(y.y) + sigmoidf_(bf_lo(g.y)) * v0[2], bf_hi(y.y) + sigmoidf_(bf_hi(g.y)) * v0[3]);
                    w[bj].z = cvt_pk_bf16(bf_lo(y.z) + sigmoidf_(bf_lo(g.z)) * v1[0], bf_hi(y.z) + sigmoidf_(bf_hi(g.z)) * v1[1]);
                    w[bj].w = cvt_pk_bf16(bf_lo(y.w) + sigmoidf_(bf_lo(g.w)) * v1[2], bf_hi(y.w) + sigmoidf_(bf_hi(g.w)) * v1[3]); }
                store_rows128(Y + (size_t)(rw + ai * 128 + m * 16) * 2048 + cw, 2048, fr, fq, w[0], w[1]); }
    }
};
template <class Epi, bool I8 = false>
__device__ __forceinline__ void run_gemm(const Frame& F, const bf16_t* A, const bf16_t* Bt, int N, int K, const Epi& E) {
    pg8::Gemm g{A, Bt, T, N, K}; pg8::StaticOrder S; S.init(T, N, F.nb, F.bid);
    pg8::gemm_phase<Epi, pg8::StaticOrder, true, true, I8>(F.lds, g, S, E);
}
#define B_ZQ(F) ((F).Z2)
#define B_ZK(F) ((F).Z2 + (size_t)T * 1024)
#define B_ZV(F) ((F).Z2 + (size_t)T * 2048)
#define B_GA(F) ((F).Z4)
#define B_GB(F) ((F).Z4 + (size_t)T * 2048)
#define B_Y(F)  ((F).Z1 + (size_t)T * 1024)
#define B_QDF(F) ((F).H)
#define B_KDF(F) ((F).H + (size_t)T * 1024)
#define B_QDB(F) ((F).H + (size_t)T * 2048)
#define B_KDB(F) ((F).Z4)
#define B_DEC(F) ((float*)((F).Z4 + (size_t)T * 1024))
#define B_OF(F) ((F).Z2)
#define B_BIN(F) ((F).H)
#define B_QQ(F) ((F).Z2 + (size_t)T * 2048)
#define B_T1(F) ((F).Z4 + (size_t)T * 2048)
__device__ __forceinline__ void phase_gemm_in(const Frame0& F0, int l) {
    {
        PHASE_IDS(F0); EpiIn E{F.Z1, B_ZQ(F), B_ZK(F), B_ZV(F), F.Z3, B_GA(F), B_GB(F), F.Z5};
        pg8::Gemm g{F.H, F.WIN + (size_t)l * NINP * 2048, T, NINP, 2048}; SubsetOrder S{0, F.nb, F.bid};
        pg8::gemm_phase<EpiIn, SubsetOrder, true, true, false>(F.lds, g, S, E); }
    {
        PHASE_IDS(F0); EpiInS E{F.Z1, B_ZQ(F), B_ZK(F), B_ZV(F), F.Z3, B_GA(F), B_GB(F), F.Z5, (const float*)(F.ws + WS_HSIN), (const float*)(F.ws + WS_CSIN) + (size_t)l * NINP};
        pg8::Gemm g{(const bf16_t*)(F.ws + WS_H8IN), (const bf16_t*)(F.ws + WS_W8IN + (size_t)l * NINP * 2048), T, NINP, 2048}; SubsetOrder S{1, F.nb, F.bid};
        pg8::gemm_phase<EpiInS, SubsetOrder, true, true, true>(F.lds, g, S, E); }
}
__device__ __forceinline__ void phase_gemm_a(const Frame0& F0, int l) { PHASE_IDS(F0); EpiA E{B_GA(F), B_Y(F)}; run_gemm(F, F.H, F.WA + (size_t)l * 2048 * 1024, 2048, 1024, E); }
__device__ __forceinline__ void phase_gemm_b(const Frame0& F0, int l) { PHASE_IDS(F0);
    EpiBS E{B_GB(F), B_Y(F), F.VS + 110592, (const float*)((const unsigned char*)F.WB + (size_t)2 * 2048 * 2048) + l * 2048};
    run_gemm<EpiBS, true>(F, B_BIN(F), (const bf16_t*)((const unsigned char*)F.WB + (size_t)l * 2048 * 2048), 2048, 2048, E); }
__device__ __forceinline__ void phase_gemm_o(const Frame0& F0, int l) { PHASE_IDS(F0); EpiO E{F.x_prompt, F.x_sample, F.out, F.MOD + (size_t)l * 9 * NADA, B_T1(F), l}; run_gemm(F, B_Y(F), F.WO + (size_t)l * 2048 * 2048, 2048, 2048, E); }
__device__ __forceinline__ void phase_gemm_pq(const Frame0& F0, int l) { PHASE_IDS(F0);
    EpiPlainS E{B_QQ(F), 2048, F.VS + 32768, (const float*)((const unsigned char*)F.WPQ + (size_t)2 * 2048 * 2048) + l * 2048};
    run_gemm<EpiPlainS, true>(F, (const bf16_t*)((const unsigned char*)F.Z3 + ((size_t)64 << 20)), (const bf16_t*)((const unsigned char*)F.WPQ + (size_t)l * 2048 * 2048), 2048, 2048, E); }

__device__ __forceinline__ void phase_conv(const Frame0& F0, int l) {
    PHASE_IDS(F0);
    const bf16_t* Z1 = F.Z1; bf16_t* AIN = F.H;
    const size_t gth = (size_t)F.nb * 512;
    for (size_t it = (size_t)F.bid * 512 + F.tid; it < (size_t)T * 128; it += gth) {
        const int t = (int)(it >> 7), ch = (int)(it & 127) * 8;
        int dlt; bool vm, vp;
        if (t < TCTX) { const int pos = t & 255; dlt = 1; vm = pos > 0; vp = pos < 255; }
        else { const int tau = (t - TCTX) & 4095;
            if (ch < 512) { dlt = 1; vm = (tau & 63) > 0; vp = (tau & 63) < 63; } else { dlt = 64; vm = tau >= 64; vp = tau < 4032; } }
        const bf16_t* zr = Z1 + (size_t)t * 3072;
        const u32x4 zero = {0u, 0u, 0u, 0u};
        const u32x4 cb = *(const u32x4*)(zr + ch), cc0 = *(const u32x4*)(zr + 1024 + ch), cx0 = *(const u32x4*)(zr + 2048 + ch);
        const u32x4 ccm = vm ? *(const u32x4*)(zr - (size_t)dlt * 3072 + 1024 + ch) : zero, cxm = vm ? *(const u32x4*)(zr - (size_t)dlt * 3072 + 2048 + ch) : zero;
        const u32x4 ccp = vp ? *(const u32x4*)(zr + (size_t)dlt * 3072 + 1024 + ch) : zero, cxp = vp ? *(const u32x4*)(zr + (size_t)dlt * 3072 + 2048 + ch) : zero;
        const float* wc = F.w_conv + (size_t)l * 3072 + ch;
        const float4 w0a = *(const float4*)(wc), w0b = *(const float4*)(wc + 4), w1a = *(const float4*)(wc + 1024), w1b = *(const float4*)(wc + 1028), w2a = *(const float4*)(wc + 2048), w2b = *(const float4*)(wc + 2052);
        const float w0[8] = {w0a.x, w0a.y, w0a.z, w0a.w, w0b.x, w0b.y, w0b.z, w0b.w};
        const float w1[8] = {w1a.x, w1a.y, w1a.z, w1a.w, w1b.x, w1b.y, w1b.z, w1b.w};
        const float w2[8] = {w2a.x, w2a.y, w2a.z, w2a.w, w2b.x, w2b.y, w2b.z, w2b.w};
        float o[8];
#pragma unroll
        for (int j = 0; j < 4; ++j) {
            const float um0 = bf_lo(ccm[j]) * bf_lo(cxm[j]), um1 = bf_hi(ccm[j]) * bf_hi(cxm[j]);
            const float u00 = bf_lo(cc0[j]) * bf_lo(cx0[j]), u01 = bf_hi(cc0[j]) * bf_hi(cx0[j]);
            const float up0 = bf_lo(ccp[j]) * bf_lo(cxp[j]), up1 = bf_hi(ccp[j]) * bf_hi(cxp[j]);
            o[2 * j] = bf_lo(cb[j]) * (um0 * w0[2 * j] + u00 * w1[2 * j] + up0 * w2[2 * j]);
            o[2 * j + 1] = bf_hi(cb[j]) * (um1 * w0[2 * j + 1] + u01 * w1[2 * j + 1] + up1 * w2[2 * j + 1]);
        }
        u32x4 w; w.x = cvt_pk_bf16(o[0], o[1]); w.y = cvt_pk_bf16(o[2], o[3]); w.z = cvt_pk_bf16(o[4], o[5]); w.w = cvt_pk_bf16(o[6], o[7]);
        *(u32x4*)(AIN + (size_t)t * 1024 + ch) = w;
    }
}

__device__ __forceinline__ float logsig_(float x) { return fminf(x, 0.f) - __logf(1.f + __expf(-fabsf(x))); }
__device__ __forceinline__ void phase_gla_prep(const Frame0& F0, int l) {
    PHASE_IDS(F0);
    LAS float* LF = (LAS float*)F.lds;
    LAS float* HT = LF + 2048;
    const int tid = F.tid;
    const int d = tid & 255, half = tid >> 8, p0 = half * 32;
    const bf16_t* ZQ = B_ZQ(F); const bf16_t* ZK = B_ZK(F); const float* Z5 = F.Z5;
    for (int u = F.bid; u < (T / 64) * 4; u += F.nb) {
        const int ch = u >> 2, head = u & 3, tb = ch * 64;
        __syncthreads();
        { const int row = tid >> 3, part = tid & 7; const f32x4 v = *(const f32x4*)(Z5 + (size_t)(tb + row) * 32 + part * 4);
          *(LAS f32x4*)(LF + (part >> 2) * 1024 + row * 16 + (part & 3) * 4) = v; }
        bf16_t qv[32], kv[32];
#pragma unroll
        for (int i = 0; i < 32; ++i) { const size_t ro = (size_t)(tb + p0 + i) * 1024 + head * 256 + d; qv[i] = ZQ[ro]; kv[i] = ZK[ro]; }
        __syncthreads();
#pragma unroll 1
        for (int dir = 0; dir < 2; ++dir) {
            float wg[16];
#pragma unroll
            for (int r = 0; r < 16; ++r) wg[r] = F.w_gk[((size_t)(l * 2 + dir) * 16 + r) * 1024 + head * 256 + d];
            const float gbias = F.b_gk[(size_t)(l * 2 + dir) * 1024 + head * 256 + d];
            float b[32];
#pragma unroll
            for (int i = 0; i < 32; ++i) { float x = gbias; const LAS float* lf = LF + dir * 1024 + (p0 + i) * 16;
#pragma unroll
                for (int r = 0; r < 16; ++r) x += lf[r] * wg[r];
                b[i] = fmaxf(logsig_(x) * 0.0625f, -1.0f); }
            float tot;
            if (!dir) {
#pragma unroll
                for (int i = 1; i < 32; ++i) b[i] += b[i - 1];
                tot = b[31];
            } else {
#pragma unroll
                for (int i = 30; i >= 0; --i) b[i] += b[i + 1];
                tot = b[0];
            }
            HT[half * 256 + d] = tot;
            __syncthreads();
            const float other = HT[(1 - half) * 256 + d];
            const float blast = tot + other;
            const float addv = (dir == 0) ? (half ? other : 0.f) : (half ? 0.f : other);
            bf16_t* QD = dir ? B_QDB(F) : B_QDF(F); bf16_t* KD = dir ? B_KDB(F) : B_KDF(F);
#pragma unroll
            for (int i = 0; i < 32; ++i) {
                const float bb = b[i] + addv; const size_t ro = (size_t)(tb + p0 + i) * 1024 + head * 256 + d;
                QD[ro] = f2bf(bf1(qv[i]) * 0.0625f * __expf(bb - blast));
                KD[ro] = f2bf(bf1(kv[i]) * __expf(blast - bb));
            }
            if (half == 0) B_DEC(F)[((size_t)dir * (T / 64) * 4 + u) * 256 + d] = __expf(blast);
            __syncthreads();
        }
    }
}
__device__ __forceinline__ void phase_gla_scan(const Frame0& F0, int l) {
    PHASE_IDS(F0);
    LAS unsigned char* L = F.lds;
    constexpr int QD_OFF = 0, KD_OFF = 33792, V_OFF = 67584, ST_OFF = 76800, ATT_OFF = 110592, DEC_OFF = 119808;
    const int tid = F.tid, lane = F.lane, wave = F.wave;
    const int fr = lane & 15, fq = lane >> 4;
    const unsigned lbase = (unsigned)(size_t)L;
    const unsigned tr_lane_v = lbase + V_OFF + (unsigned)((8 * fq + (fr >> 2)) * 144 + 8 * (lane & 3));
    const unsigned tr_lane_k = lbase + KD_OFF + (unsigned)((8 * fq + (fr >> 2)) * 528 + 8 * (lane & 3) + wave * 64);
    const bf16_t* ZV = B_ZV(F); bf16_t* OF = B_OF(F);
    const int ti = wave >> 1;
    for (int u0 = F.bid; u0 < 768; u0 += F.nb) {
        const int u = (F.nb == 256) ? (u0 & ~255) + (u0 & 7) * 32 + ((u0 & 255) >> 3) : u0;
        int seq, head, slice, tok0, nch; bool lat;
        if (u < 256) { lat = true; slice = u & 7; head = (u >> 3) & 3; seq = u >> 5; tok0 = TCTX + seq * 4096; nch = 64; }
        else { const int uc = u - 256; lat = false; slice = uc & 7; head = (uc >> 3) & 3; seq = uc >> 5; tok0 = seq * 256; nch = 4; }
#pragma unroll 1
      for (int dir = 0; dir < 2; ++dir) {
        const bf16_t* QD = dir ? B_QDB(F) : B_QDF(F); const bf16_t* KD = dir ? B_KDB(F) : B_KDF(F);
        const float* DEC = B_DEC(F) + (size_t)dir * (T / 64) * 4 * 256;
        const size_t soff = ((((size_t)seq * 2 + l) * 2 + dir) * 4 + head) * 256 * 512;
        f32x4 accS[2][4];
#pragma unroll
        for (int tdi = 0; tdi < 2; ++tdi)
#pragma unroll
            for (int te = 0; te < 4; ++te)
#pragma unroll
                for (int reg = 0; reg < 4; ++reg) {
                    const int dd = (2 * wave + tdi) * 16 + 4 * fq + reg, e = slice * 64 + te * 16 + fr;
                    accS[tdi][te][reg] = lat ? F.state[soff + (size_t)dd * 512 + e] : 0.f;
                }
        u32x4 rq[4], rk[4], rv; f32x4 rdec = {0.f, 0.f, 0.f, 0.f}; bf16_t ro[2][4];
#define GS_LOAD(cc_) do { const int c_ = dir ? nch - 1 - (cc_) : (cc_); const int tb_ = tok0 + c_ * 64; int tl_ = tid; asm volatile("" : "+v"(tl_));   \
            _Pragma("unroll") for (int i_ = 0; i_ < 4; ++i_) { const int id_ = tl_ + 512 * i_, row_ = id_ >> 5, c16_ = id_ & 31; const size_t go_ = (size_t)(tb_ + row_) * 1024 + head * 256 + c16_ * 8; \
                rq[i_] = *(const u32x4*)(QD + go_); rk[i_] = *(const u32x4*)(KD + go_); } \
            rv = *(const u32x4*)(ZV + (size_t)(tb_ + (tl_ >> 3)) * 2048 + head * 512 + slice * 64 + (tl_ & 7) * 8); \
            if (tl_ < 64) rdec = *(const f32x4*)(DEC + ((size_t)(tb_ >> 6) * 4 + head) * 256 + tl_ * 4); \
            if (dir) { const int ln_ = tl_ & 63, wv_ = tl_ >> 6; const bf16_t* ob_ = OF + (size_t)(tb_ + (wv_ >> 1) * 16 + 4 * (ln_ >> 4)) * 2048 + head * 512 + slice * 64 + 2 * (wv_ & 1) * 16 + (ln_ & 15); \
                _Pragma("unroll") for (int t2_ = 0; t2_ < 2; ++t2_) _Pragma("unroll") for (int reg_ = 0; reg_ < 4; ++reg_) ro[t2_][reg_] = ob_[reg_ * 2048 + t2_ * 16]; } } while (0)
        GS_LOAD(0);
#define GS_BAR() do { asm volatile("s_waitcnt lgkmcnt(0)" ::: "memory"); __builtin_amdgcn_s_barrier(); asm volatile("" ::: "memory"); } while (0)
        for (int cc = 0; cc < nch; ++cc) {
            const int c = dir ? nch - 1 - cc : cc; const int tb = tok0 + c * 64;
            GS_BAR();
#pragma unroll
            for (int i = 0; i < 4; ++i) { const int id = tid + 512 * i, row = id >> 5, c16 = id & 31;
                *(LAS u32x4*)(L + QD_OFF + row * 528 + c16 * 16) = rq[i]; *(LAS u32x4*)(L + KD_OFF + row * 528 + c16 * 16) = rk[i]; }
            *(LAS u32x4*)(L + V_OFF + (tid >> 3) * 144 + (tid & 7) * 16) = rv;
            if (tid < 64) *(LAS f32x4*)(L + DEC_OFF + tid * 16) = rdec;
            bf16_t oold[2][4];
#pragma unroll
            for (int t2 = 0; t2 < 2; ++t2)
#pragma unroll
                for (int reg = 0; reg < 4; ++reg) oold[t2][reg] = ro[t2][reg];
            GS_BAR();
            { const int nx = (cc + 1 < nch) ? cc + 1 : cc; GS_LOAD(nx); }
#pragma unroll
            for (int tdi = 0; tdi < 2; ++tdi) {
                const f32x4 dec = *(const LAS f32x4*)(L + DEC_OFF + ((2 * wave + tdi) * 16 + 4 * fq) * 4);
#pragma unroll
                for (int te = 0; te < 4; ++te) { accS[tdi][te] = accS[tdi][te] * dec;
                    u32x2 w; w.x = cvt_pk_bf16(accS[tdi][te][0], accS[tdi][te][1]); w.y = cvt_pk_bf16(accS[tdi][te][2], accS[tdi][te][3]);
                    *(LAS u32x2*)(L + ST_OFF + (te * 16 + fr) * 528 + ((2 * wave + tdi) * 16 + 4 * fq) * 2) = w; }
            }
#pragma unroll
            for (int t2 = 0; t2 < 2; ++t2) {
                const int tj = 2 * (wave & 1) + t2;
                const bool live = dir ? (tj >= ti) : (tj <= ti);
                f32x4 a4 = {0.f, 0.f, 0.f, 0.f};
                if (live) {
#pragma unroll
                    for (int ks = 0; ks < 8; ++ks) {
                        const bf16x8 a = *(const LAS bf16x8*)(L + QD_OFF + (ti * 16 + fr) * 528 + ks * 64 + fq * 16);
                        const bf16x8 bb = *(const LAS bf16x8*)(L + KD_OFF + (tj * 16 + fr) * 528 + ks * 64 + fq * 16);
                        a4 = __builtin_amdgcn_mfma_f32_16x16x32_bf16(a, bb, a4, 0, 0, 0);
                    }
                }
#pragma unroll
                for (int reg = 0; reg < 4; ++reg) { const int i = ti * 16 + 4 * fq + reg, j = tj * 16 + fr; const bool keep = dir ? (j >= i) : (j <= i);
                    *(LAS bf16_t*)(L + ATT_OFF + i * 144 + j * 2) = f2bf(keep ? a4[reg] : 0.f); }
            }
            GS_BAR();
            u32x2 vt[2][4][2], kt[2][2][2];
            asm volatile(
                "ds_read_b64_tr_b16 %0, %16 offset:0\n\tds_read_b64_tr_b16 %1, %16 offset:576\n\tds_read_b64_tr_b16 %2, %16 offset:32\n\tds_read_b64_tr_b16 %3, %16 offset:608\n\t"
                "ds_read_b64_tr_b16 %4, %16 offset:64\n\tds_read_b64_tr_b16 %5, %16 offset:640\n\tds_read_b64_tr_b16 %6, %16 offset:96\n\tds_read_b64_tr_b16 %7, %16 offset:672\n\t"
                "ds_read_b64_tr_b16 %8, %16 offset:4608\n\tds_read_b64_tr_b16 %9, %16 offset:5184\n\tds_read_b64_tr_b16 %10, %16 offset:4640\n\tds_read_b64_tr_b16 %11, %16 offset:5216\n\t"
                "ds_read_b64_tr_b16 %12, %16 offset:4672\n\tds_read_b64_tr_b16 %13, %16 offset:5248\n\tds_read_b64_tr_b16 %14, %16 offset:4704\n\tds_read_b64_tr_b16 %15, %16 offset:5280\n\t"
                "s_waitcnt lgkmcnt(0)"
                : "=&v"(vt[0][0][0]), "=&v"(vt[0][0][1]), "=&v"(vt[0][1][0]), "=&v"(vt[0][1][1]), "=&v"(vt[0][2][0]), "=&v"(vt[0][2][1]), "=&v"(vt[0][3][0]), "=&v"(vt[0][3][1]),
                  "=&v"(vt[1][0][0]), "=&v"(vt[1][0][1]), "=&v"(vt[1][1][0]), "=&v"(vt[1][1][1]), "=&v"(vt[1][2][0]), "=&v"(vt[1][2][1]), "=&v"(vt[1][3][0]), "=&v"(vt[1][3][1])
                : "v"(tr_lane_v) : "memory");
            asm volatile(
                "ds_read_b64_tr_b16 %0, %8 offset:0\n\tds_read_b64_tr_b16 %1, %8 offset:2112\n\tds_read_b64_tr_b16 %2, %8 offset:16896\n\tds_read_b64_tr_b16 %3, %8 offset:19008\n\t"
                "ds_read_b64_tr_b16 %4, %8 offset:32\n\tds_read_b64_tr_b16 %5, %8 offset:2144\n\tds_read_b64_tr_b16 %6, %8 offset:16928\n\tds_read_b64_tr_b16 %7, %8 offset:19040\n\t"
                "s_waitcnt lgkmcnt(0)"
                : "=&v"(kt[0][0][0]), "=&v"(kt[0][0][1]), "=&v"(kt[0][1][0]), "=&v"(kt[0][1][1]), "=&v"(kt[1][0][0]), "=&v"(kt[1][0][1]), "=&v"(kt[1][1][0]), "=&v"(kt[1][1][1])
                : "v"(tr_lane_k) : "memory");
#define GS_FRAG(x_) __builtin_bit_cast(bf16x8, (u32x4){(x_)[0].x, (x_)[0].y, (x_)[1].x, (x_)[1].y})
#pragma unroll
            for (int t2 = 0; t2 < 2; ++t2) {
                const int te = 2 * (wave & 1) + t2;
                f32x4 o4 = {0.f, 0.f, 0.f, 0.f};
#pragma unroll
                for (int ks = 0; ks < 8; ++ks) {
                    const bf16x8 a = *(const LAS bf16x8*)(L + QD_OFF + (ti * 16 + fr) * 528 + ks * 64 + fq * 16);
                    const bf16x8 bb = *(const LAS bf16x8*)(L + ST_OFF + (te * 16 + fr) * 528 + ks * 64 + fq * 16);
                    o4 = __builtin_amdgcn_mfma_f32_16x16x32_bf16(a, bb, o4, 0, 0, 0);
                }
#pragma unroll
                for (int ks = 0; ks < 2; ++ks) {
                    const bf16x8 a = *(const LAS bf16x8*)(L + ATT_OFF + (ti * 16 + fr) * 144 + ks * 64 + fq * 16);
                    const bf16x8 bb = (t2 == 0) ? ((wave & 1) ? GS_FRAG(vt[ks][2]) : GS_FRAG(vt[ks][0])) : ((wave & 1) ? GS_FRAG(vt[ks][3]) : GS_FRAG(vt[ks][1]));
                    o4 = __builtin_amdgcn_mfma_f32_16x16x32_bf16(a, bb, o4, 0, 0, 0);
                }
#pragma unroll
                for (int reg = 0; reg < 4; ++reg) { bf16_t* op = OF + (size_t)(tb + ti * 16 + 4 * fq + reg) * 2048 + head * 512 + slice * 64 + te * 16 + fr;
                    *op = f2bf(dir ? bf1(oold[t2][reg]) + o4[reg] : o4[reg]); }
            }
#pragma unroll
            for (int tdi = 0; tdi < 2; ++tdi)
#pragma unroll
                for (int te = 0; te < 4; ++te) {
                    f32x4 s4 = accS[tdi][te];
                    s4 = __builtin_amdgcn_mfma_f32_16x16x32_bf16(GS_FRAG(kt[tdi][0]), GS_FRAG(vt[0][te]), s4, 0, 0, 0);
                    s4 = __builtin_amdgcn_mfma_f32_16x16x32_bf16(GS_FRAG(kt[tdi][1]), GS_FRAG(vt[1][te]), s4, 0, 0, 0);
                    accS[tdi][te] = s4;
                }
        }
#undef GS_BAR
#undef GS_LOAD
#undef GS_FRAG
        if (!lat) {
            float* so = F.out + (size_t)T * D + soff;
#pragma unroll
            for (int tdi = 0; tdi < 2; ++tdi)
#pragma unroll
                for (int te = 0; te < 4; ++te)
#pragma unroll
                    for (int reg = 0; reg < 4; ++reg) {
                        const int dd = (2 * wave + tdi) * 16 + 4 * fq + reg, e = slice * 64 + te * 16 + fr;
                        so[(size_t)dd * 512 + e] = accS[tdi][te][reg];
                    }
        }
        __syncthreads();
      }
    }
}

__device__ __forceinline__ void phase_postgla(const Frame0& F0, int l) {
    PHASE_IDS(F0);
    const bf16_t* OF = B_OF(F); const bf16_t* R = F.Z3; unsigned char* BIN = (unsigned char*)B_BIN(F);
    float* BS = F.VS + 110592;
    for (int row = F.bid * 8 + F.wave; row < T; row += F.nb * 8) {
        float y[4][8]; float am = 0.f;
#pragma unroll
        for (int hh = 0; hh < 4; ++hh) {
            const int col = hh * 512 + F.lane * 8;
            const u32x4 a = *(const u32x4*)(OF + (size_t)row * D + col), r = *(const u32x4*)(R + (size_t)row * D + col);
            float o[8]; float ss = 0.f;
#pragma unroll
            for (int j = 0; j < 4; ++j) { o[2 * j] = bf_lo(a[j]); o[2 * j + 1] = bf_hi(a[j]); ss += o[2 * j] * o[2 * j] + o[2 * j + 1] * o[2 * j + 1]; }
            const float rn = rsqrtf(wsum(ss) * (1.f / 512.f) + LN_EPS);
            const float4 g0 = *(const float4*)(F.w_gn + (size_t)l * D + col), g1 = *(const float4*)(F.w_gn + (size_t)l * D + col + 4);
            const float gn[8] = {g0.x, g0.y, g0.z, g0.w, g1.x, g1.y, g1.z, g1.w};
#pragma unroll
            for (int j = 0; j < 4; ++j) { y[hh][2 * j] = o[2 * j] * rn * gn[2 * j] * siluf_(bf_lo(r[j])); y[hh][2 * j + 1] = o[2 * j + 1] * rn * gn[2 * j + 1] * siluf_(bf_hi(r[j]));
                am = fmaxf(am, fmaxf(fabsf(y[hh][2 * j]), fabsf(y[hh][2 * j + 1]))); }
        }
        am = wmax(am);
        const float bs = am > 0.f ? am * (1.f / 127.f) : 1.f, binv = 1.f / bs;
#pragma unroll
        for (int hh = 0; hh < 4; ++hh) { u32x2 w; w.x = pack_i8(y[hh][0] * binv, y[hh][1] * binv, y[hh][2] * binv, y[hh][3] * binv); w.y = pack_i8(y[hh][4] * binv, y[hh][5] * binv, y[hh][6] * binv, y[hh][7] * binv);
            *(u32x2*)(BIN + (size_t)row * D + hh * 512 + F.lane * 8) = w; }
        if (F.lane == 0) BS[row] = bs;
    }
}

__device__ __forceinline__ void phase_ln2(const Frame0& F0, int l) {
    PHASE_IDS(F0);
    const float* lg = F.ln_g + (size_t)(l * 2 + 0) * D; const float* lb = F.ln_b + (size_t)(l * 2 + 0) * D;
    const int stride = F.nb * 8;
    int row = F.bid * 8 + F.wave;
    unsigned char* H8 = (unsigned char*)F.Z3 + ((size_t)64 << 20);
    float4 v[8], lgv[8], lbv[8], shv[8], scv[8]; int cci = -1;
#pragma unroll
    for (int i = 0; i < 8; ++i) { lgv[i] = *(const float4*)(lg + i * 256 + F.lane * 4); lbv[i] = *(const float4*)(lb + i * 256 + F.lane * 4); }
    if (row < T) {
#pragma unroll
        for (int i = 0; i < 8; ++i) v[i] = ld_bf4(B_T1(F) + (size_t)row * D + i * 256 + F.lane * 4); }
    for (; row < T; row += stride) {
        float4 vn[8];
        const int nrow = row + stride;
        if (nrow < T) {
#pragma unroll
            for (int i = 0; i < 8; ++i) vn[i] = ld_bf4(B_T1(F) + (size_t)nrow * D + i * 256 + F.lane * 4); }
        else {
#pragma unroll
            for (int i = 0; i < 8; ++i) vn[i] = v[i]; }
        const int ci = cond_of(row);
        if (ci != cci) { const float* md = F.MOD + (size_t)(l * 9 + ci) * NADA; cci = ci;
#pragma unroll
            for (int i = 0; i < 8; ++i) { shv[i] = *(const float4*)(md + 3 * 2048 + i * 256 + F.lane * 4); scv[i] = *(const float4*)(md + 4 * 2048 + i * 256 + F.lane * 4); } }
        float s = 0.f;
#pragma unroll
        for (int i = 0; i < 8; ++i) s += (v[i].x + v[i].y) + (v[i].z + v[i].w);
        float mean = wsum(s) * (1.f / 2048.f); float q = 0.f;
#pragma unroll
        for (int i = 0; i < 8; ++i) { const float a = v[i].x - mean, b = v[i].y - mean, c = v[i].z - mean, d = v[i].w - mean; q += (a * a + b * b) + (c * c + d * d); }
        float rstd = rsqrtf(wsum(q) * (1.f / 2048.f) + LN_EPS);
        s = 0.f;
#pragma unroll
        for (int i = 0; i < 8; ++i) { const float4 g = lgv[i], bb = lbv[i];
            v[i].x = (v[i].x - mean) * rstd * g.x + bb.x; v[i].y = (v[i].y - mean) * rstd * g.y + bb.y; v[i].z = (v[i].z - mean) * rstd * g.z + bb.z; v[i].w = (v[i].w - mean) * rstd * g.w + bb.w;
            s += (v[i].x + v[i].y) + (v[i].z + v[i].w); }
        mean = wsum(s) * (1.f / 2048.f); q = 0.f;
#pragma unroll
        for (int i = 0; i < 8; ++i) { const float a = v[i].x - mean, b = v[i].y - mean, c = v[i].z - mean, d = v[i].w - mean; q += (a * a + b * b) + (c * c + d * d); }
        rstd = rsqrtf(wsum(q) * (1.f / 2048.f) + LN_EPS);
        float am = 0.f;
#pragma unroll
        for (int i = 0; i < 8; ++i) { const int col = i * 256 + F.lane * 4;
            const float4 sh = shv[i], sc = scv[i]; float4 h;
            h.x = (v[i].x - mean) * rstd * (1.f + sc.x) + sh.x; h.y = (v[i].y - mean) * rstd * (1.f + sc.y) + sh.y; h.z = (v[i].z - mean) * rstd * (1.f + sc.z) + sh.z; h.w = (v[i].w - mean) * rstd * (1.f + sc.w) + sh.w;
            u32x2 o; o.x = cvt_pk_bf16(h.x, h.y); o.y = cvt_pk_bf16(h.z, h.w);
            *(u32x2*)(F.H + (size_t)row * D + col) = o;
            v[i] = h; am = fmaxf(am, fmaxf(fmaxf(fabsf(h.x), fabsf(h.y)), fmaxf(fabsf(h.z), fabsf(h.w)))); }
        am = wmax(am);
        const float hs = am > 0.f ? am * (1.f / 127.f) : 1.f, hinv = 1.f / hs;
#pragma unroll
        for (int i = 0; i < 8; ++i) *(unsigned*)(H8 + (size_t)row * D + i * 256 + F.lane * 4) = pack_i8(v[i].x * hinv, v[i].y * hinv, v[i].z * hinv, v[i].w * hinv);
        if (F.lane == 0) F.VS[32768 + row] = hs;
#pragma unroll
        for (int i = 0; i < 8; ++i) v[i] = vn[i];
    }
}

__device__ __forceinline__ unsigned ord_u32(float f) { const unsigned u = __float_as_uint(f); return (u & 0x80000000u) ? ~u : (u | 0x80000000u); }
__device__ __forceinline__ float unord_f32(unsigned u) { return (u & 0x80000000u) ? __uint_as_float(u & 0x7fffffffu) : __uint_as_float(~u); }
__device__ __forceinline__ unsigned umax_(unsigned a, unsigned b) { return a > b ? a : b; }
__device__ __forceinline__ unsigned xmax4(unsigned m) { m = umax_(m, (unsigned)__shfl_xor((int)m, 16)); m = umax_(m, (unsigned)__shfl_xor((int)m, 32)); return m; }
__device__ __forceinline__ void phase_peer_score(const Frame0& F0, int l) {
    PHASE_IDS(F0);
    LAS unsigned char* L = F.lds;
    constexpr int KL_ROW = 272, LW_OFF = 2 * 128 * KL_ROW;
    constexpr int CA[52] = {0, 0, 0, 0, 0, 0, 0, 0, 0, 0, 0, 0, 0, 0, 0, 0, 1, 1, 1, 1, 1, 1, 1, 1, 2, 2, 2, 2, 2, 3, 3, 3, 3, 4, 4, 4, 5, 5, 6, 6, 7, 7, 8, 9, 10, 11, 12, 13, 14, 15, 0, 0};
    constexpr int CB[52] = {0, 1, 2, 3, 4, 5, 6, 7, 8, 9, 10, 11, 12, 13, 14, 15, 0, 1, 2, 3, 4, 5, 6, 7, 0, 1, 2, 3, 4, 0, 1, 2, 3, 0, 1, 2, 0, 1, 0, 1, 0, 1, 0, 0, 0, 0, 0, 0, 0, 0, 0, 0};
    const int tid = F.tid, lane = F.lane, wave = F.wave, fr = lane & 15, fq = lane >> 4;
    const bf16_t* QQ = B_QQ(F);
    int* PIDX = (int*)F.Z3; float* PGATE = (float*)((unsigned char*)F.Z3 + (size_t)T * 128 * 4);
    for (int i = tid; i < 2 * 128 * 128 / 4; i += 512) {
        const int idx = i * 4, side = idx >> 14, n = (idx >> 7) & 127, dd = idx & 127;
        const float4 v = *(const float4*)(F.pkeys + (size_t)l * 2 * 128 * 128 + idx);
        u32x2 w; w.x = cvt_pk_bf16(v.x, v.y); w.y = cvt_pk_bf16(v.z, v.w);
        *(LAS u32x2*)(L + (side * 128 + n) * KL_ROW + dd * 2) = w;
    }
    __syncthreads();
    LAS int* nbuf = (LAS int*)(L + LW_OFF + wave * 4096);
    LAS float* vbuf = (LAS float*)(L + LW_OFF + wave * 4096 + 2048);
    bf16x8 bqn[2][4];
    { const int task0 = F.bid * 8 + wave; if (task0 < (T / 16) * 8) { const int tok0 = (task0 >> 3) * 16 + fr, h0 = task0 & 7;
#pragma unroll
        for (int side = 0; side < 2; ++side)
#pragma unroll
            for (int ks = 0; ks < 4; ++ks) bqn[side][ks] = *(const bf16x8*)(QQ + (size_t)tok0 * D + h0 * 256 + side * 128 + ks * 32 + fq * 8); } }
    for (int task = F.bid * 8 + wave; task < (T / 16) * 8; task += F.nb * 8) {
        const int tg = task >> 3, h = task & 7, tok = tg * 16 + fr;
        unsigned key0[32], key1[32];
#pragma unroll
        for (int side = 0; side < 2; ++side)
#pragma unroll
            for (int tile = 0; tile < 8; ++tile) {
                f32x4 s4 = {0.f, 0.f, 0.f, 0.f};
#pragma unroll
                for (int ks = 0; ks < 4; ++ks) {
                    const bf16x8 a = *(const LAS bf16x8*)(L + (side * 128 + tile * 16 + fr) * KL_ROW + ks * 64 + fq * 16);
                    s4 = __builtin_amdgcn_mfma_f32_16x16x32_bf16(a, bqn[side][ks], s4, 0, 0, 0);
                }
#pragma unroll
                for (int reg = 0; reg < 4; ++reg) { const unsigned kv = (ord_u32(s4[reg]) & ~127u) | (unsigned)(127 - (tile * 16 + 4 * fq + reg)); if (side == 0) key0[tile * 4 + reg] = kv; else key1[tile * 4 + reg] = kv; }
                if (tile & 1) __builtin_amdgcn_sched_barrier(0);
            }
        { const int ntask = task + F.nb * 8; if (ntask < (T / 16) * 8) { const int tokn = (ntask >> 3) * 16 + fr, hn = ntask & 7;
#pragma unroll
            for (int side = 0; side < 2; ++side)
#pragma unroll
                for (int ks = 0; ks < 4; ++ks) bqn[side][ks] = *(const bf16x8*)(QQ + (size_t)tokn * D + hn * 256 + side * 128 + ks * 32 + fq * 8); } }
        float v1[16], v2[16];
#pragma unroll
        for (int side = 0; side < 2; ++side) {
#pragma unroll
            for (int r = 0; r < 16; ++r) {
                unsigned m = side == 0 ? key0[0] : key1[0];
#pragma unroll
                for (int i = 1; i < 32; ++i) m = umax_(m, side == 0 ? key0[i] : key1[i]);
                m = xmax4(m);
#pragma unroll
                for (int i = 0; i < 32; ++i) { if (side == 0) key0[i] = (key0[i] == m) ? 0u : key0[i]; else key1[i] = (key1[i] == m) ? 0u : key1[i]; }
                const float val = unord_f32(m & ~127u);
                if (side == 0) v1[r] = val; else v2[r] = val;
                if (fq == 0) { nbuf[fr * 32 + side * 16 + r] = 127 - (int)(m & 127u); vbuf[fr * 32 + side * 16 + r] = val; }
            }
        }
        unsigned ck[13];
#pragma unroll
        for (int s = 0; s < 13; ++s) {
            const float x0 = v1[CA[4 * s]] + v2[CB[4 * s]], x1 = v1[CA[4 * s + 1]] + v2[CB[4 * s + 1]], x2 = v1[CA[4 * s + 2]] + v2[CB[4 * s + 2]], x3 = v1[CA[4 * s + 3]] + v2[CB[4 * s + 3]];
            const int c0 = CA[4 * s] * 16 + CB[4 * s], c1 = CA[4 * s + 1] * 16 + CB[4 * s + 1], c2 = CA[4 * s + 2] * 16 + CB[4 * s + 2], c3 = CA[4 * s + 3] * 16 + CB[4 * s + 3];
            const float xv = fq == 0 ? x0 : (fq == 1 ? x1 : (fq == 2 ? x2 : x3));
            const int cv = fq == 0 ? c0 : (fq == 1 ? c1 : (fq == 2 ? c2 : c3));
            const bool valid = (4 * s + fq) < 50;
            ck[s] = valid ? ((ord_u32(xv) & ~255u) | (unsigned)(255 - cv)) : 0u;
        }
        unsigned cw[16];
#pragma unroll
        for (int r = 0; r < 16; ++r) {
            unsigned m = ck[0];
#pragma unroll
            for (int i = 1; i < 13; ++i) m = umax_(m, ck[i]);
            m = xmax4(m);
#pragma unroll
            for (int i = 0; i < 13; ++i) ck[i] = (ck[i] == m) ? 0u : ck[i];
            cw[r] = m;
        }
        asm volatile("s_waitcnt lgkmcnt(0)" ::: "memory");
        __builtin_amdgcn_wave_barrier();
        float sv[4]; int ix[4];
#pragma unroll
        for (int i = 0; i < 4; ++i) {
            const unsigned m = fq == 0 ? cw[4 * i] : (fq == 1 ? cw[4 * i + 1] : (fq == 2 ? cw[4 * i + 2] : cw[4 * i + 3]));
            const int code = 255 - (int)(m & 255u), a = code >> 4, b = code & 15;
            ix[i] = nbuf[fr * 32 + a] * 128 + nbuf[fr * 32 + 16 + b];
            sv[i] = vbuf[fr * 32 + a] + vbuf[fr * 32 + 16 + b];
        }
        float mx = fmaxf(fmaxf(sv[0], sv[1]), fmaxf(sv[2], sv[3]));
        mx = fmaxf(mx, __shfl_xor(mx, 16)); mx = fmaxf(mx, __shfl_xor(mx, 32));
        float ev[4], es = 0.f;
#pragma unroll
        for (int i = 0; i < 4; ++i) { ev[i] = __expf(sv[i] - mx); es += ev[i]; }
        es += __shfl_xor(es, 16); es += __shfl_xor(es, 32);
        const float inv = 1.f / es;
#pragma unroll
        for (int i = 0; i < 4; ++i) { const size_t o = ((size_t)tok * 8 + h) * 16 + 4 * i + fq; PIDX[o] = ix[i]; PGATE[o] = ev[i] * inv; }
        asm volatile("s_waitcnt lgkmcnt(0)" ::: "memory");
        __builtin_amdgcn_wave_barrier();
    }
}

constexpr int PE_NG = 32, PE_NJ = 8, PE_NTB = T / 128, PE_BI = 16384;
constexpr size_t NPAIR = (size_t)T * 128;
constexpr size_t PE_ITEMS_OFF = 0, PE_VLIST_OFF = (size_t)32 << 20, PE_BLKOFF_OFF = (size_t)64 << 20, PE_GATES_OFF = (size_t)72 << 20;
__device__ __forceinline__ unsigned lds_add(LAS unsigned* p, unsigned v) { return __hip_atomic_fetch_add(p, v, __ATOMIC_RELAXED, __HIP_MEMORY_SCOPE_WORKGROUP); }
__device__ __forceinline__ void phase_peer_bucket(const Frame0& F0) {
    PHASE_IDS(F0);
    LAS unsigned* cnt = (LAS unsigned*)F.lds;
    LAS unsigned* base = cnt + 256;
    LAS unsigned* gstart = base + 256;
    const int* PIDX = (const int*)F.Z3;
    unsigned* ITEMS = (unsigned*)((unsigned char*)F.Z1 + PE_ITEMS_OFF); int* BLKOFF = (int*)((unsigned char*)F.Z1 + PE_BLKOFF_OFF);
    float* GATES = (float*)((unsigned char*)F.Z1 + PE_GATES_OFF); const float* PGATE = (const float*)((const unsigned char*)F.Z3 + (size_t)T * 128 * 4);
    const int tid = F.tid, lane = F.lane, wave = F.wave;
    for (int tb = F.bid; tb < PE_NTB; tb += F.nb) {
        if (tid < 256) cnt[tid] = 0u;
        __syncthreads();
        unsigned myidx[32];
#pragma unroll
        for (int k = 0; k < 32; ++k) { myidx[k] = (unsigned)PIDX[(size_t)tb * PE_BI + tid + 512 * k]; (void)lds_add(&cnt[wave * 32 + (myidx[k] >> 9)], 1u); }
        __syncthreads();
        if (tid < 64) {
            unsigned s = 0u;
            if (tid < 32) {
#pragma unroll
                for (int w = 0; w < 8; ++w) { const unsigned c = cnt[w * 32 + tid]; base[w * 32 + tid] = s; s += c; }
            }
            unsigned incl = s;
#pragma unroll
            for (int off = 1; off < 32; off <<= 1) { const unsigned v = (unsigned)__shfl_up((int)incl, off); if (lane >= off) incl += v; }
            if (tid < 32) {
                const unsigned excl = incl - s; gstart[tid] = excl; if (tid == 31) gstart[32] = incl;
#pragma unroll
                for (int w = 0; w < 8; ++w) base[w * 32 + tid] += excl;
            }
        }
        __syncthreads();
        if (tid < 33) BLKOFF[tb * 33 + tid] = (int)gstart[tid];
        if (tid < 256) cnt[tid] = 0u;
        __syncthreads();
#pragma unroll
        for (int k = 0; k < 32; ++k) { const int i = tid + 512 * k; const unsigned g = myidx[k] >> 9; const unsigned p = lds_add(&cnt[wave * 32 + g], 1u); const unsigned pos = base[wave * 32 + g] + p;
            ITEMS[(size_t)tb * PE_BI + pos] = ((unsigned)(i >> 7) << 21) | ((unsigned)(i & 127) << 14) | myidx[k]; }
        __syncthreads();
    }
}
__device__ __forceinline__ void phase_peer_u(const Frame0& F0, int l) {
    PHASE_IDS(F0);
    const float* PU = F.peer_u + (size_t)l * 16384 * D;
    LAS unsigned char* L = F.lds;
    constexpr int WROW = 272, P_OFF = 512 * WROW;
    LAS int* P = (LAS int*)(L + P_OFF);
    LAS int* B0 = P + 292;
    LAS int* WT = B0 + 288;
    const unsigned char* H2 = (const unsigned char*)F.Z3 + ((size_t)64 << 20);
    const unsigned* ITEMS = (const unsigned*)((unsigned char*)F.Z1 + PE_ITEMS_OFF); const int* BLKOFF = (const int*)((unsigned char*)F.Z1 + PE_BLKOFF_OFF);
    bf16_t* PART = (bf16_t*)F.Z2;
    const int tid = F.tid, lane = F.lane, wave = F.wave;
    for (int u = F.bid; u < PE_NG * PE_NJ; u += F.nb) {
        const int j = u & 7, g = u >> 3;
        __syncthreads();
        for (int i = tid; i < 512 * 16; i += 512) { const int row = i >> 4, c = i & 15;
            const float* sp = PU + (size_t)(g * 512 + row) * D + j * 256 + c * 16; const float4 a = ((const float4*)sp)[0], b = ((const float4*)sp)[1], cq = ((const float4*)sp)[2], dq = ((const float4*)sp)[3];
            const float ui = 1.f / F.VS[16384 + g * 512 + row];
            u32x4 v; v.x = pack_i8(a.x * ui, a.y * ui, a.z * ui, a.w * ui); v.y = pack_i8(b.x * ui, b.y * ui, b.z * ui, b.w * ui); v.z = pack_i8(cq.x * ui, cq.y * ui, cq.z * ui, cq.w * ui); v.w = pack_i8(dq.x * ui, dq.y * ui, dq.z * ui, dq.w * ui);
            *(LAS u32x4*)(L + row * WROW + c * 16) = v; }
        int c = 0;
        if (tid < PE_NTB) { const int b0 = BLKOFF[tid * 33 + g]; c = BLKOFF[tid * 33 + g + 1] - b0; B0[tid] = b0; }
        int incl = c;
#pragma unroll
        for (int off = 1; off < 64; off <<= 1) { const int v = __shfl_up(incl, off); if (lane >= off) incl += v; }
        if (lane == 63) WT[wave] = incl;
        __syncthreads();
        int woff = 0;
#pragma unroll
        for (int w = 0; w < 8; ++w) woff += (w < wave) ? WT[w] : 0;
        if (tid < PE_NTB) P[tid + 1] = incl + woff;
        if (tid == 0) P[0] = 0;
        __syncthreads();
        const int total = P[PE_NTB];
        const int sub = lane & 3;
        int tbw = 0;
        const unsigned char* hbase = H2 + j * 256 + sub * 16;
        const LAS unsigned char* wbase = L + sub * 16;
        bf16_t* partj = PART + (size_t)j * NPAIR;
#define PU_ISSUE(qb_, S) do { const int q_ = (qb_) + lane; S##ok = q_ < total; S##pp = 0; S##tb = 0; S##raw = 0u; \
            if (S##ok) { while (q_ >= P[tbw + 1]) ++tbw; S##pp = tbw * PE_BI + B0[tbw] + (q_ - P[tbw]); S##tb = tbw * 128; S##raw = ITEMS[S##pp]; } } while (0)
#define PU_BCAST(x_, r_) __builtin_amdgcn_update_dpp(0, (x_), (r_) * 0x55, 0xf, 0xf, true)
#define PU_LH1(TE_, H0_, H1_, r_) { const int bc_ = PU_BCAST(TE_, r_); TE_##e[r_] = bc_ & 511; const unsigned char* hp_ = hbase + (size_t)(bc_ >> 9) * D; H0_[2 * (r_)] = *(const u32x4*)(hp_); H0_[2 * (r_) + 1] = *(const u32x4*)(hp_ + 64); H1_[2 * (r_)] = *(const u32x4*)(hp_ + 128); H1_[2 * (r_) + 1] = *(const u32x4*)(hp_ + 192); }
#define PU_LOADH(S, TE_, H0_, H1_) do { TE_ = (int)(((unsigned)(S##tb + (int)(S##raw >> 21)) << 9) | (S##raw & 511u)); \
            PU_LH1(TE_, H0_, H1_, 0) PU_LH1(TE_, H0_, H1_, 1) PU_LH1(TE_, H0_, H1_, 2) PU_LH1(TE_, H0_, H1_, 3) } while (0)
#define PU_DPP_ADD(x_, ctrl_) ((x_) + __builtin_amdgcn_update_dpp(0, (x_), (ctrl_), 0xf, 0xf, true))
#define PU_D4(h_, w_) s0_ = __builtin_amdgcn_sdot4((int)(h_).x, (int)(w_).x, s0_, false); s1_ = __builtin_amdgcn_sdot4((int)(h_).y, (int)(w_).y, s1_, false); \
                s0_ = __builtin_amdgcn_sdot4((int)(h_).z, (int)(w_).z, s0_, false); s1_ = __builtin_amdgcn_sdot4((int)(h_).w, (int)(w_).w, s1_, false);
#define PU_C1(TE_, H0_, H1_, r_) { const LAS unsigned char* wp_ = wbase + TE_##e[r_] * WROW; \
                const u32x4 w0_ = *(const LAS u32x4*)(wp_), w1_ = *(const LAS u32x4*)(wp_ + 64), w2_ = *(const LAS u32x4*)(wp_ + 128), w3_ = *(const LAS u32x4*)(wp_ + 192); int s0_ = 0, s1_ = 0; \
                PU_D4(H0_[2 * (r_)], w0_) PU_D4(H0_[2 * (r_) + 1], w1_) PU_D4(H1_[2 * (r_)], w2_) PU_D4(H1_[2 * (r_) + 1], w3_) \
                int sm_ = s0_ + s1_; sm_ = PU_DPP_ADD(sm_, 0x4e); sm_ = PU_DPP_ADD(sm_, 0xb1);   \
                keep_ = (sub == r_) ? sm_ : keep_; }
#define PU_COMPUTE(S, TE_, H0_, H1_) do { int keep_ = 0; \
            PU_C1(TE_, H0_, H1_, 0) PU_C1(TE_, H0_, H1_, 1) PU_C1(TE_, H0_, H1_, 2) PU_C1(TE_, H0_, H1_, 3) \
            if (S##ok) partj[S##pp] = f2bf((float)keep_); } while (0)
        u32x4 hA0[8], hA1[8], hB0[8], hB1[8]; int teA, teB, teAe[8], teBe[8];
        bool s0ok, s1ok, s2ok, s3ok; int s0pp, s1pp, s2pp, s3pp, s0tb, s1tb, s2tb, s3tb; unsigned s0raw, s1raw, s2raw, s3raw;
        int qb = wave * 64;
        PU_ISSUE(qb, s0); PU_ISSUE(qb + 512, s1); PU_ISSUE(qb + 1024, s2);
        PU_LOADH(s0, teA, hA0, hA1);
        for (; qb < total; qb += 2048) {
            PU_ISSUE(qb + 1536, s3); PU_LOADH(s1, teB, hB0, hB1); PU_COMPUTE(s0, teA, hA0, hA1);
            PU_ISSUE(qb + 2048, s0); PU_LOADH(s2, teA, hA0, hA1); PU_COMPUTE(s1, teB, hB0, hB1);
            PU_ISSUE(qb + 2560, s1); PU_LOADH(s3, teB, hB0, hB1); PU_COMPUTE(s2, teA, hA0, hA1);
            PU_ISSUE(qb + 3072, s2); PU_LOADH(s0, teA, hA0, hA1); PU_COMPUTE(s3, teB, hB0, hB1);
        }
#undef PU_ISSUE
#undef PU_BCAST
#undef PU_LOADH
#undef PU_LH1
#undef PU_C1
#undef PU_D4
#undef PU_DPP_ADD
#undef PU_COMPUTE
    }
}
__device__ __forceinline__ void phase_peer_coef(const Frame0& F0) {
    PHASE_IDS(F0);
    const unsigned* ITEMS = (const unsigned*)((unsigned char*)F.Z1 + PE_ITEMS_OFF); unsigned* VLIST = (unsigned*)((unsigned char*)F.Z1 + PE_VLIST_OFF);
    const bf16_t* PART = (const bf16_t*)F.Z2; const float* PGATE = (const float*)((const unsigned char*)F.Z3 + (size_t)T * 128 * 4);
    for (int Lu = F.bid; Lu < PE_NTB * 8; Lu += F.nb) {
        int tb, su;
        if (F.nb == 256) { const int k = Lu >> 8, b = Lu & 255; tb = k * 32 + (b & 7) * 4 + (b >> 6); su = (b >> 3) & 7; } else { tb = Lu >> 3; su = Lu & 7; }
        const size_t p0 = (size_t)tb * PE_BI + su * 2048 + F.tid;
        unsigned item[4]; float s[4], gt[4], vs[4], qs[4];
#pragma unroll
        for (int r = 0; r < 4; ++r) { item[r] = ITEMS[p0 + r * 512]; s[r] = 0.f; }
#pragma unroll
        for (int r = 0; r < 4; ++r) { const size_t p = p0 + r * 512;
#pragma unroll
            for (int j = 0; j < PE_NJ; ++j) s[r] += bf1(PART[(size_t)j * NPAIR + p]); }
#pragma unroll
        for (int r = 0; r < 4; ++r) { const int t = tb * 128 + (int)(item[r] >> 21), slot = (int)((item[r] >> 14) & 127u);
            gt[r] = PGATE[(size_t)t * 128 + slot]; vs[r] = F.VS[item[r] & 16383u]; qs[r] = F.VS[16384 + (item[r] & 16383u)] * F.VS[32768 + t]; }
#pragma unroll
        for (int r = 0; r < 4; ++r) { const int t = tb * 128 + (int)(item[r] >> 21), slot = (int)((item[r] >> 14) & 127u); const unsigned idx = item[r] & 16383u;
            const float coef = gt[r] * gelu_tanh(s[r] * qs[r]) * vs[r];
            VLIST[((size_t)(t >> 6) * 128 + slot) * 64 + (t & 63)] = (idx << 16) | (unsigned)f2bf(coef); }
    }
}
constexpr size_t PE_PK_OFF = (size_t)80 << 20;
__device__ __forceinline__ void phase_peer_pack(const Frame0& F0) {
    PHASE_IDS(F0);
    const unsigned* VLIST = (const unsigned*)((unsigned char*)F.Z1 + PE_VLIST_OFF); unsigned* PK = (unsigned*)((unsigned char*)F.Z1 + PE_PK_OFF);
    float* CT = F.VS + 73728;
    for (int tw = F.bid + F.wave * F.nb; tw < T / 64; tw += 8 * F.nb) {
        const int t = tw * 64 + F.lane;
        const unsigned* vl = VLIST + (size_t)(t >> 6) * 8192 + (t & 63);
        float cm = 0.f;
#pragma unroll 1
        for (int kh = 0; kh < 2; ++kh) {
            unsigned it[64];
#pragma unroll
            for (int k = 0; k < 64; ++k) it[k] = vl[(kh * 64 + k) * 64];
#pragma unroll
            for (int k = 0; k < 64; ++k) cm = fmaxf(cm, fabsf(__uint_as_float(it[k] << 16)));
        }
        const float ct = cm > 0.f ? cm * (1.f / 127.f) : 1.f, cinv = 1.f / ct;
        unsigned* pk = PK + (size_t)(t >> 6) * (32 * 3 * 64) + (t & 63);
#pragma unroll 1
        for (int kh = 0; kh < 2; ++kh) {
            unsigned it[64];
#pragma unroll
            for (int k = 0; k < 64; ++k) it[k] = vl[(kh * 64 + k) * 64];
#pragma unroll
            for (int q = 0; q < 16; ++q) { const unsigned w0 = it[4 * q], w1 = it[4 * q + 1], w2 = it[4 * q + 2], w3 = it[4 * q + 3];
                unsigned* o = pk + (size_t)((kh * 16 + q) * 3) * 64;
                o[0] = (w0 >> 16) | (w1 & 0xffff0000u); o[64] = (w2 >> 16) | (w3 & 0xffff0000u);
                o[128] = pack_i8(__uint_as_float(w0 << 16) * cinv, __uint_as_float(w1 << 16) * cinv, __uint_as_float(w2 << 16) * cinv, __uint_as_float(w3 << 16) * cinv); }
        }
        CT[t] = ct;
    }
}
__device__ __forceinline__ void phase_peer_v(const Frame0& F0) {
    PHASE_IDS(F0);
    LAS unsigned char* L = F.lds;
    const unsigned char* V8 = F.V8; const unsigned* PK = (const unsigned*)((unsigned char*)F.Z1 + PE_PK_OFF);
    const float* CT = F.VS + 73728;
    float* FBUF = (float*)F.Z2;
    const int tid = F.tid;
    for (int u0 = F.bid; u0 < 256; u0 += F.nb) {
        const int u = (F.nb == 256) ? (u0 & 7) * 32 + (u0 >> 3) : u0;
        __syncthreads();
        for (int e = tid; e < 16384; e += 512) { const u32x2 v = *(const u32x2*)(V8 + (size_t)e * 2048 + u * 8); *(LAS u32x2*)(L + e * 8) = v; }
        __syncthreads();
        unsigned la[48], lb[48];
#define PV_LOAD(dst, t_, kb_) do { const unsigned* pk_ = PK + (size_t)((t_) >> 6) * (32 * 3 * 64) + ((t_) & 63) + (size_t)(kb_) * 48 * 64; \
            _Pragma("unroll") for (int i_ = 0; i_ < 48; ++i_) dst[i_] = pk_[i_ * 64]; } while (0)
#define PV_QUAD(src, q_) do { const unsigned d0_ = src[3 * (q_)], d1_ = src[3 * (q_) + 1], cq_ = src[3 * (q_) + 2]; \
            const u32x2 x0_ = *(const LAS u32x2*)(L + (d0_ & 0xffffu) * 8), x1_ = *(const LAS u32x2*)(L + (d0_ >> 16) * 8), x2_ = *(const LAS u32x2*)(L + (d1_ & 0xffffu) * 8), x3_ = *(const LAS u32x2*)(L + (d1_ >> 16) * 8); \
            { const unsigned tl01 = __builtin_amdgcn_perm(x1_.x, x0_.x, 0x05010400u), th01 = __builtin_amdgcn_perm(x1_.x, x0_.x, 0x07030602u), tl23 = __builtin_amdgcn_perm(x3_.x, x2_.x, 0x05010400u), th23 = __builtin_amdgcn_perm(x3_.x, x2_.x, 0x07030602u); \
              a0 = __builtin_amdgcn_sdot4((int)__builtin_amdgcn_perm(tl23, tl01, 0x05040100u), (int)cq_, a0, false); a1 = __builtin_amdgcn_sdot4((int)__builtin_amdgcn_perm(tl23, tl01, 0x07060302u), (int)cq_, a1, false); \
              a2 = __builtin_amdgcn_sdot4((int)__builtin_amdgcn_perm(th23, th01, 0x05040100u), (int)cq_, a2, false); a3 = __builtin_amdgcn_sdot4((int)__builtin_amdgcn_perm(th23, th01, 0x07060302u), (int)cq_, a3, false); } \
            { const unsigned tl01 = __builtin_amdgcn_perm(x1_.y, x0_.y, 0x05010400u), th01 = __builtin_amdgcn_perm(x1_.y, x0_.y, 0x07030602u), tl23 = __builtin_amdgcn_perm(x3_.y, x2_.y, 0x05010400u), th23 = __builtin_amdgcn_perm(x3_.y, x2_.y, 0x07030602u); \
              a4 = __builtin_amdgcn_sdot4((int)__builtin_amdgcn_perm(tl23, tl01, 0x05040100u), (int)cq_, a4, false); a5 = __builtin_amdgcn_sdot4((int)__builtin_amdgcn_perm(tl23, tl01, 0x07060302u), (int)cq_, a5, false); \
              a6 = __builtin_amdgcn_sdot4((int)__builtin_amdgcn_perm(th23, th01, 0x05040100u), (int)cq_, a6, false); a7 = __builtin_amdgcn_sdot4((int)__builtin_amdgcn_perm(th23, th01, 0x07060302u), (int)cq_, a7, false); } } while (0)
#define PV_BATCH(src) do { _Pragma("unroll") for (int q_ = 0; q_ < 16; ++q_) { PV_QUAD(src, q_); if ((q_ & 3) == 3) __builtin_amdgcn_sched_barrier(0); } } while (0)
        PV_LOAD(la, tid, 0);
        for (int t = tid; t < T; t += 512) {
            int a0 = 0, a1 = 0, a2 = 0, a3 = 0, a4 = 0, a5 = 0, a6 = 0, a7 = 0;
            const float ct = CT[t];
            const int tn = (t + 512 < T) ? t + 512 : t;
            PV_LOAD(lb, t, 1); PV_BATCH(la);
            PV_LOAD(la, tn, 0); PV_BATCH(lb);
            f32x4 o0 = {(float)a0 * ct, (float)a1 * ct, (float)a2 * ct, (float)a3 * ct}, o1 = {(float)a4 * ct, (float)a5 * ct, (float)a6 * ct, (float)a7 * ct};
            *(f32x4*)(FBUF + (size_t)t * D + u * 8) = o0; *(f32x4*)(FBUF + (size_t)t * D + u * 8 + 4) = o1;
        }
#undef PV_LOAD
#undef PV_QUAD
#undef PV_BATCH
    }
}
__device__ __forceinline__ void phase_peer_final(const Frame0& F0, int l) {
    PHASE_IDS(F0);
    const float* FBUF = (const float*)F.Z2;
    const float* lg = F.ln_g + (size_t)(l * 2 + 1) * D; const float* lb = F.ln_b + (size_t)(l * 2 + 1) * D;
    const float* lg0 = F.ln_g + (size_t)(l * 2 + 0) * D; const float* lb0 = F.ln_b + (size_t)(l * 2 + 0) * D;
    LAS float* PL = (LAS float*)F.lds;
    for (int i = F.tid; i < 2048; i += 512) { PL[i] = lg0[i]; PL[2048 + i] = lb0[i]; PL[4096 + i] = lg[i]; PL[6144 + i] = lb[i]; }
    __syncthreads();
    const int stride = F.nb * 8;
    int row = F.bid * 8 + F.wave;
    float4 xv[8], g2v[8]; int cci = -1;
    if (row < T) {
#pragma unroll
        for (int i = 0; i < 8; ++i) xv[i] = ld_bf4(B_T1(F) + (size_t)row * D + i * 256 + F.lane * 4); }
    for (; row < T; row += stride) {
        float4 xn[8], fv[8];
#pragma unroll
        for (int i = 0; i < 8; ++i) fv[i] = *(const float4*)(FBUF + (size_t)row * D + i * 256 + F.lane * 4);
        const int nrow = row + stride;
        if (nrow < T) {
#pragma unroll
            for (int i = 0; i < 8; ++i) xn[i] = ld_bf4(B_T1(F) + (size_t)nrow * D + i * 256 + F.lane * 4); }
        else {
#pragma unroll
            for (int i = 0; i < 8; ++i) xn[i] = xv[i]; }
        int lo4 = F.lane * 4; asm volatile("" : "+v"(lo4));
        {
            float s0 = 0.f;
#pragma unroll
            for (int i = 0; i < 8; ++i) s0 += (xv[i].x + xv[i].y) + (xv[i].z + xv[i].w);
            const float mean0 = wsum(s0) * (1.f / 2048.f); float q0 = 0.f;
#pragma unroll
            for (int i = 0; i < 8; ++i) { const float a = xv[i].x - mean0, b = xv[i].y - mean0, c = xv[i].z - mean0, d = xv[i].w - mean0; q0 += (a * a + b * b) + (c * c + d * d); }
            const float rstd0 = rsqrtf(wsum(q0) * (1.f / 2048.f) + LN_EPS);
#pragma unroll
            for (int i = 0; i < 8; ++i) { const f32x4 g = *(const LAS f32x4*)(PL + i * 256 + lo4), bb = *(const LAS f32x4*)(PL + 2048 + i * 256 + lo4);
                xv[i].x = (xv[i].x - mean0) * rstd0 * g.x + bb.x; xv[i].y = (xv[i].y - mean0) * rstd0 * g.y + bb.y; xv[i].z = (xv[i].z - mean0) * rstd0 * g.z + bb.z; xv[i].w = (xv[i].w - mean0) * rstd0 * g.w + bb.w; }
        }
        float* xr = F.XA + (size_t)row * D;
        const int ci = cond_of(row);
        if (ci != cci) { const float* g2 = F.MOD + (size_t)(l * 9 + ci) * NADA + 5 * 2048; cci = ci;
#pragma unroll
            for (int i = 0; i < 8; ++i) g2v[i] = *(const float4*)(g2 + i * 256 + F.lane * 4); }
        float4 v[8]; float s = 0.f;
#pragma unroll
        for (int i = 0; i < 8; ++i) { const float4 x = xv[i], g = g2v[i], f = fv[i];
            v[i].x = ALPHA * x.x + g.x * f.x; v[i].y = ALPHA * x.y + g.y * f.y; v[i].z = ALPHA * x.z + g.z * f.z; v[i].w = ALPHA * x.w + g.w * f.w; s += (v[i].x + v[i].y) + (v[i].z + v[i].w); }
        float mean = wsum(s) * (1.f / 2048.f); float q = 0.f;
#pragma unroll
        for (int i = 0; i < 8; ++i) { const float a = v[i].x - mean, b = v[i].y - mean, c = v[i].z - mean, d = v[i].w - mean; q += (a * a + b * b) + (c * c + d * d); }
        float rstd = rsqrtf(wsum(q) * (1.f / 2048.f) + LN_EPS);
        s = 0.f;
#pragma unroll
        for (int i = 0; i < 8; ++i) { const int col = i * 256 + F.lane * 4; const f32x4 g = *(const LAS f32x4*)(PL + 4096 + i * 256 + lo4), bb = *(const LAS f32x4*)(PL + 6144 + i * 256 + lo4);
            v[i].x = (v[i].x - mean) * rstd * g.x + bb.x; v[i].y = (v[i].y - mean) * rstd * g.y + bb.y; v[i].z = (v[i].z - mean) * rstd * g.z + bb.z; v[i].w = (v[i].w - mean) * rstd * g.w + bb.w;
            *(float4*)(xr + col) = v[i]; s += (v[i].x + v[i].y) + (v[i].z + v[i].w); }
        if (l == 0) {
            const float* md = F.MOD + (size_t)(9 + ci) * NADA;
            float4 shn[8], scn[8];
#pragma unroll
            for (int i = 0; i < 8; ++i) { shn[i] = *(const float4*)(md + i * 256 + F.lane * 4); scn[i] = *(const float4*)(md + 2048 + i * 256 + F.lane * 4); }
            mean = wsum(s) * (1.f / 2048.f); q = 0.f;
#pragma unroll
            for (int i = 0; i < 8; ++i) { const float a = v[i].x - mean, b = v[i].y - mean, c = v[i].z - mean, d = v[i].w - mean; q += (a * a + b * b) + (c * c + d * d); }
            rstd = rsqrtf(wsum(q) * (1.f / 2048.f) + LN_EPS);
            float am = 0.f;
#pragma unroll
            for (int i = 0; i < 8; ++i) { const int col = i * 256 + F.lane * 4;
                const float4 sh = shn[i], sc = scn[i];
                float4 h; h.x = (v[i].x - mean) * rstd * (1.f + sc.x) + sh.x; h.y = (v[i].y - mean) * rstd * (1.f + sc.y) + sh.y; h.z = (v[i].z - mean) * rstd * (1.f + sc.z) + sh.z; h.w = (v[i].w - mean) * rstd * (1.f + sc.w) + sh.w;
                if (row < TCTX) { u32x2 o; o.x = cvt_pk_bf16(h.x, h.y); o.y = cvt_pk_bf16(h.z, h.w); *(u32x2*)(F.H + (size_t)row * D + col) = o; }
                v[i] = h; am = fmaxf(am, fmaxf(fmaxf(fabsf(h.x), fabsf(h.y)), fmaxf(fabsf(h.z), fabsf(h.w)))); }
            am = wmax(am);
            const float hs = am > 0.f ? am * (1.f / 127.f) : 1.f, hinv = 1.f / hs;
#pragma unroll
            for (int i = 0; i < 8; ++i) *(unsigned*)(F.ws + WS_H8IN + (size_t)row * D + i * 256 + F.lane * 4) = pack_i8(v[i].x * hinv, v[i].y * hinv, v[i].z * hinv, v[i].w * hinv);
            if (F.lane == 0) ((float*)(F.ws + WS_HSIN))[row] = hs;
        }
#pragma unroll
        for (int i = 0; i < 8; ++i) xv[i] = xn[i];
    }
}

constexpr int N_PHASES = 25;
__global__ void __launch_bounds__(512, 2) hybrid_fwd(Args args) {
    extern __shared__ __attribute__((aligned(16))) unsigned char lds_raw[];
    Frame0 F; F.lds = (LAS unsigned char*)lds_raw;
    const int lo = args.ph_lo, hi = args.ph_hi;
#if MK_ONE_LAUNCH
    volatile LAS unsigned* misc = (volatile LAS unsigned*)(F.lds + MISC_OFF);
    if (threadIdx.x < 16) misc[threadIdx.x] = 0u;
    __syncthreads();
    XcdBarrier bar = xcd_barrier_post((unsigned*)(args.ws + WS_BAR), misc);
#define SEAM(k) do { xcd_barrier(bar); } while (0)
#else
#define SEAM(k) do { } while (0)
#endif
#define NREP(k) ((args.rep == (k)) ? 2 : 1)
#ifndef PH_ONLY
#define PH_ONLY -1
#endif
#define IN(k) (lo <= (k) && (k) < hi && (PH_ONLY < 0 || ((k) == 0 ? 0 : ((k) - 1) % 12 + 1) == PH_ONLY))
    if (IN(0)) { for (int r = NREP(13); r > 0; --r) { phase_prologue(F); SEAM(0); } }
    for (int l = 0; l < 2; ++l) {
        const int pb = 1 + 12 * l;
        if (IN(pb + 0) && l == 0) { for (int r = NREP(1); r > 0; --r) { phase_lnmod(F, l); SEAM(pb + 0); } }
        if (IN(pb + 1)) { for (int r = NREP(2); r > 0; --r) { phase_gemm_in(F, l); SEAM(pb + 1); } }
        if (IN(pb + 2)) { for (int r = NREP(3); r > 0; --r) { phase_conv(F, l); SEAM(pb + 2); } }
        if (IN(pb + 3)) { phase_gemm_a(F, l); SEAM(pb + 3); }
        if (IN(pb + 4)) {
#ifndef NO_PREP
            for (int r = NREP(4); r > 0; --r) { phase_gla_prep(F, l); SEAM(pb + 4); }
#endif
#ifndef NO_SCAN
            for (int r = NREP(5); r > 0; --r) { phase_gla_scan(F, l); SEAM(pb + 4); }
#endif
        }
        if (IN(pb + 5)) { for (int r = NREP(6); r > 0; --r) { phase_postgla(F, l); SEAM(pb + 5); } }
        if (IN(pb + 6)) { phase_gemm_b(F, l); SEAM(pb + 6); }
        if (IN(pb + 7)) { phase_gemm_o(F, l); SEAM(pb + 7); }
        if (IN(pb + 8)) { phase_ln2(F, l); conv_tables(F, l); SEAM(pb + 8); }
        if (IN(pb + 9)) { for (int r = NREP(10); r > 0; --r) { phase_gemm_pq(F, l); SEAM(pb + 9); } }
        if (IN(pb + 10)) { for (int r = NREP(11); r > 0; --r) { phase_peer_score(F, l); SEAM(pb + 10); } }
        if (IN(pb + 11)) {
            for (int r = NREP(20); r > 0; --r) { phase_peer_bucket(F); SEAM(pb + 11); }
            for (int r = NREP(21); r > 0; --r) { phase_peer_u(F, l); SEAM(pb + 11); }
            for (int r = NREP(22); r > 0; --r) { phase_peer_coef(F); SEAM(pb + 11); }
            phase_peer_pack(F); SEAM(pb + 11);
            for (int r = NREP(23); r > 0; --r) { phase_peer_v(F); SEAM(pb + 11); }
            phase_peer_final(F, l); SEAM(pb + 11); }
    }
#undef IN
#undef SEAM
}

extern "C" void kernel_launch(void* const* d_in, const int* in_sizes, int n_in, void* d_out, int out_size, void* d_ws, size_t ws_size, hipStream_t stream) {
    static int grid = 0;
    if (grid == 0) {
        if (n_in != 21 || ws_size < WS_END) { fprintf(stderr, "kernel_launch: unexpected inputs (n_in %d) or workspace %zu < %zu\n", n_in, ws_size, (size_t)WS_END); grid = -1; return; }
        int dev = 0, cus = 0, per_cu = 0;
        if (hipGetDevice(&dev) != hipSuccess || hipDeviceGetAttribute(&cus, hipDeviceAttributeMultiprocessorCount, dev) != hipSuccess) { grid = -1; return; }
        if (hipFuncSetAttribute((const void*)hybrid_fwd, hipFuncAttributeMaxDynamicSharedMemorySize, LDS_TOTAL) != hipSuccess) { fprintf(stderr, "kernel_launch: hipFuncSetAttribute failed\n"); grid = -1; return; }
        if (hipOccupancyMaxActiveBlocksPerMultiprocessor(&per_cu, (const void*)hybrid_fwd, 512, LDS_TOTAL) != hipSuccess || per_cu < 1) { fprintf(stderr, "kernel_launch: occupancy query says %d\n", per_cu); }
        (void)hipGetLastError();
        grid = cus;
    }
    if (grid < 0) return;
    (void)hipMemsetAsync((char*)d_ws + WS_BAR, 0, 16384, stream);
    Args a{};
    for (int i = 0; i < 21; ++i) a.in[i] = (const float*)d_in[i];
    a.out = (float*)d_out; a.ws = (unsigned char*)d_ws;
#ifndef PROBE_REP
#define PROBE_REP 0
#endif
    a.rep = PROBE_REP; a.pad = 0;
#if MK_ONE_LAUNCH
    a.ph_lo = 0; a.ph_hi = N_PHASES;
    hipLaunchKernelGGL(hybrid_fwd, dim3(grid), dim3(512), LDS_TOTAL, stream, a);
#else
    for (int p = 0; p < N_PHASES; ++p) { a.ph_lo = p; a.ph_hi = p + 1; hipLaunchKernelGGL(hybrid_fwd, dim3(grid), dim3(512), LDS_TOTAL, stream, a); }
#endif
}
```

```cpp
#include <hip/hip_runtime.h>
#include <cstdio>
#include <cstdint>

#ifndef STORE_POLICY
#define STORE_POLICY 1
#endif
#ifndef MK_ONE_LAUNCH
#define MK_ONE_LAUNCH 1
#endif

#define LAS __attribute__((address_space(3)))
typedef unsigned short bf16_t;
typedef short bf16x8 __attribute__((ext_vector_type(8)));
typedef float f32x4 __attribute__((ext_vector_type(4)));
typedef unsigned u32x4 __attribute__((ext_vector_type(4)));
typedef int i32x4 __attribute__((ext_vector_type(4)));
typedef unsigned u32x2 __attribute__((ext_vector_type(2)));
typedef __bf16 bf16x2_t __attribute__((ext_vector_type(2)));

constexpr int D = 2048, TCTX = 4096, TLAT = 32768, T = TCTX + TLAT;
constexpr int NINP = 13568;
constexpr int NADA = 12288;
constexpr float ALPHA = 1.41421356237f;
constexpr float LN_EPS = 1e-5f;
constexpr int LDS_TOTAL = 155648;
constexpr int MISC_OFF = LDS_TOTAL - 64;

constexpr size_t al256(size_t x) { return (x + 255) & ~(size_t)255; }
constexpr size_t WS_BAR = 0;
constexpr size_t WS_MOD = 16384;
constexpr size_t WS_WIN = WS_MOD + 1048576;
constexpr size_t WS_WA = WS_WIN + (size_t)2 * NINP * 2048 * 2;
constexpr size_t WS_WB = WS_WA + (size_t)2 * 2048 * 1024 * 2;
constexpr size_t WS_WO = WS_WB + (size_t)2 * 2048 * 2048 * 2;
constexpr size_t WS_WPQ = WS_WO + (size_t)2 * 2048 * 2048 * 2;
constexpr size_t WS_H = WS_WPQ + (size_t)2 * 2048 * 2048 * 2;
constexpr size_t WS_Z1 = WS_H + (size_t)T * 2048 * 2;
constexpr size_t WS_Z2 = WS_Z1 + (size_t)T * 3072 * 2;
constexpr size_t WS_Z3 = WS_Z2 + (size_t)T * 4096 * 2;
constexpr size_t WS_Z4 = WS_Z3 + (size_t)T * 2048 * 2;
constexpr size_t WS_U16 = WS_Z4;
constexpr size_t WS_V8 = WS_U16 + (size_t)16384 * 2048 * 2;
constexpr size_t WS_VS = WS_V8 + (size_t)16384 * 2048;
constexpr size_t WS_Z5 = WS_Z4 + (size_t)T * 4096 * 2;
constexpr size_t WS_END0 = WS_Z5 + (size_t)T * 32 * 4;
constexpr size_t WS_H8IN = al256(WS_END0);
constexpr size_t WS_W8IN = WS_H8IN + (size_t)T * 2048;
constexpr size_t WS_CSIN = WS_W8IN + (size_t)2 * NINP * 2048;
constexpr size_t WS_HSIN = WS_CSIN + (size_t)2 * NINP * 4;
constexpr size_t WS_END = WS_HSIN + (size_t)T * 4;

__device__ __forceinline__ unsigned cvt_pk_bf16(float lo, float hi) { unsigned r; asm("v_cvt_pk_bf16_f32 %0, %1, %2" : "=v"(r) : "v"(lo), "v"(hi)); return r; }
__device__ __forceinline__ bf16_t f2bf(float x) { return (bf16_t)(cvt_pk_bf16(x, 0.f) & 0xffffu); }
__device__ __forceinline__ float bf_lo(unsigned w) { return __uint_as_float(w << 16); }
__device__ __forceinline__ float bf_hi(unsigned w) { return __uint_as_float(w & 0xffff0000u); }
__device__ __forceinline__ float bf1(bf16_t u) { return __uint_as_float((unsigned)u << 16); }
__device__ __forceinline__ float wmax(float v) {
#pragma unroll
    for (int sh = 32; sh >= 1; sh >>= 1) v = fmaxf(v, __shfl_xor(v, sh));
    return v; }
__device__ __forceinline__ unsigned pack_i8(float a, float b, float c, float d) { const int q0 = __float2int_rn(a), q1 = __float2int_rn(b), q2 = __float2int_rn(c), q3 = __float2int_rn(d);
    return ((unsigned)q0 & 255u) | (((unsigned)q1 & 255u) << 8) | (((unsigned)q2 & 255u) << 16) | ((unsigned)q3 << 24); }
__device__ __forceinline__ float wsum(float v) {
#pragma unroll
    for (int m = 32; m >= 1; m >>= 1) v += __shfl_xor(v, m);
    return v;
}
__device__ __forceinline__ float sigmoidf_(float x) { return __builtin_amdgcn_rcpf(1.f + __expf(-x)); }
__device__ __forceinline__ float siluf_(float x) { return x * sigmoidf_(x); }
__device__ __forceinline__ float gelu_tanh(float x) {
    const float y = 0.7978845608028654f * (x + 0.044715f * x * x * x);
    const float e = __expf(2.f * y);
    const float th = 1.f - 2.f * __builtin_amdgcn_rcpf(e + 1.f);
    return 0.5f * x * (1.f + th);
}
__device__ __forceinline__ float dot2bf(unsigned a, unsigned b, float acc) { return __builtin_amdgcn_fdot2_f32_bf16(__builtin_bit_cast(bf16x2_t, a), __builtin_bit_cast(bf16x2_t, b), acc, false); }

#define XB_TMO      128
#define XB_XCNT(j)  (256  + 64 * (j))
#define XB_XSUB(j)  (1280 + 64 * (j))
#define XB_XGEN(j)  (2304 + 64 * (j))
#define XB_TOP      3328
#define XB_TOPGEN   3392
#define XCD_BAR_WORDS 3456
#define XB_SPIN_CAP (1u << 18)
__device__ __forceinline__ unsigned xb_ld(unsigned* p)              { return __hip_atomic_load(p, __ATOMIC_RELAXED, __HIP_MEMORY_SCOPE_AGENT); }
__device__ __forceinline__ unsigned xb_add(unsigned* p, unsigned v) { return __hip_atomic_fetch_add(p, v, __ATOMIC_RELAXED, __HIP_MEMORY_SCOPE_AGENT); }
__device__ __forceinline__ unsigned xb_xcc_id() { return (unsigned)__builtin_amdgcn_s_getreg((3 << 11) | 20) & 0xFu; }
#define XB_SPIN(cond, bar) do { unsigned _sp = 0; while (cond) { __builtin_amdgcn_s_sleep(1); \
    if ((++_sp & 255u) == 0u) { if (xb_ld(&(bar)[XB_TMO])) break; if (_sp > XB_SPIN_CAP) { atomicAdd(&(bar)[XB_TMO], 1u); break; } } } } while (0)
struct XcdBarrier { unsigned* bar; unsigned x; volatile LAS unsigned* st; };
__device__ __forceinline__ XcdBarrier xcd_barrier_post(unsigned* bar, volatile LAS unsigned* st) {
    XcdBarrier b; b.bar = bar; b.x = xb_xcc_id(); b.st = st;
    if (threadIdx.x == 0) (void)xb_add(&bar[XB_XCNT(b.x)], 1u);
    return b;
}
__device__ __forceinline__ void xcd_barrier_complete(unsigned* bar, unsigned x, unsigned& nloc, unsigned& nx) {
    const unsigned G = gridDim.x * gridDim.y * gridDim.z;
    unsigned sum, cnt, mine, sp = 0u;
    for (;;) {
        sum = 0u; cnt = 0u; mine = 0u;
#pragma unroll
        for (unsigned j = 0; j < 16; ++j) { const unsigned c = xb_ld(&bar[XB_XCNT(j)]); sum += c; cnt += (c > 0u) ? 1u : 0u; mine = (j == x) ? c : mine; }
        if (sum == G) break;
        __builtin_amdgcn_s_sleep(1);
        if ((++sp & 255u) == 0u) { if (xb_ld(&bar[XB_TMO])) break; if (sp > XB_SPIN_CAP) { atomicAdd(&bar[XB_TMO], 1u); break; } }
    }
    nloc = mine > 0u ? mine : 1u; nx = cnt > 0u ? cnt : 1u;
}
__device__ __forceinline__ void xcd_barrier(const XcdBarrier& b) {
    asm volatile("s_waitcnt vmcnt(0)" ::: "memory");
    __syncthreads();
    if (threadIdx.x == 0) {
        unsigned* bar = b.bar;
        __builtin_amdgcn_s_waitcnt(0);
        unsigned nloc = b.st[0], nx = b.st[1];
        if (nloc == 0u) { xcd_barrier_complete(bar, b.x, nloc, nx); b.st[0] = nloc; b.st[1] = nx; }
        const unsigned old = xb_add(&bar[XB_XSUB(b.x)], 1u);
        const unsigned gen = old / nloc;
        if (old + 1u == (gen + 1u) * nloc) {
            __builtin_amdgcn_fence(__ATOMIC_RELEASE, "agent");
            asm volatile("s_waitcnt vmcnt(0)" ::: "memory");
            const unsigned og = xb_add(&bar[XB_TOP], 1u);
            const unsigned tg = og / nx;
            if (og + 1u == (tg + 1u) * nx) xb_add(&bar[XB_TOPGEN], 1u);
            else XB_SPIN(xb_ld(&bar[XB_TOPGEN]) == tg, bar);
            __builtin_amdgcn_fence(__ATOMIC_ACQUIRE, "agent");
            xb_add(&bar[XB_XGEN(b.x)], 1u);
            asm volatile("s_waitcnt vmcnt(0)" ::: "memory");
        } else {
            XB_SPIN(xb_ld(&bar[XB_XGEN(b.x)]) == gen, bar);
            __builtin_amdgcn_fence(__ATOMIC_ACQUIRE, "agent");
            asm volatile("s_waitcnt vmcnt(0)" ::: "memory");
        }
    }
    __syncthreads();
}

namespace pg8 {
#define PG8_LAS __attribute__((address_space(3)))
constexpr int BM = 256, BK = 64, HALF = 128, HTB = HALF * BK * 2, STAGE_BYTES = 8 * HTB, NXCD = 8, WGM = 8;
__host__ __device__ __forceinline__ int lds_byte(int r, int c) { const int st = (r >> 4) * 2 + (c >> 5), rr = r & 15, cc = c & 31, ob = rr * 64 + cc * 2; return st * 1024 + (ob ^ (((ob >> 9) & 1) << 5)); }
__host__ __device__ __forceinline__ void stage_rc(int b, int& R, int& C) { const int st = b / 1024, sb = b % 1024, swz = sb ^ (((sb >> 9) & 1) << 5); R = (st >> 1) * 16 + swz / 64; C = (st & 1) * 32 + (swz % 64) / 2; }
__host__ __device__ __forceinline__ int perm32(int rho) { const int n = rho >> 4, i = rho & 15; return 8 * (i >> 2) + 4 * n + (i & 3); }
struct Unit { int pm, pn; };
struct Gemm { const bf16_t* A; const bf16_t* Bt; int M, N, K; };
struct StaticOrder {
    int nM, nN, nwg, G, c;
    __host__ __device__ void init(int M, int N, int G_, int c_) { nM = M / BM; nN = N / BM; nwg = nM * nN; G = G_; c = c_; }
    __host__ __device__ bool next(int i, Unit& u) const {
        const long L = (long)i * G + c; if (L >= nwg) return false;
        int wgid = (int)L; { const int q = nwg / NXCD, r = nwg % NXCD, xcd = wgid % NXCD, off = wgid / NXCD; wgid = (xcd < r ? xcd * (q + 1) : r * (q + 1) + (xcd - r) * q) + off; }
        const int nig = WGM * nN, gid = wgid / nig, fm = gid * WGM, gsz = (nM - fm) < WGM ? (nM - fm) : WGM;
        u.pm = fm + ((wgid % nig) % gsz); u.pn = (wgid % nig) / gsz; return true;
    }
    __device__ __forceinline__ void a_ready(const Unit&) const {}
    __device__ __forceinline__ void done(const Unit&) const {}
};

template <bool I8> struct AccT { typedef f32x4 type; };
template <> struct AccT<true> { typedef i32x4 type; };
template <class Epi, class Sched, bool ALIGN_EPI = false, bool SP2 = false, bool I8 = false>
__device__ __forceinline__ void gemm_phase(PG8_LAS unsigned char* lds, const Gemm g, const Sched& S, const Epi& E) {
    int tid_ = threadIdx.x; asm volatile("" : "+v"(tid_));
    const int tid = tid_, wid = __builtin_amdgcn_readfirstlane(tid >> 6), lane = tid & 63, wr = wid >> 2, wc = wid & 3, fr = lane & 15, fq = lane >> 4;
    const int K = g.K, nt = I8 ? K / (2 * BK) : K / BK; const unsigned KB = I8 ? (unsigned)K : 2u * (unsigned)K;
    typedef typename AccT<I8>::type acc_t;
    unsigned voffA[2], voffB[2];
#pragma unroll
    for (int i = 0; i < 2; ++i) { int R, C; stage_rc(tid * 16 + i * 8192, R, C); const int Rb = 64 * (R >> 5) + (Epi::PERM ? perm32(R & 31) : (R & 31));
        voffA[i] = (unsigned)R * KB + (unsigned)C * 2u; voffB[i] = (unsigned)Rb * KB + (unsigned)C * 2u; }
    const size_t kstep = (size_t)(BK * 2);
    const size_t hstep = (size_t)HALF * KB;
    const size_t hstepB = (size_t)32 * KB;
    const size_t tstep = 2 * hstep;
    const unsigned ldsw = (unsigned)wid * 1024u;
    const int aoff = lds_byte(wr * 64 + fr, fq * 8), boff = lds_byte(wc * 32 + fr, fq * 8);
#define PG8_SA(b, h) (((b) * 2 + (h)) * HTB)
#define PG8_SB(b, h) ((4 + (b) * 2 + (h)) * HTB)
#define PG8_STAGE(bufoff, gbase, voff) do { _Pragma("unroll") for (int _i = 0; _i < 2; ++_i) \
        __builtin_amdgcn_global_load_lds((const unsigned*)((const char*)(gbase) + (voff)[_i]), (PG8_LAS unsigned*)(lds + (bufoff) + ldsw + _i * 8192), 16, 0, 0); } while (0)
#define PG8_LDA(dst, b, h) do { _Pragma("unroll") for (int m = 0; m < 4; ++m) _Pragma("unroll") for (int k = 0; k < 2; ++k) dst[m][k] = *(const PG8_LAS bf16x8*)(lds + PG8_SA(b, h) + aoff + m * 2048 + k * 1024); } while (0)
#define PG8_LDB(dst, b, h) do { _Pragma("unroll") for (int n = 0; n < 2; ++n) _Pragma("unroll") for (int k = 0; k < 2; ++k) dst[n][k] = *(const PG8_LAS bf16x8*)(lds + PG8_SB(b, h) + boff + n * 2048 + k * 1024); } while (0)
#define PG8_MMA(ai, bj, At, Bt) do { __builtin_amdgcn_s_setprio(1); _Pragma("unroll") for (int m = 0; m < 4; ++m) _Pragma("unroll") for (int n = 0; n < 2; ++n) _Pragma("unroll") for (int k = 0; k < 2; ++k) \
        { if constexpr (I8) acc[ai][bj][m][n] = __builtin_amdgcn_mfma_i32_16x16x64_i8(__builtin_bit_cast(i32x4, Bt[n][k]), __builtin_bit_cast(i32x4, At[m][k]), acc[ai][bj][m][n], 0, 0, 0); \
          else acc[ai][bj][m][n] = __builtin_amdgcn_mfma_f32_16x16x32_bf16(Bt[n][k], At[m][k], acc[ai][bj][m][n], 0, 0, 0); } __builtin_amdgcn_s_setprio(0); } while (0)
#define PG8_WAIT_V(n) asm volatile("s_waitcnt vmcnt(" #n ")" ::: "memory")
#define PG8_WAIT_L(n) asm volatile("s_waitcnt lgkmcnt(" #n ")" ::: "memory")
#define PG8_BAR __builtin_amdgcn_s_barrier()
#define PG8_SCHED __builtin_amdgcn_sched_barrier(0)
    Unit cur, nxt; int ui = 0;
    if (!S.next(0, cur)) return;
    acc_t acc[2][2][4][2];
#pragma unroll
    for (int a = 0; a < 2; ++a)
#pragma unroll
        for (int b = 0; b < 2; ++b)
#pragma unroll
            for (int m = 0; m < 4; ++m)
#pragma unroll
                for (int n = 0; n < 2; ++n) acc[a][b][m][n] = (acc_t){0, 0, 0, 0};
    bf16x8 At[4][2], B0[2][2], B1[2][2];
    const char* cA = (const char*)g.A + (size_t)cur.pm * tstep; const char* cB = (const char*)g.Bt + (size_t)cur.pn * tstep;
    S.a_ready(cur);
    if constexpr (SP2) {
        PG8_STAGE(PG8_SB(0, 0), cB, voffB); PG8_STAGE(PG8_SB(0, 1), cB + hstepB, voffB); PG8_STAGE(PG8_SA(0, 0), cA, voffA); PG8_STAGE(PG8_SA(0, 1), cA + hstep, voffA);
        if (wr == 1) PG8_BAR;
        PG8_WAIT_V(2); PG8_BAR;
        PG8_STAGE(PG8_SB(1, 0), cB + kstep, voffB); PG8_STAGE(PG8_SA(1, 0), cA + kstep, voffA); PG8_STAGE(PG8_SB(1, 1), cB + hstepB + kstep, voffB);
        PG8_WAIT_V(6); PG8_BAR;
    } else {
        PG8_STAGE(PG8_SB(0, 0), cB, voffB); PG8_STAGE(PG8_SA(0, 0), cA, voffA); PG8_STAGE(PG8_SB(0, 1), cB + hstepB, voffB); PG8_STAGE(PG8_SA(0, 1), cA + hstep, voffA);
        if (wr == 1) PG8_BAR;
        PG8_WAIT_V(4); PG8_BAR;
        PG8_STAGE(PG8_SB(1, 0), cB + kstep, voffB); PG8_STAGE(PG8_SA(1, 0), cA + kstep, voffA); PG8_STAGE(PG8_SB(1, 1), cB + hstepB + kstep, voffB);
        PG8_WAIT_V(6); PG8_BAR;
    }
    for (;;) {
        const bool has_next = S.next(ui + 1, nxt);
        const char* nA = has_next ? (const char*)g.A + (size_t)nxt.pm * tstep : cA; const char* nB = has_next ? (const char*)g.Bt + (size_t)nxt.pn * tstep : cB;
        for (int t = 0; t < nt; t += 2) {
            const bool last = (t == nt - 2);
            const char* a1 = cA + (size_t)(t + 1) * kstep;
            const char* a2 = last ? nA : cA + (size_t)(t + 2) * kstep; const char* b2 = last ? nB : cB + (size_t)(t + 2) * kstep;
            const char* a3 = a2 + kstep; const char* b3 = b2 + kstep;
            if (last && has_next) S.a_ready(nxt);
            if constexpr (SP2) {
            PG8_LDB(B0, 0, 0); PG8_LDB(B1, 0, 1); PG8_SCHED; PG8_LDA(At, 0, 0); PG8_STAGE(PG8_SA(1, 1), a1 + hstep, voffA);
            PG8_WAIT_V(8); PG8_WAIT_L(0); PG8_BAR; PG8_MMA(0, 0, At, B0); PG8_MMA(0, 1, At, B1); PG8_BAR; PG8_SCHED;
            PG8_LDA(At, 0, 1); PG8_STAGE(PG8_SB(0, 0), b2, voffB); PG8_STAGE(PG8_SB(0, 1), b2 + hstepB, voffB); PG8_STAGE(PG8_SA(0, 0), a2, voffA);
            PG8_WAIT_V(8); PG8_WAIT_L(0); PG8_BAR; PG8_MMA(1, 0, At, B0); PG8_MMA(1, 1, At, B1); PG8_BAR; PG8_SCHED;
            PG8_LDB(B0, 1, 0); PG8_LDB(B1, 1, 1); PG8_SCHED; PG8_LDA(At, 1, 0); PG8_STAGE(PG8_SA(0, 1), a2 + hstep, voffA);
            PG8_WAIT_V(8); PG8_WAIT_L(0); PG8_BAR; PG8_MMA(0, 0, At, B0); PG8_MMA(0, 1, At, B1); PG8_BAR; PG8_SCHED;
            PG8_LDA(At, 1, 1); PG8_STAGE(PG8_SB(1, 0), b3, voffB); PG8_STAGE(PG8_SB(1, 1), b3 + hstepB, voffB); PG8_STAGE(PG8_SA(1, 0), a3, voffA);
            PG8_WAIT_V(8); PG8_WAIT_L(0); PG8_BAR; PG8_MMA(1, 0, At, B0); PG8_MMA(1, 1, At, B1); PG8_BAR; PG8_SCHED;
            } else {
            PG8_LDB(B0, 0, 0); PG8_SCHED; PG8_LDA(At, 0, 0); PG8_STAGE(PG8_SA(1, 1), a1 + hstep, voffA);
            PG8_WAIT_L(8); PG8_BAR; PG8_WAIT_L(0); PG8_MMA(0, 0, At, B0); PG8_BAR; PG8_SCHED;
            PG8_LDB(B1, 0, 1); PG8_STAGE(PG8_SB(0, 0), b2, voffB);
            PG8_BAR; PG8_WAIT_L(0); PG8_MMA(0, 1, At, B1); PG8_BAR;
            PG8_LDA(At, 0, 1); PG8_STAGE(PG8_SA(0, 0), a2, voffA);
            PG8_BAR; PG8_WAIT_L(0); PG8_MMA(1, 0, At, B0); PG8_BAR; PG8_SCHED;
            PG8_STAGE(PG8_SB(0, 1), b2 + hstepB, voffB);
            PG8_WAIT_V(6); PG8_BAR; PG8_MMA(1, 1, At, B1); PG8_BAR;
            PG8_LDB(B0, 1, 0); PG8_SCHED; PG8_LDA(At, 1, 0); PG8_STAGE(PG8_SA(0, 1), a2 + hstep, voffA);
            PG8_WAIT_L(8); PG8_BAR; PG8_WAIT_L(0); PG8_MMA(0, 0, At, B0); PG8_BAR; PG8_SCHED;
            PG8_LDB(B1, 1, 1); PG8_STAGE(PG8_SB(1, 0), b3, voffB);
            PG8_BAR; PG8_WAIT_L(0); PG8_MMA(0, 1, At, B1); PG8_BAR;
            PG8_LDA(At, 1, 1); PG8_STAGE(PG8_SA(1, 0), a3, voffA);
            PG8_BAR; PG8_WAIT_L(0); PG8_MMA(1, 0, At, B0); PG8_BAR; PG8_SCHED;
            PG8_STAGE(PG8_SB(1, 1), b3 + hstepB, voffB);
            PG8_WAIT_V(6); PG8_BAR; PG8_MMA(1, 1, At, B1); PG8_BAR;
            }
        }
        if constexpr (ALIGN_EPI) { if (wr == 0) PG8_BAR; }
        E(acc, cur, wr, wc, fr, fq); S.done(cur);
        if (!has_next) break;
#pragma unroll
        for (int a = 0; a < 2; ++a)
#pragma unroll
            for (int b = 0; b < 2; ++b)
#pragma unroll
                for (int m = 0; m < 4; ++m)
#pragma unroll
                    for (int n = 0; n < 2; ++n) acc[a][b][m][n] = (acc_t){0, 0, 0, 0};
        cur = nxt; cA = nA; cB = nB; ++ui;
        if constexpr (ALIGN_EPI) { if (wr == 1) PG8_BAR; }
    }
    PG8_WAIT_V(0);
    if constexpr (!ALIGN_EPI) { if (wr == 0) PG8_BAR; }
    PG8_BAR;
#undef PG8_SA
#undef PG8_SB
#undef PG8_STAGE
#undef PG8_LDA
#undef PG8_LDB
#undef PG8_MMA
#undef PG8_WAIT_V
#undef PG8_WAIT_L
#undef PG8_BAR
#undef PG8_SCHED
}
}

struct Args { const float* in[21]; float* out; unsigned char* ws; int ph_lo, ph_hi, rep, pad; };
struct Frame0 { LAS unsigned char* lds; };
struct Frame {
    LAS unsigned char* lds; int tid, lane, wave, bid, nb;
    const float *x_prompt, *x_sample, *state, *cvec, *cctx, *w_in, *w_conv, *w_a, *w_gk, *b_gk, *w_gn, *w_b, *w_o, *w_ada, *b_ada, *ln_g, *ln_b, *w_pq, *pkeys, *peer_u, *peer_v;
    float* out; unsigned char* ws;
    float* MOD; bf16_t *WIN, *WA, *WB, *WO, *WPQ, *U16; unsigned char* V8; float* VS; float* XA; bf16_t *H, *Z1, *Z2, *Z3, *Z4; float* Z5;
};
typedef const __attribute__((address_space(4))) Args* KArgs;
__device__ __forceinline__ void fill_frame(Frame& F, const Frame0& F0) {
    auto kp = __builtin_amdgcn_kernarg_segment_ptr();
    asm volatile("" : "+s"(kp));
    KArgs A = (KArgs)kp;
    int t_ = threadIdx.x; asm volatile("" : "+v"(t_));
    F.lds = F0.lds; F.tid = t_; F.lane = t_ & 63; F.wave = __builtin_amdgcn_readfirstlane(t_ >> 6); F.bid = blockIdx.x; F.nb = gridDim.x;
    F.x_prompt = A->in[0]; F.x_sample = A->in[1]; F.state = A->in[2]; F.cvec = A->in[3]; F.cctx = A->in[4]; F.w_in = A->in[5]; F.w_conv = A->in[6]; F.w_a = A->in[7];
    F.w_gk = A->in[8]; F.b_gk = A->in[9]; F.w_gn = A->in[10]; F.w_b = A->in[11]; F.w_o = A->in[12]; F.w_ada = A->in[13]; F.b_ada = A->in[14]; F.ln_g = A->in[15]; F.ln_b = A->in[16];
    F.w_pq = A->in[17]; F.pkeys = A->in[18]; F.peer_u = A->in[19]; F.peer_v = A->in[20];
    F.out = A->out; unsigned char* ws = A->ws; F.ws = ws;
    F.MOD = (float*)(ws + WS_MOD); F.WIN = (bf16_t*)(ws + WS_WIN); F.WA = (bf16_t*)(ws + WS_WA); F.WB = (bf16_t*)(ws + WS_WB); F.WO = (bf16_t*)(ws + WS_WO); F.WPQ = (bf16_t*)(ws + WS_WPQ);
    F.U16 = (bf16_t*)(ws + WS_U16); F.V8 = ws + WS_V8; F.VS = (float*)(ws + WS_VS); F.XA = A->out; F.H = (bf16_t*)(ws + WS_H);
    F.Z1 = (bf16_t*)(ws + WS_Z1); F.Z2 = (bf16_t*)(ws + WS_Z2); F.Z3 = (bf16_t*)(ws + WS_Z3); F.Z4 = (bf16_t*)(ws + WS_Z4); F.Z5 = (float*)(ws + WS_Z5);
}
#define PHASE_IDS(F0_) Frame F; fill_frame(F, F0_)
__device__ __forceinline__ const float* xrow_in(const Frame& F, int l, int row) {
    if (l == 0) return row < TCTX ? F.x_prompt + (size_t)row * D : F.x_sample + (size_t)(row - TCTX) * D;
    return F.out + (size_t)row * D;
}
__device__ __forceinline__ int cond_of(int row) { return row < TCTX ? 8 : ((row - TCTX) >> 12); }

__device__ __forceinline__ void phase_mod(const Frame0& F0) {
    PHASE_IDS(F0);
    LAS float* sl = (LAS float*)F.lds;
    LAS float* red = (LAS float*)(F.lds + 73728);
    for (int i = F.tid; i < 9 * 2048; i += 512) { const int ci = i >> 11, dd = i & 2047; const float c = ci < 8 ? F.cvec[ci * 2048 + dd] : F.cctx[dd]; sl[i] = siluf_(c); }
    __syncthreads();
    const int cg = F.tid & 15, ks = F.tid >> 4;
    for (int u = F.bid; u < 2 * 192; u += F.nb) {
        const int l = u / 192, c0 = (u % 192) * 64;
        float acc[9][4];
#pragma unroll
        for (int ci = 0; ci < 9; ++ci)
#pragma unroll
            for (int j = 0; j < 4; ++j) acc[ci][j] = 0.f;
        const float* wp = F.w_ada + ((size_t)l * 2048 + ks * 64) * NADA + c0 + cg * 4;
#pragma unroll 4
        for (int r = 0; r < 64; ++r) {
            const float4 w = *(const float4*)(wp + (size_t)r * NADA);
#pragma unroll
            for (int ci = 0; ci < 9; ++ci) { const float s = sl[ci * 2048 + ks * 64 + r]; acc[ci][0] += s * w.x; acc[ci][1] += s * w.y; acc[ci][2] += s * w.z; acc[ci][3] += s * w.w; }
        }
#pragma unroll
        for (int ci = 0; ci < 9; ++ci)
#pragma unroll
            for (int j = 0; j < 4; ++j) { float v = acc[ci][j]; v += __shfl_xor(v, 16); v += __shfl_xor(v, 32); acc[ci][j] = v; }
        if (F.lane < 16) {
#pragma unroll
            for (int ci = 0; ci < 9; ++ci)
#pragma unroll
                for (int j = 0; j < 4; ++j) red[(F.wave * 9 + ci) * 64 + cg * 4 + j] = acc[ci][j];
        }
        __syncthreads();
        for (int i = F.tid; i < 576; i += 512) { const int ci = i >> 6, c = i & 63; float s = 0.f;
#pragma unroll
            for (int w = 0; w < 8; ++w) s += red[(w * 9 + ci) * 64 + c];
            F.MOD[(size_t)(l * 9 + ci) * NADA + c0 + c] = s + F.b_ada[l * NADA + c0 + c]; }
        __syncthreads();
    }
}
template <class Map>
__device__ __forceinline__ void tr_convert(const Frame0& F0, const float* src, int ldsrc, bf16_t* dst, int K, int N, Map map) {
    PHASE_IDS(F0);
    LAS bf16_t* tile = (LAS bf16_t*)F.lds;
    const int ntn = N / 64, ntk = K / 256;
    for (int u = F.bid; u < ntn * ntk; u += F.nb) {
        const int n0 = (u / ntk) * 64, k0 = (u % ntk) * 256;
        const int nn = F.tid & 63, kq = F.tid >> 6;
        const int sc = map(n0 + nn);
        float vals[32];
#pragma unroll
        for (int i = 0; i < 32; ++i) { const int kk = i * 8 + kq; vals[i] = sc >= 0 ? src[(size_t)(k0 + kk) * ldsrc + sc] : 0.f; }
#pragma unroll
        for (int i = 0; i < 32; ++i) tile[nn * 258 + i * 8 + kq] = f2bf(vals[i]);
        __syncthreads();
#pragma unroll
        for (int i = 0; i < 4; ++i) { const int id = F.tid + 512 * i, r = id >> 5, kc = id & 31; const LAS unsigned* p = (const LAS unsigned*)(tile + r * 258 + kc * 8);
            uint4 o; o.x = p[0]; o.y = p[1]; o.z = p[2]; o.w = p[3];
            *(uint4*)(dst + (size_t)(n0 + r) * K + k0 + kc * 8) = o; }
        __syncthreads();
    }
}
template <class Map>
__device__ __forceinline__ void tr_strip8(const Frame& F, const float* src, int ldsrc, unsigned char* dst, float* scales, int K, int n0, Map map) {
    LAS unsigned char* tile = (LAS unsigned char*)F.lds;
    LAS float* red = (LAS float*)(F.lds + 64 * 272);
    const int nn = F.tid & 63, kq = F.tid >> 6;
    const int sc = map(n0 + nn);
    float m = 0.f;
    for (int i0 = 0; i0 < K / 8; i0 += 64) {
        float vals[64];
#pragma unroll
        for (int i = 0; i < 64; ++i) vals[i] = sc >= 0 ? src[(size_t)((i0 + i) * 8 + kq) * ldsrc + sc] : 0.f;
#pragma unroll
        for (int i = 0; i < 64; ++i) m = fmaxf(m, fabsf(vals[i]));
    }
    __syncthreads();
    red[kq * 64 + nn] = m;
    __syncthreads();
    if (F.tid < 64) { float mm = 0.f;
#pragma unroll
        for (int q = 0; q < 8; ++q) mm = fmaxf(mm, red[q * 64 + F.tid]);
        const float scl = mm > 0.f ? mm * (1.f / 127.f) : 1.f; scales[n0 + F.tid] = scl; red[512 + F.tid] = 1.f / scl; }
    __syncthreads();
    const float inv = red[512 + nn];
    for (int k0 = 0; k0 < K; k0 += 256) {
        float vals[32];
#pragma unroll
        for (int i = 0; i < 32; ++i) vals[i] = sc >= 0 ? src[(size_t)(k0 + i * 8 + kq) * ldsrc + sc] : 0.f;
#pragma unroll
        for (int i = 0; i < 32; ++i) tile[nn * 272 + i * 8 + kq] = (unsigned char)(__float2int_rn(vals[i] * inv) & 255);
        __syncthreads();
#pragma unroll
        for (int i = 0; i < 2; ++i) { const int id = F.tid + 512 * i, r = id >> 4, kc = id & 15; const u32x4 o = *(const LAS u32x4*)(tile + r * 272 + kc * 16);
            *(u32x4*)(dst + (size_t)(n0 + r) * K + k0 + kc * 16) = o; }
        __syncthreads();
    }
}
struct MapId { __device__ __forceinline__ int operator()(int n) const { return n; } };
struct MapInOff { int off; __device__ __forceinline__ int operator()(int n) const { n += off; return n < 9216 ? n : (n < 13312 ? n + 32 : (n < 13344 ? n - 13312 + 9216 : -1)); } };
struct MapIn { __device__ __forceinline__ int operator()(int n) const { return n < 9216 ? n : (n < 13312 ? n + 32 : (n < 13344 ? n - 13312 + 9216 : -1)); } };
__device__ __forceinline__ void conv_tables(const Frame0& F0, int l) {
    PHASE_IDS(F0);
    for (int e = F.bid * 8 + F.wave; e < 16384; e += F.nb * 8) {
        const float* s = F.peer_v + ((size_t)l * 16384 + e) * 2048;
        float4 v[8]; float m = 0.f;
#pragma unroll
        for (int i = 0; i < 8; ++i) { v[i] = *(const float4*)(s + i * 256 + F.lane * 4); m = fmaxf(m, fmaxf(fmaxf(fabsf(v[i].x), fabsf(v[i].y)), fmaxf(fabsf(v[i].z), fabsf(v[i].w)))); }
#pragma unroll
        for (int sh = 32; sh >= 1; sh >>= 1) m = fmaxf(m, __shfl_xor(m, sh));
        const float sc = m > 0.f ? m * (1.f / 127.f) : 1.f, inv = 1.f / sc;
#pragma unroll
        for (int i = 0; i < 8; ++i) *(unsigned*)(F.V8 + (size_t)e * 2048 + i * 256 + F.lane * 4) = pack_i8(v[i].x * inv, v[i].y * inv, v[i].z * inv, v[i].w * inv);
        if (F.lane == 0) F.VS[e] = sc;
    }
    for (int e = F.bid * 8 + F.wave; e < 16384; e += F.nb * 8) {
        const float* s = F.peer_u + ((size_t)l * 16384 + e) * 2048;
        float m = 0.f;
#pragma unroll
        for (int i = 0; i < 8; ++i) { const float4 v = *(const float4*)(s + i * 256 + F.lane * 4); m = fmaxf(m, fmaxf(fmaxf(fabsf(v.x), fabsf(v.y)), fmaxf(fabsf(v.z), fabsf(v.w)))); }
        m = wmax(m);
        if (F.lane == 0) F.VS[16384 + e] = m > 0.f ? m * (1.f / 127.f) : 1.f;
    }
}
__device__ __forceinline__ void phase_prologue(const Frame0& F0) {
    phase_mod(F0);
    {
        PHASE_IDS(F0);
        for (int sidx = F.bid; sidx < 2 * 276; sidx += F.nb) {
            const int l = sidx / 276, r = sidx % 276;
            if (r < 212) tr_strip8(F, F.w_in + (size_t)l * 2048 * 13344, 13344, F.ws + WS_W8IN + (size_t)l * NINP * 2048, (float*)(F.ws + WS_CSIN) + (size_t)l * NINP, 2048, r * 64, MapIn());
            else if (r < 244) tr_strip8(F, F.w_b + (size_t)l * 2048 * 2048, 2048, (unsigned char*)F.WB + (size_t)l * 2048 * 2048, (float*)((unsigned char*)F.WB + (size_t)2 * 2048 * 2048) + l * 2048, 2048, (r - 212) * 64, MapId());
            else tr_strip8(F, F.w_pq + (size_t)l * 2048 * 2048, 2048, (unsigned char*)F.WPQ + (size_t)l * 2048 * 2048, (float*)((unsigned char*)F.WPQ + (size_t)2 * 2048 * 2048) + l * 2048, 2048, (r - 244) * 64, MapId());
        }
    }
    for (int l = 0; l < 2; ++l) {
        Frame P; fill_frame(P, F0);
        tr_convert(F0, P.w_in + (size_t)l * 2048 * 13344, 13344, P.WIN + ((size_t)l * NINP + 4096) * 2048, 2048, 3072, MapInOff{4096});
        tr_convert(F0, P.w_in + (size_t)l * 2048 * 13344, 13344, P.WIN + ((size_t)l * NINP + 13312) * 2048, 2048, 256, MapInOff{13312});
        tr_convert(F0, P.w_a + (size_t)l * 1024 * 2048, 2048, P.WA + (size_t)l * 2048 * 1024, 1024, 2048, MapId());
        tr_convert(F0, P.w_o + (size_t)l * 2048 * 2048, 2048, P.WO + (size_t)l * 2048 * 2048, 2048, 2048, MapId());
    }
}

__device__ __forceinline__ void phase_lnmod(const Frame0& F0, int l) {
    PHASE_IDS(F0);
    const int stride = F.nb * 8;
    int row = F.bid * 8 + F.wave;
    float4 v[8], shv[8], scv[8]; int cci = -1;
    if (row < T) { const float* xr = xrow_in(F, l, row);
#pragma unroll
        for (int i = 0; i < 8; ++i) v[i] = *(const float4*)(xr + i * 256 + F.lane * 4); }
    for (; row < T; row += stride) {
        float4 vn[8];
        const int nrow = row + stride;
        if (nrow < T) { const float* xn = xrow_in(F, l, nrow);
#pragma unroll
            for (int i = 0; i < 8; ++i) vn[i] = *(const float4*)(xn + i * 256 + F.lane * 4); }
        else {
#pragma unroll
            for (int i = 0; i < 8; ++i) vn[i] = v[i]; }
        const int ci = cond_of(row);
        if (ci != cci) { const float* md = F.MOD + (size_t)(l * 9 + ci) * NADA; cci = ci;
#pragma unroll
            for (int i = 0; i < 8; ++i) { shv[i] = *(const float4*)(md + i * 256 + F.lane * 4); scv[i] = *(const float4*)(md + 2048 + i * 256 + F.lane * 4); } }
        float s = 0.f;
#pragma unroll
        for (int i = 0; i < 8; ++i) s += (v[i].x + v[i].y) + (v[i].z + v[i].w);
        const float mean = wsum(s) * (1.f / 2048.f);
        float q = 0.f;
#pragma unroll
        for (int i = 0; i < 8; ++i) { const float a = v[i].x - mean, b = v[i].y - mean, c = v[i].z - mean, d = v[i].w - mean; q += (a * a + b * b) + (c * c + d * d); }
        const float rstd = rsqrtf(wsum(q) * (1.f / 2048.f) + LN_EPS);
        float am = 0.f;
#pragma unroll
        for (int i = 0; i < 8; ++i) { const int col = i * 256 + F.lane * 4;
            const float4 sh = shv[i], sc = scv[i];
            const float y0 = (v[i].x - mean) * rstd * (1.f + sc.x) + sh.x, y1 = (v[i].y - mean) * rstd * (1.f + sc.y) + sh.y;
            const float y2 = (v[i].z - mean) * rstd * (1.f + sc.z) + sh.z, y3 = (v[i].w - mean) * rstd * (1.f + sc.w) + sh.w;
            if (row < TCTX) { u32x2 o; o.x = cvt_pk_bf16(y0, y1); o.y = cvt_pk_bf16(y2, y3); *(u32x2*)(F.H + (size_t)row * D + col) = o; }
            v[i].x = y0; v[i].y = y1; v[i].z = y2; v[i].w = y3; am = fmaxf(am, fmaxf(fmaxf(fabsf(y0), fabsf(y1)), fmaxf(fabsf(y2), fabsf(y3)))); }
        am = wmax(am);
        const float hs = am > 0.f ? am * (1.f / 127.f) : 1.f, hinv = 1.f / hs;
#pragma unroll
        for (int i = 0; i < 8; ++i) *(unsigned*)(F.ws + WS_H8IN + (size_t)row * D + i * 256 + F.lane * 4) = pack_i8(v[i].x * hinv, v[i].y * hinv, v[i].z * hinv, v[i].w * hinv);
        if (F.lane == 0) ((float*)(F.ws + WS_HSIN))[row] = hs;
#pragma unroll
        for (int i = 0; i < 8; ++i) v[i] = vn[i];
    }
}

__device__ __forceinline__ unsigned dpp_ror8(unsigned x) { return (unsigned)__builtin_amdgcn_update_dpp(0, (int)x, 0x128, 0xf, 0xf, true); }
__device__ __forceinline__ void store_rows128(bf16_t* base, size_t ld, int fr, int fq, const u32x4 w0, const u32x4 w1) {
    const bool lo = fr < 8;
    u32x4 a, b;
#pragma unroll
    for (int j = 0; j < 4; ++j) { const unsigned t0 = dpp_ror8(w0[j]), t1 = dpp_ror8(w1[j]); a[j] = lo ? w0[j] : t1; b[j] = lo ? t0 : w1[j]; }
    bf16_t* p = base + (size_t)(fr & 7) * ld + (lo ? 0 : 32) + 8 * fq;
#if STORE_POLICY == 1
    __builtin_nontemporal_store(a, (u32x4*)p); __builtin_nontemporal_store(b, (u32x4*)(p + 8 * ld));
#elif STORE_POLICY == 2
    asm volatile("global_store_dwordx4 %0, %1, off sc1" :: "v"(p), "v"(a) : "memory"); asm volatile("global_store_dwordx4 %0, %1, off sc1" :: "v"(p + 8 * ld), "v"(b) : "memory");
#elif STORE_POLICY == 3
    asm volatile("global_store_dwordx4 %0, %1, off sc0 sc1" :: "v"(p), "v"(a) : "memory"); asm volatile("global_store_dwordx4 %0, %1, off sc0 sc1" :: "v"(p + 8 * ld), "v"(b) : "memory");
#else
    *(u32x4*)p = a; *(u32x4*)(p + 8 * ld) = b;
#endif
}
__device__ __forceinline__ void store_rows128_f32(float* base, size_t ld, int fr, int fq, const f32x4 v0, const f32x4 v1) {
    const bool lo = fr < 8;
    f32x4 a, b;
#pragma unroll
    for (int j = 0; j < 4; ++j) { const float t0 = __uint_as_float(dpp_ror8(__float_as_uint(v0[j]))), t1 = __uint_as_float(dpp_ror8(__float_as_uint(v1[j]))); a[j] = lo ? v0[j] : t1; b[j] = lo ? t0 : v1[j]; }
    float* p = base + (size_t)(fr & 7) * ld + (lo ? 0 : 16) + 4 * fq;
    *(f32x4*)p = a; *(f32x4*)(p + 8 * ld) = b;
}
__device__ __forceinline__ float4 ld_bf4(const bf16_t* p) { const u32x2 w = *(const u32x2*)p; float4 r; r.x = __uint_as_float(w.x << 16); r.y = __uint_as_float(w.x & 0xffff0000u); r.z = __uint_as_float(w.y << 16); r.w = __uint_as_float(w.y & 0xffff0000u); return r; }
__device__ __forceinline__ u32x4 pack8(const f32x4 v0, const f32x4 v1) { u32x4 w; w.x = cvt_pk_bf16(v0[0], v0[1]); w.y = cvt_pk_bf16(v0[2], v0[3]); w.z = cvt_pk_bf16(v1[0], v1[1]); w.w = cvt_pk_bf16(v1[2], v1[3]); return w; }
struct EpiIn {
    static constexpr bool PERM = true;
    bf16_t *Z1, *ZQ, *ZK, *ZV, *Z3, *GA, *GB; float* Z5;
    __device__ __forceinline__ void operator()(const f32x4 (&acc)[2][2][4][2], const pg8::Unit& u, int wr, int wc, int fr0, int fq0) const {
        int fr = fr0, fq = fq0; asm volatile("" : "+v"(fr), "+v"(fq));
        const int rw = u.pm * 256 + wr * 64;
        if (u.pn < 52) {
            bf16_t* base; int ld, c;
            const int colt = u.pn * 256;
            if (u.pn < 12) { base = Z1; ld = 3072; c = colt; }
            else if (u.pn < 16) { base = ZQ; ld = 1024; c = colt - 3072; }
            else if (u.pn < 20) { base = ZK; ld = 1024; c = colt - 4096; }
            else if (u.pn < 28) { base = ZV; ld = 2048; c = colt - 5120; }
            else if (u.pn < 36) { base = Z3; ld = 2048; c = colt - 7168; }
            else if (u.pn < 44) { base = GA; ld = 2048; c = colt - 9216; }
            else { base = GB; ld = 2048; c = colt - 11264; }
#pragma unroll
            for (int ai = 0; ai < 2; ++ai)
#pragma unroll
                for (int m = 0; m < 4; ++m)
                    store_rows128(base + (size_t)(rw + ai * 128 + m * 16) * ld + c + wc * 64, (size_t)ld, fr, fq, pack8(acc[ai][0][m][0], acc[ai][0][m][1]), pack8(acc[ai][1][m][0], acc[ai][1][m][1]));
        } else if (wc == 0) {
#pragma unroll
            for (int ai = 0; ai < 2; ++ai)
#pragma unroll
                for (int m = 0; m < 4; ++m) { float* rowp = Z5 + (size_t)(rw + fr + ai * 128 + m * 16) * 32 + 8 * fq;
                    *(f32x4*)(rowp) = acc[ai][0][m][0]; *(f32x4*)(rowp + 4) = acc[ai][0][m][1]; }
        }
    }
};
struct SubsetOrder {
    int mode, G, c;
    __device__ __forceinline__ bool next(int i, pg8::Unit& u) const {
        const long L = (long)i * G + c;
        if (mode == 0) { if (L >= 208) return false; const int k = (int)L >> 4; u.pm = (int)L & 15; u.pn = k < 12 ? 16 + k : 52; return true; }
        if (L >= 7424) return false;
        const int w = ((int)L & 7) * 928 + ((int)L >> 3);
        if (w < 6784) { const int r = w % 424; u.pm = 16 + (w / 424) * 8 + (r & 7); u.pn = r >> 3; }
        else { const int v = w - 6784, q = v >> 4; u.pm = v & 15; u.pn = q < 16 ? q : q + 12; }
        return true;
    }
    __device__ __forceinline__ void a_ready(const pg8::Unit&) const {}
    __device__ __forceinline__ void done(const pg8::Unit&) const {}
};
struct EpiInS {
    static constexpr bool PERM = true;
    bf16_t *Z1, *ZQ, *ZK, *ZV, *Z3, *GA, *GB; float* Z5; const float* RS; const float* CS;
    __device__ __forceinline__ void operator()(const i32x4 (&acc)[2][2][4][2], const pg8::Unit& u, int wr, int wc, int fr0, int fq0) const {
        int fr = fr0, fq = fq0; asm volatile("" : "+v"(fr), "+v"(fq));
        const int rw = u.pm * 256 + wr * 64;
        const int colt = u.pn * 256;
        f32x4 cs[2][2];
#pragma unroll
        for (int bj = 0; bj < 2; ++bj)
#pragma unroll
            for (int n = 0; n < 2; ++n) cs[bj][n] = *(const f32x4*)(CS + colt + wc * 64 + bj * 32 + 8 * fq + 4 * n);
        if (u.pn < 52) {
            bf16_t* base; int ld, c;
            if (u.pn < 12) { base = Z1; ld = 3072; c = colt; }
            else if (u.pn < 16) { base = ZQ; ld = 1024; c = colt - 3072; }
            else if (u.pn < 20) { base = ZK; ld = 1024; c = colt - 4096; }
            else if (u.pn < 28) { base = ZV; ld = 2048; c = colt - 5120; }
            else if (u.pn < 36) { base = Z3; ld = 2048; c = colt - 7168; }
            else if (u.pn < 44) { base = GA; ld = 2048; c = colt - 9216; }
            else { base = GB; ld = 2048; c = colt - 11264; }
#pragma unroll
            for (int ai = 0; ai < 2; ++ai)
#pragma unroll
                for (int m = 0; m < 4; ++m) { const float rs = RS[rw + ai * 128 + m * 16 + fr]; f32x4 v[2][2];
#pragma unroll
                    for (int bj = 0; bj < 2; ++bj)
#pragma unroll
                        for (int n = 0; n < 2; ++n)
#pragma unroll
                            for (int j = 0; j < 4; ++j) v[bj][n][j] = (float)acc[ai][bj][m][n][j] * rs * cs[bj][n][j];
                    store_rows128(base + (size_t)(rw + ai * 128 + m * 16) * ld + c + wc * 64, (size_t)ld, fr, fq, pack8(v[0][0], v[0][1]), pack8(v[1][0], v[1][1])); }
        } else if (wc == 0) {
#pragma unroll
            for (int ai = 0; ai < 2; ++ai)
#pragma unroll
                for (int m = 0; m < 4; ++m) { const float rs = RS[rw + ai * 128 + m * 16 + fr]; float* rowp = Z5 + (size_t)(rw + fr + ai * 128 + m * 16) * 32 + 8 * fq; f32x4 v0, v1;
#pragma unroll
                    for (int j = 0; j < 4; ++j) { v0[j] = (float)acc[ai][0][m][0][j] * rs * cs[0][0][j]; v1[j] = (float)acc[ai][0][m][1][j] * rs * cs[0][1][j]; }
                    *(f32x4*)(rowp) = v0; *(f32x4*)(rowp + 4) = v1; }
        }
    }
};
struct EpiA {
    static constexpr bool PERM = true;
    const bf16_t* Z4; bf16_t* Y;
    __device__ __forceinline__ void operator()(const f32x4 (&acc)[2][2][4][2], const pg8::Unit& u, int wr, int wc, int fr0, int fq0) const {
        int fr = fr0, fq = fq0; asm volatile("" : "+v"(fr), "+v"(fq));
        const int rw = u.pm * 256 + wr * 64, cw = u.pn * 256 + wc * 64;
#pragma unroll
        for (int ai = 0; ai < 2; ++ai)
#pragma unroll
            for (int m = 0; m < 4; ++m) { const size_t row = (size_t)(rw + fr + ai * 128 + m * 16);
                u32x4 w[2];
#pragma unroll
                for (int bj = 0; bj < 2; ++bj) { const int col = cw + bj * 32 + 8 * fq;
                    const u32x4 g = *(const u32x4*)(Z4 + row * 2048 + col);
                    const f32x4 v0 = acc[ai][bj][m][0], v1 = acc[ai][bj][m][1];
                    w[bj].x = cvt_pk_bf16(sigmoidf_(bf_lo(g.x)) * v0[0], sigmoidf_(bf_hi(g.x)) * v0[1]);
                    w[bj].y = cvt_pk_bf16(sigmoidf_(bf_lo(g.y)) * v0[2], sigmoidf_(bf_hi(g.y)) * v0[3]);
                    w[bj].z = cvt_pk_bf16(sigmoidf_(bf_lo(g.z)) * v1[0], sigmoidf_(bf_hi(g.z)) * v1[1]);
                    w[bj].w = cvt_pk_bf16(sigmoidf_(bf_lo(g.w)) * v1[2], sigmoidf_(bf_hi(g.w)) * v1[3]); }
                store_rows128(Y + (size_t)(rw + ai * 128 + m * 16) * 2048 + cw, 2048, fr, fq, w[0], w[1]); }
    }
};
struct EpiB {
    static constexpr bool PERM = true;
    const bf16_t* Z4; bf16_t* Y;
    __device__ __forceinline__ void operator()(const f32x4 (&acc)[2][2][4][2], const pg8::Unit& u, int wr, int wc, int fr0, int fq0) const {
        int fr = fr0, fq = fq0; asm volatile("" : "+v"(fr), "+v"(fq));
        const int rw = u.pm * 256 + wr * 64, cw = u.pn * 256 + wc * 64;
#pragma unroll
        for (int ai = 0; ai < 2; ++ai)
#pragma unroll
            for (int m = 0; m < 4; ++m) { const size_t row = (size_t)(rw + fr + ai * 128 + m * 16);
                u32x4 w[2];
#pragma unroll
                for (int bj = 0; bj < 2; ++bj) { const int col = cw + bj * 32 + 8 * fq;
                    const u32x4 g = *(const u32x4*)(Z4 + row * 2048 + col);
                    const u32x4 y = *(const u32x4*)(Y + row * 2048 + col);
                    const f32x4 v0 = acc[ai][bj][m][0], v1 = acc[ai][bj][m][1];
                    w[bj].x = cvt_pk_bf16(bf_lo(y.x) + sigmoidf_(bf_lo(g.x)) * v0[0], bf_hi(y.x) + sigmoidf_(bf_hi(g.x)) * v0[1]);
                    w[bj].y = cvt_pk_bf16(bf_lo(y.y) + sigmoidf_(bf_lo(g.y)) * v0[2], bf_hi(y.y) + sigmoidf_(bf_hi(g.y)) * v0[3]);
                    w[bj].z = cvt_pk_bf16(bf_lo(y.z) + sigmoidf_(bf_lo(g.z)) * v1[0], bf_hi(y.z) + sigmoidf_(bf_hi(g.z)) * v1[1]);
                    w[bj].w = cvt_pk_bf16(bf_lo(y.w) + sigmoidf_(bf_lo(g.w)) * v1[2], bf_hi(y.w) + sigmoidf_(bf_hi(g.w)) * v1[3]); }
                store_rows128(Y + (size_t)(rw + ai * 128 + m * 16) * 2048 + cw, 2048, fr, fq, w[0], w[1]); }
    }
};
struct EpiO {
    static constexpr bool PERM = true;
    const float *xp, *xs, *xo; const float* MODl; bf16_t* T1; int l;
    __device__ __forceinline__ void operator()(const f32x4 (&acc)[2][2][4][2], const pg8::Unit& u, int wr, int wc, int fr0, int fq0) const {
        int fr = fr0, fq = fq0; asm volatile("" : "+v"(fr), "+v"(fq));
        const int cw = u.pn * 256 + wc * 64;
        const int rbase = u.pm * 256;
        const float* g1 = MODl + (size_t)cond_of(rbase) * NADA + 2 * 2048;
        const float* xb = (l == 0) ? (rbase < TCTX ? xp + (size_t)rbase * D : xs + (size_t)(rbase - TCTX) * D) : xo + (size_t)rbase * D;
#pragma unroll
        for (int ai = 0; ai < 2; ++ai)
#pragma unroll
            for (int m = 0; m < 4; ++m) { const int rl0 = wr * 64 + ai * 128 + m * 16, rl = rl0 + fr; u32x4 w[2];
#pragma unroll
                for (int bj = 0; bj < 2; ++bj) { f32x4 r[2]; const int col = cw + bj * 32 + 8 * fq;
#pragma unroll
                    for (int n = 0; n < 2; ++n) {
                        const f32x4 xv = *(const f32x4*)(xb + (size_t)rl * D + col + 4 * n);
                        const f32x4 gvv = *(const f32x4*)(g1 + col + 4 * n);
                        r[n] = xv * ALPHA + gvv * acc[ai][bj][m][n]; }
                    w[bj] = pack8(r[0], r[1]); }
                store_rows128(T1 + (size_t)(rbase + rl0) * D + cw, (size_t)D, fr, fq, w[0], w[1]);
                __builtin_amdgcn_sched_barrier(0); }
    }
};
struct EpiPlain {
    static constexpr bool PERM = true;
    bf16_t* O; int ld;
    __device__ __forceinline__ void operator()(const f32x4 (&acc)[2][2][4][2], const pg8::Unit& u, int wr, int wc, int fr0, int fq0) const {
        int fr = fr0, fq = fq0; asm volatile("" : "+v"(fr), "+v"(fq));
        const int rw = u.pm * 256 + wr * 64, cw = u.pn * 256 + wc * 64;
#pragma unroll
        for (int ai = 0; ai < 2; ++ai)
#pragma unroll
            for (int m = 0; m < 4; ++m)
                store_rows128(O + (size_t)(rw + ai * 128 + m * 16) * ld + cw, (size_t)ld, fr, fq, pack8(acc[ai][0][m][0], acc[ai][0][m][1]), pack8(acc[ai][1][m][0], acc[ai][1][m][1]));
    }
};
struct EpiPlainS {
    static constexpr bool PERM = true;
    bf16_t* O; int ld; const float* RS; const float* CS;
    __device__ __forceinline__ void operator()(const i32x4 (&acc)[2][2][4][2], const pg8::Unit& u, int wr, int wc, int fr0, int fq0) const {
        int fr = fr0, fq = fq0; asm volatile("" : "+v"(fr), "+v"(fq));
        const int rw = u.pm * 256 + wr * 64, cw = u.pn * 256 + wc * 64;
        f32x4 cs[2][2];
#pragma unroll
        for (int bj = 0; bj < 2; ++bj)
#pragma unroll
            for (int n = 0; n < 2; ++n) cs[bj][n] = *(const f32x4*)(CS + cw + bj * 32 + 8 * fq + 4 * n);
#pragma unroll
        for (int ai = 0; ai < 2; ++ai)
#pragma unroll
            for (int m = 0; m < 4; ++m) { const float rs = RS[rw + ai * 128 + m * 16 + fr]; f32x4 v[2][2];
#pragma unroll
                for (int bj = 0; bj < 2; ++bj)
#pragma unroll
                    for (int n = 0; n < 2; ++n)
#pragma unroll
                        for (int j = 0; j < 4; ++j) v[bj][n][j] = (float)acc[ai][bj][m][n][j] * rs * cs[bj][n][j];
                store_rows128(O + (size_t)(rw + ai * 128 + m * 16) * ld + cw, (size_t)ld, fr, fq, pack8(v[0][0], v[0][1]), pack8(v[1][0], v[1][1])); }
    }
};
struct EpiBS {
    static constexpr bool PERM = true;
    const bf16_t* Z4; bf16_t* Y; const float* RS; const float* CS;
    __device__ __forceinline__ void operator()(const i32x4 (&acc)[2][2][4][2], const pg8::Unit& u, int wr, int wc, int fr0, int fq0) const {
        int fr = fr0, fq = fq0; asm volatile("" : "+v"(fr), "+v"(fq));
        const int rw = u.pm * 256 + wr * 64, cw = u.pn * 256 + wc * 64;
        f32x4 cs[2][2];
#pragma unroll
        for (int bj = 0; bj < 2; ++bj)
#pragma unroll
            for (int n = 0; n < 2; ++n) cs[bj][n] = *(const f32x4*)(CS + cw + bj * 32 + 8 * fq + 4 * n);
#pragma unroll
        for (int ai = 0; ai < 2; ++ai)
#pragma unroll
            for (int m = 0; m < 4; ++m) { const size_t row = (size_t)(rw + fr + ai * 128 + m * 16); const float rs = RS[row];
                u32x4 w[2];
#pragma unroll
                for (int bj = 0; bj < 2; ++bj) { const int col = cw + bj * 32 + 8 * fq;
                    const u32x4 g = *(const u32x4*)(Z4 + row * 2048 + col);
                    const u32x4 y = *(const u32x4*)(Y + row * 2048 + col);
                    f32x4 v0, v1;
#pragma unroll
                    for (int j = 0; j < 4; ++j) { v0[j] = (float)acc[ai][bj][m][0][j] * rs * cs[bj][0][j]; v1[j] = (float)acc[ai][bj][m][1][j] * rs * cs[bj][1][j]; }
                    w[bj].x = cvt_pk_bf16(bf_lo(y.x) + sigmoidf_(bf_lo(g.x)) * v0[0], bf_hi(y.x) + sigmoidf_(bf_hi(g.x)) * v0[1]);
                    w[bj].y = cvt_pk_bf16(bf_lo(y.y) + sigmoidf_(bf_lo(g.y)) * v0[2], bf_hi(y.y) + sigmoidf_(bf_hi(g.y)) * v0[3]);
                    w[bj].z = cvt_pk_bf16(bf_lo(y.z) + sigmoidf_(bf_lo(g.z)) * v1[0], bf_hi(y.z) + sigmoidf_(bf_hi(g.z)) * v1[1]);
                    w[bj].w = cvt_pk_bf16(bf_lo(y.w) + sigmoidf_(bf_lo(g.w)) * v1[2], bf_hi(y.w) + sigmoidf_(bf_hi(g.w)) * v1[3]); }
                store_rows128(Y + (size_t)(rw + ai * 128 + m * 16) * 2048 + cw, 2048, fr, fq, w[0], w[1]); }
    }
};
template <class Epi, bool I8 = false>
__device__ __forceinline__ void run_gemm(const Frame& F, const bf16_t* A, const bf16_t* Bt, int N, int K, const Epi& E) {
    pg8::Gemm g{A, Bt, T, N, K}; pg8::StaticOrder S; S.init(T, N, F.nb, F.bid);
    pg8::gemm_phase<Epi, pg8::StaticOrder, true, true, I8>(F.lds, g, S, E);
}
#define B_ZQ(F) ((F).Z2)
#define B_ZK(F) ((F).Z2 + (size_t)T * 1024)
#define B_ZV(F) ((F).Z2 + (size_t)T * 2048)
#define B_GA(F) ((F).Z4)
#define B_GB(F) ((F).Z4 + (size_t)T * 2048)
#define B_Y(F)  ((F).Z1 + (size_t)T * 1024)
#define B_QDF(F) ((F).H)
#define B_KDF(F) ((F).H + (size_t)T * 1024)
#define B_QDB(F) ((F).H + (size_t)T * 2048)
#define B_KDB(F) ((F).Z4)
#define B_DEC(F) ((float*)((F).Z4 + (size_t)T * 1024))
#define B_OF(F) ((F).Z2)
#define B_BIN(F) ((F).H)
#define B_QQ(F) ((F).Z2 + (size_t)T * 2048)
#define B_T1(F) ((F).Z4 + (size_t)T * 2048)
__device__ __forceinline__ void phase_gemm_in(const Frame0& F0, int l) {
    {
        PHASE_IDS(F0); EpiIn E{F.Z1, B_ZQ(F), B_ZK(F), B_ZV(F), F.Z3, B_GA(F), B_GB(F), F.Z5};
        pg8::Gemm g{F.H, F.WIN + (size_t)l * NINP * 2048, T, NINP, 2048}; SubsetOrder S{0, F.nb, F.bid};
        pg8::gemm_phase<EpiIn, SubsetOrder, true, true, false>(F.lds, g, S, E); }
    {
        PHASE_IDS(F0); EpiInS E{F.Z1, B_ZQ(F), B_ZK(F), B_ZV(F), F.Z3, B_GA(F), B_GB(F), F.Z5, (const float*)(F.ws + WS_HSIN), (const float*)(F.ws + WS_CSIN) + (size_t)l * NINP};
        pg8::Gemm g{(const bf16_t*)(F.ws + WS_H8IN), (const bf16_t*)(F.ws + WS_W8IN + (size_t)l * NINP * 2048), T, NINP, 2048}; SubsetOrder S{1, F.nb, F.bid};
        pg8::gemm_phase<EpiInS, SubsetOrder, true, true, true>(F.lds, g, S, E); }
}
__device__ __forceinline__ void phase_gemm_a(const Frame0& F0, int l) { PHASE_IDS(F0); EpiA E{B_GA(F), B_Y(F)}; run_gemm(F, F.H, F.WA + (size_t)l * 2048 * 1024, 2048, 1024, E); }
__device__ __forceinline__ void phase_gemm_b(const Frame0& F0, int l) { PHASE_IDS(F0);
    EpiBS E{B_GB(F), B_Y(F), F.VS + 110592, (const float*)((const unsigned char*)F.WB + (size_t)2 * 2048 * 2048) + l * 2048};
    run_gemm<EpiBS, true>(F, B_BIN(F), (const bf16_t*)((const unsigned char*)F.WB + (size_t)l * 2048 * 2048), 2048, 2048, E); }
__device__ __forceinline__ void phase_gemm_o(const Frame0& F0, int l) { PHASE_IDS(F0); EpiO E{F.x_prompt, F.x_sample, F.out, F.MOD + (size_t)l * 9 * NADA, B_T1(F), l}; run_gemm(F, B_Y(F), F.WO + (size_t)l * 2048 * 2048, 2048, 2048, E); }
__device__ __forceinline__ void phase_gemm_pq(const Frame0& F0, int l) { PHASE_IDS(F0);
    EpiPlainS E{B_QQ(F), 2048, F.VS + 32768, (const float*)((const unsigned char*)F.WPQ + (size_t)2 * 2048 * 2048) + l * 2048};
    run_gemm<EpiPlainS, true>(F, (const bf16_t*)((const unsigned char*)F.Z3 + ((size_t)64 << 20)), (const bf16_t*)((const unsigned char*)F.WPQ + (size_t)l * 2048 * 2048), 2048, 2048, E); }

__device__ __forceinline__ void phase_conv(const Frame0& F0, int l) {
    PHASE_IDS(F0);
    const bf16_t* Z1 = F.Z1; bf16_t* AIN = F.H;
    const size_t gth = (size_t)F.nb * 512;
    for (size_t it = (size_t)F.bid * 512 + F.tid; it < (size_t)T * 128; it += gth) {
        const int t = (int)(it >> 7), ch = (int)(it & 127) * 8;
        int dlt; bool vm, vp;
        if (t < TCTX) { const int pos = t & 255; dlt = 1; vm = pos > 0; vp = pos < 255; }
        else { const int tau = (t - TCTX) & 4095;
            if (ch < 512) { dlt = 1; vm = (tau & 63) > 0; vp = (tau & 63) < 63; } else { dlt = 64; vm = tau >= 64; vp = tau < 4032; } }
        const bf16_t* zr = Z1 + (size_t)t * 3072;
        const u32x4 zero = {0u, 0u, 0u, 0u};
        const u32x4 cb = *(const u32x4*)(zr + ch), cc0 = *(const u32x4*)(zr + 1024 + ch), cx0 = *(const u32x4*)(zr + 2048 + ch);
        const u32x4 ccm = vm ? *(const u32x4*)(zr - (size_t)dlt * 3072 + 1024 + ch) : zero, cxm = vm ? *(const u32x4*)(zr - (size_t)dlt * 3072 + 2048 + ch) : zero;
        const u32x4 ccp = vp ? *(const u32x4*)(zr + (size_t)dlt * 3072 + 1024 + ch) : zero, cxp = vp ? *(const u32x4*)(zr + (size_t)dlt * 3072 + 2048 + ch) : zero;
        const float* wc = F.w_conv + (size_t)l * 3072 + ch;
        const float4 w0a = *(const float4*)(wc), w0b = *(const float4*)(wc + 4), w1a = *(const float4*)(wc + 1024), w1b = *(const float4*)(wc + 1028), w2a = *(const float4*)(wc + 2048), w2b = *(const float4*)(wc + 2052);
        const float w0[8] = {w0a.x, w0a.y, w0a.z, w0a.w, w0b.x, w0b.y, w0b.z, w0b.w};
        const float w1[8] = {w1a.x, w1a.y, w1a.z, w1a.w, w1b.x, w1b.y, w1b.z, w1b.w};
        const float w2[8] = {w2a.x, w2a.y, w2a.z, w2a.w, w2b.x, w2b.y, w2b.z, w2b.w};
        float o[8];
#pragma unroll
        for (int j = 0; j < 4; ++j) {
            const float um0 = bf_lo(ccm[j]) * bf_lo(cxm[j]), um1 = bf_hi(ccm[j]) * bf_hi(cxm[j]);
            const float u00 = bf_lo(cc0[j]) * bf_lo(cx0[j]), u01 = bf_hi(cc0[j]) * bf_hi(cx0[j]);
            const float up0 = bf_lo(ccp[j]) * bf_lo(cxp[j]), up1 = bf_hi(ccp[j]) * bf_hi(cxp[j]);
            o[2 * j] = bf_lo(cb[j]) * (um0 * w0[2 * j] + u00 * w1[2 * j] + up0 * w2[2 * j]);
            o[2 * j + 1] = bf_hi(cb[j]) * (um1 * w0[2 * j + 1] + u01 * w1[2 * j + 1] + up1 * w2[2 * j + 1]);
        }
        u32x4 w; w.x = cvt_pk_bf16(o[0], o[1]); w.y = cvt_pk_bf16(o[2], o[3]); w.z = cvt_pk_bf16(o[4], o[5]); w.w = cvt_pk_bf16(o[6], o[7]);
        *(u32x4*)(AIN + (size_t)t * 1024 + ch) = w;
    }
}

__device__ __forceinline__ float logsig_(float x) { return fminf(x, 0.f) - __logf(1.f + __expf(-fabsf(x))); }
__device__ __forceinline__ void phase_gla_prep(const Frame0& F0, int l) {
    PHASE_IDS(F0);
    LAS float* LF = (LAS float*)F.lds;
    LAS float* HT = LF + 2048;
    const int tid = F.tid;
    const int d = tid & 255, half = tid >> 8, p0 = half * 32;
    const bf16_t* ZQ = B_ZQ(F); const bf16_t* ZK = B_ZK(F); const float* Z5 = F.Z5;
    for (int u = F.bid; u < (T / 64) * 4; u += F.nb) {
        const int ch = u >> 2, head = u & 3, tb = ch * 64;
        __syncthreads();
        { const int row = tid >> 3, part = tid & 7; const f32x4 v = *(const f32x4*)(Z5 + (size_t)(tb + row) * 32 + part * 4);
          *(LAS f32x4*)(LF + (part >> 2) * 1024 + row * 16 + (part & 3) * 4) = v; }
        bf16_t qv[32], kv[32];
#pragma unroll
        for (int i = 0; i < 32; ++i) { const size_t ro = (size_t)(tb + p0 + i) * 1024 + head * 256 + d; qv[i] = ZQ[ro]; kv[i] = ZK[ro]; }
        __syncthreads();
#pragma unroll 1
        for (int dir = 0; dir < 2; ++dir) {
            float wg[16];
#pragma unroll
            for (int r = 0; r < 16; ++r) wg[r] = F.w_gk[((size_t)(l * 2 + dir) * 16 + r) * 1024 + head * 256 + d];
            const float gbias = F.b_gk[(size_t)(l * 2 + dir) * 1024 + head * 256 + d];
            float b[32];
#pragma unroll
            for (int i = 0; i < 32; ++i) { float x = gbias; const LAS float* lf = LF + dir * 1024 + (p0 + i) * 16;
#pragma unroll
                for (int r = 0; r < 16; ++r) x += lf[r] * wg[r];
                b[i] = fmaxf(logsig_(x) * 0.0625f, -1.0f); }
            float tot;
            if (!dir) {
#pragma unroll
                for (int i = 1; i < 32; ++i) b[i] += b[i - 1];
                tot = b[31];
            } else {
#pragma unroll
                for (int i = 30; i >= 0; --i) b[i] += b[i + 1];
                tot = b[0];
            }
            HT[half * 256 + d] = tot;
            __syncthreads();
            const float other = HT[(1 - half) * 256 + d];
            const float blast = tot + other;
            const float addv = (dir == 0) ? (half ? other : 0.f) : (half ? 0.f : other);
            bf16_t* QD = dir ? B_QDB(F) : B_QDF(F); bf16_t* KD = dir ? B_KDB(F) : B_KDF(F);
#pragma unroll
            for (int i = 0; i < 32; ++i) {
                const float bb = b[i] + addv; const size_t ro = (size_t)(tb + p0 + i) * 1024 + head * 256 + d;
                QD[ro] = f2bf(bf1(qv[i]) * 0.0625f * __expf(bb - blast));
                KD[ro] = f2bf(bf1(kv[i]) * __expf(blast - bb));
            }
            if (half == 0) B_DEC(F)[((size_t)dir * (T / 64) * 4 + u) * 256 + d] = __expf(blast);
            __syncthreads();
        }
    }
}
__device__ __forceinline__ void phase_gla_scan(const Frame0& F0, int l) {
    PHASE_IDS(F0);
    LAS unsigned char* L = F.lds;
    constexpr int QD_OFF = 0, KD_OFF = 33792, V_OFF = 67584, ST_OFF = 76800, ATT_OFF = 110592, DEC_OFF = 119808;
    const int tid = F.tid, lane = F.lane, wave = F.wave;
    const int fr = lane & 15, fq = lane >> 4;
    const unsigned lbase = (unsigned)(size_t)L;
    const unsigned tr_lane_v = lbase + V_OFF + (unsigned)((8 * fq + (fr >> 2)) * 144 + 8 * (lane & 3));
    const unsigned tr_lane_k = lbase + KD_OFF + (unsigned)((8 * fq + (fr >> 2)) * 528 + 8 * (lane & 3) + wave * 64);
    const bf16_t* ZV = B_ZV(F); bf16_t* OF = B_OF(F);
    const int ti = wave >> 1;
    for (int u0 = F.bid; u0 < 768; u0 += F.nb) {
        const int u = (F.nb == 256) ? (u0 & ~255) + (u0 & 7) * 32 + ((u0 & 255) >> 3) : u0;
        int seq, head, slice, tok0, nch; bool lat;
        if (u < 256) { lat = true; slice = u & 7; head = (u >> 3) & 3; seq = u >> 5; tok0 = TCTX + seq * 4096; nch = 64; }
        else { const int uc = u - 256; lat = false; slice = uc & 7; head = (uc >> 3) & 3; seq = uc >> 5; tok0 = seq * 256; nch = 4; }
#pragma unroll 1
      for (int dir = 0; dir < 2; ++dir) {
        const bf16_t* QD = dir ? B_QDB(F) : B_QDF(F); const bf16_t* KD = dir ? B_KDB(F) : B_KDF(F);
        const float* DEC = B_DEC(F) + (size_t)dir * (T / 64) * 4 * 256;
        const size_t soff = ((((size_t)seq * 2 + l) * 2 + dir) * 4 + head) * 256 * 512;
        f32x4 accS[2][4];
#pragma unroll
        for (int tdi = 0; tdi < 2; ++tdi)
#pragma unroll
            for (int te = 0; te < 4; ++te)
#pragma unroll
                for (int reg = 0; reg < 4; ++reg) {
                    const int dd = (2 * wave + tdi) * 16 + 4 * fq + reg, e = slice * 64 + te * 16 + fr;
                    accS[tdi][te][reg] = lat ? F.state[soff + (size_t)dd * 512 + e] : 0.f;
                }
        u32x4 rq[4], rk[4], rv; f32x4 rdec = {0.f, 0.f, 0.f, 0.f}; bf16_t ro[2][4];
#define GS_LOAD(cc_) do { const int c_ = dir ? nch - 1 - (cc_) : (cc_); const int tb_ = tok0 + c_ * 64; int tl_ = tid; asm volatile("" : "+v"(tl_));   \
            _Pragma("unroll") for (int i_ = 0; i_ < 4; ++i_) { const int id_ = tl_ + 512 * i_, row_ = id_ >> 5, c16_ = id_ & 31; const size_t go_ = (size_t)(tb_ + row_) * 1024 + head * 256 + c16_ * 8; \
                rq[i_] = *(const u32x4*)(QD + go_); rk[i_] = *(const u32x4*)(KD + go_); } \
            rv = *(const u32x4*)(ZV + (size_t)(tb_ + (tl_ >> 3)) * 2048 + head * 512 + slice * 64 + (tl_ & 7) * 8); \
            if (tl_ < 64) rdec = *(const f32x4*)(DEC + ((size_t)(tb_ >> 6) * 4 + head) * 256 + tl_ * 4); \
            if (dir) { const int ln_ = tl_ & 63, wv_ = tl_ >> 6; const bf16_t* ob_ = OF + (size_t)(tb_ + (wv_ >> 1) * 16 + 4 * (ln_ >> 4)) * 2048 + head * 512 + slice * 64 + 2 * (wv_ & 1) * 16 + (ln_ & 15); \
                _Pragma("unroll") for (int t2_ = 0; t2_ < 2; ++t2_) _Pragma("unroll") for (int reg_ = 0; reg_ < 4; ++reg_) ro[t2_][reg_] = ob_[reg_ * 2048 + t2_ * 16]; } } while (0)
        GS_LOAD(0);
#define GS_BAR() do { asm volatile("s_waitcnt lgkmcnt(0)" ::: "memory"); __builtin_amdgcn_s_barrier(); asm volatile("" ::: "memory"); } while (0)
        for (int cc = 0; cc < nch; ++cc) {
            const int c = dir ? nch - 1 - cc : cc; const int tb = tok0 + c * 64;
            GS_BAR();
#pragma unroll
            for (int i = 0; i < 4; ++i) { const int id = tid + 512 * i, row = id >> 5, c16 = id & 31;
                *(LAS u32x4*)(L + QD_OFF + row * 528 + c16 * 16) = rq[i]; *(LAS u32x4*)(L + KD_OFF + row * 528 + c16 * 16) = rk[i]; }
            *(LAS u32x4*)(L + V_OFF + (tid >> 3) * 144 + (tid & 7) * 16) = rv;
            if (tid < 64) *(LAS f32x4*)(L + DEC_OFF + tid * 16) = rdec;
            bf16_t oold[2][4];
#pragma unroll
            for (int t2 = 0; t2 < 2; ++t2)
#pragma unroll
                for (int reg = 0; reg < 4; ++reg) oold[t2][reg] = ro[t2][reg];
            GS_BAR();
            { const int nx = (cc + 1 < nch) ? cc + 1 : cc; GS_LOAD(nx); }
#pragma unroll
            for (int tdi = 0; tdi < 2; ++tdi) {
                const f32x4 dec = *(const LAS f32x4*)(L + DEC_OFF + ((2 * wave + tdi) * 16 + 4 * fq) * 4);
#pragma unroll
                for (int te = 0; te < 4; ++te) { accS[tdi][te] = accS[tdi][te] * dec;
                    u32x2 w; w.x = cvt_pk_bf16(accS[tdi][te][0], accS[tdi][te][1]); w.y = cvt_pk_bf16(accS[tdi][te][2], accS[tdi][te][3]);
                    *(LAS u32x2*)(L + ST_OFF + (te * 16 + fr) * 528 + ((2 * wave + tdi) * 16 + 4 * fq) * 2) = w; }
            }
#pragma unroll
            for (int t2 = 0; t2 < 2; ++t2) {
                const int tj = 2 * (wave & 1) + t2;
                const bool live = dir ? (tj >= ti) : (tj <= ti);
                f32x4 a4 = {0.f, 0.f, 0.f, 0.f};
                if (live) {
#pragma unroll
                    for (int ks = 0; ks < 8; ++ks) {
                        const bf16x8 a = *(const LAS bf16x8*)(L + QD_OFF + (ti * 16 + fr) * 528 + ks * 64 + fq * 16);
                        const bf16x8 bb = *(const LAS bf16x8*)(L + KD_OFF + (tj * 16 + fr) * 528 + ks * 64 + fq * 16);
                        a4 = __builtin_amdgcn_mfma_f32_16x16x32_bf16(a, bb, a4, 0, 0, 0);
                    }
                }
#pragma unroll
                for (int reg = 0; reg < 4; ++reg) { const int i = ti * 16 + 4 * fq + reg, j = tj * 16 + fr; const bool keep = dir ? (j >= i) : (j <= i);
                    *(LAS bf16_t*)(L + ATT_OFF + i * 144 + j * 2) = f2bf(keep ? a4[reg] : 0.f); }
            }
            GS_BAR();
            u32x2 vt[2][4][2], kt[2][2][2];
            asm volatile(
                "ds_read_b64_tr_b16 %0, %16 offset:0\n\tds_read_b64_tr_b16 %1, %16 offset:576\n\tds_read_b64_tr_b16 %2, %16 offset:32\n\tds_read_b64_tr_b16 %3, %16 offset:608\n\t"
                "ds_read_b64_tr_b16 %4, %16 offset:64\n\tds_read_b64_tr_b16 %5, %16 offset:640\n\tds_read_b64_tr_b16 %6, %16 offset:96\n\tds_read_b64_tr_b16 %7, %16 offset:672\n\t"
                "ds_read_b64_tr_b16 %8, %16 offset:4608\n\tds_read_b64_tr_b16 %9, %16 offset:5184\n\tds_read_b64_tr_b16 %10, %16 offset:4640\n\tds_read_b64_tr_b16 %11, %16 offset:5216\n\t"
                "ds_read_b64_tr_b16 %12, %16 offset:4672\n\tds_read_b64_tr_b16 %13, %16 offset:5248\n\tds_read_b64_tr_b16 %14, %16 offset:4704\n\tds_read_b64_tr_b16 %15, %16 offset:5280\n\t"
                "s_waitcnt lgkmcnt(0)"
                : "=&v"(vt[0][0][0]), "=&v"(vt[0][0][1]), "=&v"(vt[0][1][0]), "=&v"(vt[0][1][1]), "=&v"(vt[0][2][0]), "=&v"(vt[0][2][1]), "=&v"(vt[0][3][0]), "=&v"(vt[0][3][1]),
                  "=&v"(vt[1][0][0]), "=&v"(vt[1][0][1]), "=&v"(vt[1][1][0]), "=&v"(vt[1][1][1]), "=&v"(vt[1][2][0]), "=&v"(vt[1][2][1]), "=&v"(vt[1][3][0]), "=&v"(vt[1][3][1])
                : "v"(tr_lane_v) : "memory");
            asm volatile(
                "ds_read_b64_tr_b16 %0, %8 offset:0\n\tds_read_b64_tr_b16 %1, %8 offset:2112\n\tds_read_b64_tr_b16 %2, %8 offset:16896\n\tds_read_b64_tr_b16 %3, %8 offset:19008\n\t"
                "ds_read_b64_tr_b16 %4, %8 offset:32\n\tds_read_b64_tr_b16 %5, %8 offset:2144\n\tds_read_b64_tr_b16 %6, %8 offset:16928\n\tds_read_b64_tr_b16 %7, %8 offset:19040\n\t"
                "s_waitcnt lgkmcnt(0)"
                : "=&v"(kt[0][0][0]), "=&v"(kt[0][0][1]), "=&v"(kt[0][1][0]), "=&v"(kt[0][1][1]), "=&v"(kt[1][0][0]), "=&v"(kt[1][0][1]), "=&v"(kt[1][1][0]), "=&v"(kt[1][1][1])
                : "v"(tr_lane_k) : "memory");
#define GS_FRAG(x_) __builtin_bit_cast(bf16x8, (u32x4){(x_)[0].x, (x_)[0].y, (x_)[1].x, (x_)[1].y})
#pragma unroll
            for (int t2 = 0; t2 < 2; ++t2) {
                const int te = 2 * (wave & 1) + t2;
                f32x4 o4 = {0.f, 0.f, 0.f, 0.f};
#pragma unroll
                for (int ks = 0; ks < 8; ++ks) {
                    const bf16x8 a = *(const LAS bf16x8*)(L + QD_OFF + (ti * 16 + fr) * 528 + ks * 64 + fq * 16);
                    const bf16x8 bb = *(const LAS bf16x8*)(L + ST_OFF + (te * 16 + fr) * 528 + ks * 64 + fq * 16);
                    o4 = __builtin_amdgcn_mfma_f32_16x16x32_bf16(a, bb, o4, 0, 0, 0);
                }
#pragma unroll
                for (int ks = 0; ks < 2; ++ks) {
                    const bf16x8 a = *(const LAS bf16x8*)(L + ATT_OFF + (ti * 16 + fr) * 144 + ks * 64 + fq * 16);
                    const bf16x8 bb = (t2 == 0) ? ((wave & 1) ? GS_FRAG(vt[ks][2]) : GS_FRAG(vt[ks][0])) : ((wave & 1) ? GS_FRAG(vt[ks][3]) : GS_FRAG(vt[ks][1]));
                    o4 = __builtin_amdgcn_mfma_f32_16x16x32_bf16(a, bb, o4, 0, 0, 0);
                }
#pragma unroll
                for (int reg = 0; reg < 4; ++reg) { bf16_t* op = OF + (size_t)(tb + ti * 16 + 4 * fq + reg) * 2048 + head * 512 + slice * 64 + te * 16 + fr;
                    *op = f2bf(dir ? bf1(oold[t2][reg]) + o4[reg] : o4[reg]); }
            }
#pragma unroll
            for (int tdi = 0; tdi < 2; ++tdi)
#pragma unroll
                for (int te = 0; te < 4; ++te) {
                    f32x4 s4 = accS[tdi][te];
                    s4 = __builtin_amdgcn_mfma_f32_16x16x32_bf16(GS_FRAG(kt[tdi][0]), GS_FRAG(vt[0][te]), s4, 0, 0, 0);
                    s4 = __builtin_amdgcn_mfma_f32_16x16x32_bf16(GS_FRAG(kt[tdi][1]), GS_FRAG(vt[1][te]), s4, 0, 0, 0);
                    accS[tdi][te] = s4;
                }
        }
#undef GS_BAR
#undef GS_LOAD
#undef GS_FRAG
        if (!lat) {
            float* so = F.out + (size_t)T * D + soff;
#pragma unroll
            for (int tdi = 0; tdi < 2; ++tdi)
#pragma unroll
                for (int te = 0; te < 4; ++te)
#pragma unroll
                    for (int reg = 0; reg < 4; ++reg) {
                        const int dd = (2 * wave + tdi) * 16 + 4 * fq + reg, e = slice * 64 + te * 16 + fr;
                        so[(size_t)dd * 512 + e] = accS[tdi][te][reg];
                    }
        }
        __syncthreads();
      }
    }
}

__device__ __forceinline__ void phase_postgla(const Frame0& F0, int l) {
    PHASE_IDS(F0);
    const bf16_t* OF = B_OF(F); const bf16_t* R = F.Z3; unsigned char* BIN = (unsigned char*)B_BIN(F);
    float* BS = F.VS + 110592;
    for (int row = F.bid * 8 + F.wave; row < T; row += F.nb * 8) {
        float y[4][8]; float am = 0.f;
#pragma unroll
        for (int hh = 0; hh < 4; ++hh) {
            const int col = hh * 512 + F.lane * 8;
            const u32x4 a = *(const u32x4*)(OF + (size_t)row * D + col), r = *(const u32x4*)(R + (size_t)row * D + col);
            float o[8]; float ss = 0.f;
#pragma unroll
            for (int j = 0; j < 4; ++j) { o[2 * j] = bf_lo(a[j]); o[2 * j + 1] = bf_hi(a[j]); ss += o[2 * j] * o[2 * j] + o[2 * j + 1] * o[2 * j + 1]; }
            const float rn = rsqrtf(wsum(ss) * (1.f / 512.f) + LN_EPS);
            const float4 g0 = *(const float4*)(F.w_gn + (size_t)l * D + col), g1 = *(const float4*)(F.w_gn + (size_t)l * D + col + 4);
            const float gn[8] = {g0.x, g0.y, g0.z, g0.w, g1.x, g1.y, g1.z, g1.w};
#pragma unroll
            for (int j = 0; j < 4; ++j) { y[hh][2 * j] = o[2 * j] * rn * gn[2 * j] * siluf_(bf_lo(r[j])); y[hh][2 * j + 1] = o[2 * j + 1] * rn * gn[2 * j + 1] * siluf_(bf_hi(r[j]));
                am = fmaxf(am, fmaxf(fabsf(y[hh][2 * j]), fabsf(y[hh][2 * j + 1]))); }
        }
        am = wmax(am);
        const float bs = am > 0.f ? am * (1.f / 127.f) : 1.f, binv = 1.f / bs;
#pragma unroll
        for (int hh = 0; hh < 4; ++hh) { u32x2 w; w.x = pack_i8(y[hh][0] * binv, y[hh][1] * binv, y[hh][2] * binv, y[hh][3] * binv); w.y = pack_i8(y[hh][4] * binv, y[hh][5] * binv, y[hh][6] * binv, y[hh][7] * binv);
            *(u32x2*)(BIN + (size_t)row * D + hh * 512 + F.lane * 8) = w; }
        if (F.lane == 0) BS[row] = bs;
    }
}

__device__ __forceinline__ void phase_ln2(const Frame0& F0, int l) {
    PHASE_IDS(F0);
    const float* lg = F.ln_g + (size_t)(l * 2 + 0) * D; const float* lb = F.ln_b + (size_t)(l * 2 + 0) * D;
    const int stride = F.nb * 8;
    int row = F.bid * 8 + F.wave;
    unsigned char* H8 = (unsigned char*)F.Z3 + ((size_t)64 << 20);
    float4 v[8], lgv[8], lbv[8], shv[8], scv[8]; int cci = -1;
#pragma unroll
    for (int i = 0; i < 8; ++i) { lgv[i] = *(const float4*)(lg + i * 256 + F.lane * 4); lbv[i] = *(const float4*)(lb + i * 256 + F.lane * 4); }
    if (row < T) {
#pragma unroll
        for (int i = 0; i < 8; ++i) v[i] = ld_bf4(B_T1(F) + (size_t)row * D + i * 256 + F.lane * 4); }
    for (; row < T; row += stride) {
        float4 vn[8];
        const int nrow = row + stride;
        if (nrow < T) {
#pragma unroll
            for (int i = 0; i < 8; ++i) vn[i] = ld_bf4(B_T1(F) + (size_t)nrow * D + i * 256 + F.lane * 4); }
        else {
#pragma unroll
            for (int i = 0; i < 8; ++i) vn[i] = v[i]; }
        const int ci = cond_of(row);
        if (ci != cci) { const float* md = F.MOD + (size_t)(l * 9 + ci) * NADA; cci = ci;
#pragma unroll
            for (int i = 0; i < 8; ++i) { shv[i] = *(const float4*)(md + 3 * 2048 + i * 256 + F.lane * 4); scv[i] = *(const float4*)(md + 4 * 2048 + i * 256 + F.lane * 4); } }
        float s = 0.f;
#pragma unroll
        for (int i = 0; i < 8; ++i) s += (v[i].x + v[i].y) + (v[i].z + v[i].w);
        float mean = wsum(s) * (1.f / 2048.f); float q = 0.f;
#pragma unroll
        for (int i = 0; i < 8; ++i) { const float a = v[i].x - mean, b = v[i].y - mean, c = v[i].z - mean, d = v[i].w - mean; q += (a * a + b * b) + (c * c + d * d); }
        float rstd = rsqrtf(wsum(q) * (1.f / 2048.f) + LN_EPS);
        s = 0.f;
#pragma unroll
        for (int i = 0; i < 8; ++i) { const float4 g = lgv[i], bb = lbv[i];
            v[i].x = (v[i].x - mean) * rstd * g.x + bb.x; v[i].y = (v[i].y - mean) * rstd * g.y + bb.y; v[i].z = (v[i].z - mean) * rstd * g.z + bb.z; v[i].w = (v[i].w - mean) * rstd * g.w + bb.w;
            s += (v[i].x + v[i].y) + (v[i].z + v[i].w); }
        mean = wsum(s) * (1.f / 2048.f); q = 0.f;
#pragma unroll
        for (int i = 0; i < 8; ++i) { const float a = v[i].x - mean, b = v[i].y - mean, c = v[i].z - mean, d = v[i].w - mean; q += (a * a + b * b) + (c * c + d * d); }
        rstd = rsqrtf(wsum(q) * (1.f / 2048.f) + LN_EPS);
        float am = 0.f;
#pragma unroll
        for (int i = 0; i < 8; ++i) { const int col = i * 256 + F.lane * 4;
            const float4 sh = shv[i], sc = scv[i]; float4 h;
            h.x = (v[i].x - mean) * rstd * (1.f + sc.x) + sh.x; h.y = (v[i].y - mean) * rstd * (1.f + sc.y) + sh.y; h.z = (v[i].z - mean) * rstd * (1.f + sc.z) + sh.z; h.w = (v[i].w - mean) * rstd * (1.f + sc.w) + sh.w;
            u32x2 o; o.x = cvt_pk_bf16(h.x, h.y); o.y = cvt_pk_bf16(h.z, h.w);
            *(u32x2*)(F.H + (size_t)row * D + col) = o;
            v[i] = h; am = fmaxf(am, fmaxf(fmaxf(fabsf(h.x), fabsf(h.y)), fmaxf(fabsf(h.z), fabsf(h.w)))); }
        am = wmax(am);
        const float hs = am > 0.f ? am * (1.f / 127.f) : 1.f, hinv = 1.f / hs;
#pragma unroll
        for (int i = 0; i < 8; ++i) *(unsigned*)(H8 + (size_t)row * D + i * 256 + F.lane * 4) = pack_i8(v[i].x * hinv, v[i].y * hinv, v[i].z * hinv, v[i].w * hinv);
        if (F.lane == 0) F.VS[32768 + row] = hs;
#pragma unroll
        for (int i = 0; i < 8; ++i) v[i] = vn[i];
    }
}

__device__ __forceinline__ unsigned ord_u32(float f) { const unsigned u = __float_as_uint(f); return (u & 0x80000000u) ? ~u : (u | 0x80000000u); }
__device__ __forceinline__ float unord_f32(unsigned u) { return (u & 0x80000000u) ? __uint_as_float(u & 0x7fffffffu) : __uint_as_float(~u); }
__device__ __forceinline__ unsigned umax_(unsigned a, unsigned b) { return a > b ? a : b; }
__device__ __forceinline__ unsigned xmax4(unsigned m) { m = umax_(m, (unsigned)__shfl_xor((int)m, 16)); m = umax_(m, (unsigned)__shfl_xor((int)m, 32)); return m; }
__device__ __forceinline__ void phase_peer_score(const Frame0& F0, int l) {
    PHASE_IDS(F0);
    LAS unsigned char* L = F.lds;
    constexpr int KL_ROW = 272, LW_OFF = 2 * 128 * KL_ROW;
    constexpr int CA[52] = {0, 0, 0, 0, 0, 0, 0, 0, 0, 0, 0, 0, 0, 0, 0, 0, 1, 1, 1, 1, 1, 1, 1, 1, 2, 2, 2, 2, 2, 3, 3, 3, 3, 4, 4, 4, 5, 5, 6, 6, 7, 7, 8, 9, 10, 11, 12, 13, 14, 15, 0, 0};
    constexpr int CB[52] = {0, 1, 2, 3, 4, 5, 6, 7, 8, 9, 10, 11, 12, 13, 14, 15, 0, 1, 2, 3, 4, 5, 6, 7, 0, 1, 2, 3, 4, 0, 1, 2, 3, 0, 1, 2, 0, 1, 0, 1, 0, 1, 0, 0, 0, 0, 0, 0, 0, 0, 0, 0};
    const int tid = F.tid, lane = F.lane, wave = F.wave, fr = lane & 15, fq = lane >> 4;
    const bf16_t* QQ = B_QQ(F);
    int* PIDX = (int*)F.Z3; float* PGATE = (float*)((unsigned char*)F.Z3 + (size_t)T * 128 * 4);
    for (int i = tid; i < 2 * 128 * 128 / 4; i += 512) {
        const int idx = i * 4, side = idx >> 14, n = (idx >> 7) & 127, dd = idx & 127;
        const float4 v = *(const float4*)(F.pkeys + (size_t)l * 2 * 128 * 128 + idx);
        u32x2 w; w.x = cvt_pk_bf16(v.x, v.y); w.y = cvt_pk_bf16(v.z, v.w);
        *(LAS u32x2*)(L + (side * 128 + n) * KL_ROW + dd * 2) = w;
    }
    __syncthreads();
    LAS int* nbuf = (LAS int*)(L + LW_OFF + wave * 4096);
    LAS float* vbuf = (LAS float*)(L + LW_OFF + wave * 4096 + 2048);
    bf16x8 bqn[2][4];
    { const int task0 = F.bid * 8 + wave; if (task0 < (T / 16) * 8) { const int tok0 = (task0 >> 3) * 16 + fr, h0 = task0 & 7;
#pragma unroll
        for (int side = 0; side < 2; ++side)
#pragma unroll
            for (int ks = 0; ks < 4; ++ks) bqn[side][ks] = *(const bf16x8*)(QQ + (size_t)tok0 * D + h0 * 256 + side * 128 + ks * 32 + fq * 8); } }
    for (int task = F.bid * 8 + wave; task < (T / 16) * 8; task += F.nb * 8) {
        const int tg = task >> 3, h = task & 7, tok = tg * 16 + fr;
        unsigned key0[32], key1[32];
#pragma unroll
        for (int side = 0; side < 2; ++side)
#pragma unroll
            for (int tile = 0; tile < 8; ++tile) {
                f32x4 s4 = {0.f, 0.f, 0.f, 0.f};
#pragma unroll
                for (int ks = 0; ks < 4; ++ks) {
                    const bf16x8 a = *(const LAS bf16x8*)(L + (side * 128 + tile * 16 + fr) * KL_ROW + ks * 64 + fq * 16);
                    s4 = __builtin_amdgcn_mfma_f32_16x16x32_bf16(a, bqn[side][ks], s4, 0, 0, 0);
                }
#pragma unroll
                for (int reg = 0; reg < 4; ++reg) { const unsigned kv = (ord_u32(s4[reg]) & ~127u) | (unsigned)(127 - (tile * 16 + 4 * fq + reg)); if (side == 0) key0[tile * 4 + reg] = kv; else key1[tile * 4 + reg] = kv; }
                if (tile & 1) __builtin_amdgcn_sched_barrier(0);
            }
        { const int ntask = task + F.nb * 8; if (ntask < (T / 16) * 8) { const int tokn = (ntask >> 3) * 16 + fr, hn = ntask & 7;
#pragma unroll
            for (int side = 0; side < 2; ++side)
#pragma unroll
                for (int ks = 0; ks < 4; ++ks) bqn[side][ks] = *(const bf16x8*)(QQ + (size_t)tokn * D + hn * 256 + side * 128 + ks * 32 + fq * 8); } }
        float v1[16], v2[16];
#pragma unroll
        for (int side = 0; side < 2; ++side) {
#pragma unroll
            for (int r = 0; r < 16; ++r) {
                unsigned m = side == 0 ? key0[0] : key1[0];
#pragma unroll
                for (int i = 1; i < 32; ++i) m = umax_(m, side == 0 ? key0[i] : key1[i]);
                m = xmax4(m);
#pragma unroll
                for (int i = 0; i < 32; ++i) { if (side == 0) key0[i] = (key0[i] == m) ? 0u : key0[i]; else key1[i] = (key1[i] == m) ? 0u : key1[i]; }
                const float val = unord_f32(m & ~127u);
                if (side == 0) v1[r] = val; else v2[r] = val;
                if (fq == 0) { nbuf[fr * 32 + side * 16 + r] = 127 - (int)(m & 127u); vbuf[fr * 32 + side * 16 + r] = val; }
            }
        }
        unsigned ck[13];
#pragma unroll
        for (int s = 0; s < 13; ++s) {
            const float x0 = v1[CA[4 * s]] + v2[CB[4 * s]], x1 = v1[CA[4 * s + 1]] + v2[CB[4 * s + 1]], x2 = v1[CA[4 * s + 2]] + v2[CB[4 * s + 2]], x3 = v1[CA[4 * s + 3]] + v2[CB[4 * s + 3]];
            const int c0 = CA[4 * s] * 16 + CB[4 * s], c1 = CA[4 * s + 1] * 16 + CB[4 * s + 1], c2 = CA[4 * s + 2] * 16 + CB[4 * s + 2], c3 = CA[4 * s + 3] * 16 + CB[4 * s + 3];
            const float xv = fq == 0 ? x0 : (fq == 1 ? x1 : (fq == 2 ? x2 : x3));
            const int cv = fq == 0 ? c0 : (fq == 1 ? c1 : (fq == 2 ? c2 : c3));
            const bool valid = (4 * s + fq) < 50;
            ck[s] = valid ? ((ord_u32(xv) & ~255u) | (unsigned)(255 - cv)) : 0u;
        }
        unsigned cw[16];
#pragma unroll
        for (int r = 0; r < 16; ++r) {
            unsigned m = ck[0];
#pragma unroll
            for (int i = 1; i < 13; ++i) m = umax_(m, ck[i]);
            m = xmax4(m);
#pragma unroll
            for (int i = 0; i < 13; ++i) ck[i] = (ck[i] == m) ? 0u : ck[i];
            cw[r] = m;
        }
        asm volatile("s_waitcnt lgkmcnt(0)" ::: "memory");
        __builtin_amdgcn_wave_barrier();
        float sv[4]; int ix[4];
#pragma unroll
        for (int i = 0; i < 4; ++i) {
            const unsigned m = fq == 0 ? cw[4 * i] : (fq == 1 ? cw[4 * i + 1] : (fq == 2 ? cw[4 * i + 2] : cw[4 * i + 3]));
            const int code = 255 - (int)(m & 255u), a = code >> 4, b = code & 15;
            ix[i] = nbuf[fr * 32 + a] * 128 + nbuf[fr * 32 + 16 + b];
            sv[i] = vbuf[fr * 32 + a] + vbuf[fr * 32 + 16 + b];
        }
        float mx = fmaxf(fmaxf(sv[0], sv[1]), fmaxf(sv[2], sv[3]));
        mx = fmaxf(mx, __shfl_xor(mx, 16)); mx = fmaxf(mx, __shfl_xor(mx, 32));
        float ev[4], es = 0.f;
#pragma unroll
        for (int i = 0; i < 4; ++i) { ev[i] = __expf(sv[i] - mx); es += ev[i]; }
        es += __shfl_xor(es, 16); es += __shfl_xor(es, 32);
        const float inv = 1.f / es;
#pragma unroll
        for (int i = 0; i < 4; ++i) { const size_t o = ((size_t)tok * 8 + h) * 16 + 4 * i + fq; PIDX[o] = ix[i]; PGATE[o] = ev[i] * inv; }
        asm volatile("s_waitcnt lgkmcnt(0)" ::: "memory");
        __builtin_amdgcn_wave_barrier();
    }
}

constexpr int PE_NG = 32, PE_NJ = 8, PE_NTB = T / 128, PE_BI = 16384;
constexpr size_t NPAIR = (size_t)T * 128;
constexpr size_t PE_ITEMS_OFF = 0, PE_VLIST_OFF = (size_t)32 << 20, PE_BLKOFF_OFF = (size_t)64 << 20, PE_GATES_OFF = (size_t)72 << 20;
__device__ __forceinline__ unsigned lds_add(LAS unsigned* p, unsigned v) { return __hip_atomic_fetch_add(p, v, __ATOMIC_RELAXED, __HIP_MEMORY_SCOPE_WORKGROUP); }
__device__ __forceinline__ void phase_peer_bucket(const Frame0& F0) {
    PHASE_IDS(F0);
    LAS unsigned* cnt = (LAS unsigned*)F.lds;
    LAS unsigned* base = cnt + 256;
    LAS unsigned* gstart = base + 256;
    const int* PIDX = (const int*)F.Z3;
    unsigned* ITEMS = (unsigned*)((unsigned char*)F.Z1 + PE_ITEMS_OFF); int* BLKOFF = (int*)((unsigned char*)F.Z1 + PE_BLKOFF_OFF);
    float* GATES = (float*)((unsigned char*)F.Z1 + PE_GATES_OFF); const float* PGATE = (const float*)((const unsigned char*)F.Z3 + (size_t)T * 128 * 4);
    const int tid = F.tid, lane = F.lane, wave = F.wave;
    for (int tb = F.bid; tb < PE_NTB; tb += F.nb) {
        if (tid < 256) cnt[tid] = 0u;
        __syncthreads();
        unsigned myidx[32];
#pragma unroll
        for (int k = 0; k < 32; ++k) { myidx[k] = (unsigned)PIDX[(size_t)tb * PE_BI + tid + 512 * k]; (void)lds_add(&cnt[wave * 32 + (myidx[k] >> 9)], 1u); }
        __syncthreads();
        if (tid < 64) {
            unsigned s = 0u;
            if (tid < 32) {
#pragma unroll
                for (int w = 0; w < 8; ++w) { const unsigned c = cnt[w * 32 + tid]; base[w * 32 + tid] = s; s += c; }
            }
            unsigned incl = s;
#pragma unroll
            for (int off = 1; off < 32; off <<= 1) { const unsigned v = (unsigned)__shfl_up((int)incl, off); if (lane >= off) incl += v; }
            if (tid < 32) {
                const unsigned excl = incl - s; gstart[tid] = excl; if (tid == 31) gstart[32] = incl;
#pragma unroll
                for (int w = 0; w < 8; ++w) base[w * 32 + tid] += excl;
            }
        }
        __syncthreads();
        if (tid < 33) BLKOFF[tb * 33 + tid] = (int)gstart[tid];
        if (tid < 256) cnt[tid] = 0u;
        __syncthreads();
#pragma unroll
        for (int k = 0; k < 32; ++k) { const int i = tid + 512 * k; const unsigned g = myidx[k] >> 9; const unsigned p = lds_add(&cnt[wave * 32 + g], 1u); const unsigned pos = base[wave * 32 + g] + p;
            ITEMS[(size_t)tb * PE_BI + pos] = ((unsigned)(i >> 7) << 21) | ((unsigned)(i & 127) << 14) | myidx[k]; }
        __syncthreads();
    }
}
__device__ __forceinline__ void phase_peer_u(const Frame0& F0, int l) {
    PHASE_IDS(F0);
    const float* PU = F.peer_u + (size_t)l * 16384 * D;
    LAS unsigned char* L = F.lds;
    constexpr int WROW = 272, P_OFF = 512 * WROW;
    LAS int* P = (LAS int*)(L + P_OFF);
    LAS int* B0 = P + 292;
    LAS int* WT = B0 + 288;
    const unsigned char* H2 = (const unsigned char*)F.Z3 + ((size_t)64 << 20);
    const unsigned* ITEMS = (const unsigned*)((unsigned char*)F.Z1 + PE_ITEMS_OFF); const int* BLKOFF = (const int*)((unsigned char*)F.Z1 + PE_BLKOFF_OFF);
    bf16_t* PART = (bf16_t*)F.Z2;
    const int tid = F.tid, lane = F.lane, wave = F.wave;
    for (int u = F.bid; u < PE_NG * PE_NJ; u += F.nb) {
        const int j = u & 7, g = u >> 3;
        __syncthreads();
        for (int i = tid; i < 512 * 16; i += 512) { const int row = i >> 4, c = i & 15;
            const float* sp = PU + (size_t)(g * 512 + row) * D + j * 256 + c * 16; const float4 a = ((const float4*)sp)[0], b = ((const float4*)sp)[1], cq = ((const float4*)sp)[2], dq = ((const float4*)sp)[3];
            const float ui = 1.f / F.VS[16384 + g * 512 + row];
            u32x4 v; v.x = pack_i8(a.x * ui, a.y * ui, a.z * ui, a.w * ui); v.y = pack_i8(b.x * ui, b.y * ui, b.z * ui, b.w * ui); v.z = pack_i8(cq.x * ui, cq.y * ui, cq.z * ui, cq.w * ui); v.w = pack_i8(dq.x * ui, dq.y * ui, dq.z * ui, dq.w * ui);
            *(LAS u32x4*)(L + row * WROW + c * 16) = v; }
        int c = 0;
        if (tid < PE_NTB) { const int b0 = BLKOFF[tid * 33 + g]; c = BLKOFF[tid * 33 + g + 1] - b0; B0[tid] = b0; }
        int incl = c;
#pragma unroll
        for (int off = 1; off < 64; off <<= 1) { const int v = __shfl_up(incl, off); if (lane >= off) incl += v; }
        if (lane == 63) WT[wave] = incl;
        __syncthreads();
        int woff = 0;
#pragma unroll
        for (int w = 0; w < 8; ++w) woff += (w < wave) ? WT[w] : 0;
        if (tid < PE_NTB) P[tid + 1] = incl + woff;
        if (tid == 0) P[0] = 0;
        __syncthreads();
        const int total = P[PE_NTB];
        const int sub = lane & 3;
        int tbw = 0;
        const unsigned char* hbase = H2 + j * 256 + sub * 16;
        const LAS unsigned char* wbase = L + sub * 16;
        bf16_t* partj = PART + (size_t)j * NPAIR;
#define PU_ISSUE(qb_, S) do { const int q_ = (qb_) + lane; S##ok = q_ < total; S##pp = 0; S##tb = 0; S##raw = 0u; \
            if (S##ok) { while (q_ >= P[tbw + 1]) ++tbw; S##pp = tbw * PE_BI + B0[tbw] + (q_ - P[tbw]); S##tb = tbw * 128; S##raw = ITEMS[S##pp]; } } while (0)
#define PU_BCAST(x_, r_) __builtin_amdgcn_update_dpp(0, (x_), (r_) * 0x55, 0xf, 0xf, true)
#define PU_LH1(TE_, H0_, H1_, r_) { const int bc_ = PU_BCAST(TE_, r_); TE_##e[r_] = bc_ & 511; const unsigned char* hp_ = hbase + (size_t)(bc_ >> 9) * D; H0_[2 * (r_)] = *(const u32x4*)(hp_); H0_[2 * (r_) + 1] = *(const u32x4*)(hp_ + 64); H1_[2 * (r_)] = *(const u32x4*)(hp_ + 128); H1_[2 * (r_) + 1] = *(const u32x4*)(hp_ + 192); }
#define PU_LOADH(S, TE_, H0_, H1_) do { TE_ = (int)(((unsigned)(S##tb + (int)(S##raw >> 21)) << 9) | (S##raw & 511u)); \
            PU_LH1(TE_, H0_, H1_, 0) PU_LH1(TE_, H0_, H1_, 1) PU_LH1(TE_, H0_, H1_, 2) PU_LH1(TE_, H0_, H1_, 3) } while (0)
#define PU_DPP_ADD(x_, ctrl_) ((x_) + __builtin_amdgcn_update_dpp(0, (x_), (ctrl_), 0xf, 0xf, true))
#define PU_D4(h_, w_) s0_ = __builtin_amdgcn_sdot4((int)(h_).x, (int)(w_).x, s0_, false); s1_ = __builtin_amdgcn_sdot4((int)(h_).y, (int)(w_).y, s1_, false); \
                s0_ = __builtin_amdgcn_sdot4((int)(h_).z, (int)(w_).z, s0_, false); s1_ = __builtin_amdgcn_sdot4((int)(h_).w, (int)(w_).w, s1_, false);
#define PU_C1(TE_, H0_, H1_, r_) { const LAS unsigned char* wp_ = wbase + TE_##e[r_] * WROW; \
                const u32x4 w0_ = *(const LAS u32x4*)(wp_), w1_ = *(const LAS u32x4*)(wp_ + 64), w2_ = *(const LAS u32x4*)(wp_ + 128), w3_ = *(const LAS u32x4*)(wp_ + 192); int s0_ = 0, s1_ = 0; \
                PU_D4(H0_[2 * (r_)], w0_) PU_D4(H0_[2 * (r_) + 1], w1_) PU_D4(H1_[2 * (r_)], w2_) PU_D4(H1_[2 * (r_) + 1], w3_) \
                int sm_ = s0_ + s1_; sm_ = PU_DPP_ADD(sm_, 0x4e); sm_ = PU_DPP_ADD(sm_, 0xb1);   \
                keep_ = (sub == r_) ? sm_ : keep_; }
#define PU_COMPUTE(S, TE_, H0_, H1_) do { int keep_ = 0; \
            PU_C1(TE_, H0_, H1_, 0) PU_C1(TE_, H0_, H1_, 1) PU_C1(TE_, H0_, H1_, 2) PU_C1(TE_, H0_, H1_, 3) \
            if (S##ok) partj[S##pp] = f2bf((float)keep_); } while (0)
        u32x4 hA0[8], hA1[8], hB0[8], hB1[8]; int teA, teB, teAe[8], teBe[8];
        bool s0ok, s1ok, s2ok, s3ok; int s0pp, s1pp, s2pp, s3pp, s0tb, s1tb, s2tb, s3tb; unsigned s0raw, s1raw, s2raw, s3raw;
        int qb = wave * 64;
        PU_ISSUE(qb, s0); PU_ISSUE(qb + 512, s1); PU_ISSUE(qb + 1024, s2);
        PU_LOADH(s0, teA, hA0, hA1);
        for (; qb < total; qb += 2048) {
            PU_ISSUE(qb + 1536, s3); PU_LOADH(s1, teB, hB0, hB1); PU_COMPUTE(s0, teA, hA0, hA1);
            PU_ISSUE(qb + 2048, s0); PU_LOADH(s2, teA, hA0, hA1); PU_COMPUTE(s1, teB, hB0, hB1);
            PU_ISSUE(qb + 2560, s1); PU_LOADH(s3, teB, hB0, hB1); PU_COMPUTE(s2, teA, hA0, hA1);
            PU_ISSUE(qb + 3072, s2); PU_LOADH(s0, teA, hA0, hA1); PU_COMPUTE(s3, teB, hB0, hB1);
        }
#undef PU_ISSUE
#undef PU_BCAST
#undef PU_LOADH
#undef PU_LH1
#undef PU_C1
#undef PU_D4
#undef PU_DPP_ADD
#undef PU_COMPUTE
    }
}
__device__ __forceinline__ void phase_peer_coef(const Frame0& F0) {
    PHASE_IDS(F0);
    const unsigned* ITEMS = (const unsigned*)((unsigned char*)F.Z1 + PE_ITEMS_OFF); unsigned* VLIST = (unsigned*)((unsigned char*)F.Z1 + PE_VLIST_OFF);
    const bf16_t* PART = (const bf16_t*)F.Z2; const float* PGATE = (const float*)((const unsigned char*)F.Z3 + (size_t)T * 128 * 4);
    for (int Lu = F.bid; Lu < PE_NTB * 8; Lu += F.nb) {
        int tb, su;
        if (F.nb == 256) { const int k = Lu >> 8, b = Lu & 255; tb = k * 32 + (b & 7) * 4 + (b >> 6); su = (b >> 3) & 7; } else { tb = Lu >> 3; su = Lu & 7; }
        const size_t p0 = (size_t)tb * PE_BI + su * 2048 + F.tid;
        unsigned item[4]; float s[4], gt[4], vs[4], qs[4];
#pragma unroll
        for (int r = 0; r < 4; ++r) { item[r] = ITEMS[p0 + r * 512]; s[r] = 0.f; }
#pragma unroll
        for (int r = 0; r < 4; ++r) { const size_t p = p0 + r * 512;
#pragma unroll
            for (int j = 0; j < PE_NJ; ++j) s[r] += bf1(PART[(size_t)j * NPAIR + p]); }
#pragma unroll
        for (int r = 0; r < 4; ++r) { const int t = tb * 128 + (int)(item[r] >> 21), slot = (int)((item[r] >> 14) & 127u);
            gt[r] = PGATE[(size_t)t * 128 + slot]; vs[r] = F.VS[item[r] & 16383u]; qs[r] = F.VS[16384 + (item[r] & 16383u)] * F.VS[32768 + t]; }
#pragma unroll
        for (int r = 0; r < 4; ++r) { const int t = tb * 128 + (int)(item[r] >> 21), slot = (int)((item[r] >> 14) & 127u); const unsigned idx = item[r] & 16383u;
            const float coef = gt[r] * gelu_tanh(s[r] * qs[r]) * vs[r];
            VLIST[((size_t)(t >> 6) * 128 + slot) * 64 + (t & 63)] = (idx << 16) | (unsigned)f2bf(coef); }
    }
}
constexpr size_t PE_PK_OFF = (size_t)80 << 20;
__device__ __forceinline__ void phase_peer_pack(const Frame0& F0) {
    PHASE_IDS(F0);
    const unsigned* VLIST = (const unsigned*)((unsigned char*)F.Z1 + PE_VLIST_OFF); unsigned* PK = (unsigned*)((unsigned char*)F.Z1 + PE_PK_OFF);
    float* CT = F.VS + 73728;
    for (int tw = F.bid + F.wave * F.nb; tw < T / 64; tw += 8 * F.nb) {
        const int t = tw * 64 + F.lane;
        const unsigned* vl = VLIST + (size_t)(t >> 6) * 8192 + (t & 63);
        float cm = 0.f;
#pragma unroll 1
        for (int kh = 0; kh < 2; ++kh) {
            unsigned it[64];
#pragma unroll
            for (int k = 0; k < 64; ++k) it[k] = vl[(kh * 64 + k) * 64];
#pragma unroll
            for (int k = 0; k < 64; ++k) cm = fmaxf(cm, fabsf(__uint_as_float(it[k] << 16)));
        }
        const float ct = cm > 0.f ? cm * (1.f / 127.f) : 1.f, cinv = 1.f / ct;
        unsigned* pk = PK + (size_t)(t >> 6) * (32 * 3 * 64) + (t & 63);
#pragma unroll 1
        for (int kh = 0; kh < 2; ++kh) {
            unsigned it[64];
#pragma unroll
            for (int k = 0; k < 64; ++k) it[k] = vl[(kh * 64 + k) * 64];
#pragma unroll
            for (int q = 0; q < 16; ++q) { const unsigned w0 = it[4 * q], w1 = it[4 * q + 1], w2 = it[4 * q + 2], w3 = it[4 * q + 3];
                unsigned* o = pk + (size_t)((kh * 16 + q) * 3) * 64;
                o[0] = (w0 >> 16) | (w1 & 0xffff0000u); o[64] = (w2 >> 16) | (w3 & 0xffff0000u);
                o[128] = pack_i8(__uint_as_float(w0 << 16) * cinv, __uint_as_float(w1 << 16) * cinv, __uint_as_float(w2 << 16) * cinv, __uint_as_float(w3 << 16) * cinv); }
        }
        CT[t] = ct;
    }
}
__device__ __forceinline__ void phase_peer_v(const Frame0& F0) {
    PHASE_IDS(F0);
    LAS unsigned char* L = F.lds;
    const unsigned char* V8 = F.V8; const unsigned* PK = (const unsigned*)((unsigned char*)F.Z1 + PE_PK_OFF);
    const float* CT = F.VS + 73728;
    float* FBUF = (float*)F.Z2;
    const int tid = F.tid;
    for (int u0 = F.bid; u0 < 256; u0 += F.nb) {
        const int u = (F.nb == 256) ? (u0 & 7) * 32 + (u0 >> 3) : u0;
        __syncthreads();
        for (int e = tid; e < 16384; e += 512) { const u32x2 v = *(const u32x2*)(V8 + (size_t)e * 2048 + u * 8); *(LAS u32x2*)(L + e * 8) = v; }
        __syncthreads();
        unsigned la[48], lb[48];
#define PV_LOAD(dst, t_, kb_) do { const unsigned* pk_ = PK + (size_t)((t_) >> 6) * (32 * 3 * 64) + ((t_) & 63) + (size_t)(kb_) * 48 * 64; \
            _Pragma("unroll") for (int i_ = 0; i_ < 48; ++i_) dst[i_] = pk_[i_ * 64]; } while (0)
#define PV_QUAD(src, q_) do { const unsigned d0_ = src[3 * (q_)], d1_ = src[3 * (q_) + 1], cq_ = src[3 * (q_) + 2]; \
            const u32x2 x0_ = *(const LAS u32x2*)(L + (d0_ & 0xffffu) * 8), x1_ = *(const LAS u32x2*)(L + (d0_ >> 16) * 8), x2_ = *(const LAS u32x2*)(L + (d1_ & 0xffffu) * 8), x3_ = *(const LAS u32x2*)(L + (d1_ >> 16) * 8); \
            { const unsigned tl01 = __builtin_amdgcn_perm(x1_.x, x0_.x, 0x05010400u), th01 = __builtin_amdgcn_perm(x1_.x, x0_.x, 0x07030602u), tl23 = __builtin_amdgcn_perm(x3_.x, x2_.x, 0x05010400u), th23 = __builtin_amdgcn_perm(x3_.x, x2_.x, 0x07030602u); \
              a0 = __builtin_amdgcn_sdot4((int)__builtin_amdgcn_perm(tl23, tl01, 0x05040100u), (int)cq_, a0, false); a1 = __builtin_amdgcn_sdot4((int)__builtin_amdgcn_perm(tl23, tl01, 0x07060302u), (int)cq_, a1, false); \
              a2 = __builtin_amdgcn_sdot4((int)__builtin_amdgcn_perm(th23, th01, 0x05040100u), (int)cq_, a2, false); a3 = __builtin_amdgcn_sdot4((int)__builtin_amdgcn_perm(th23, th01, 0x07060302u), (int)cq_, a3, false); } \
            { const unsigned tl01 = __builtin_amdgcn_perm(x1_.y, x0_.y, 0x05010400u), th01 = __builtin_amdgcn_perm(x1_.y, x0_.y, 0x07030602u), tl23 = __builtin_amdgcn_perm(x3_.y, x2_.y, 0x05010400u), th23 = __builtin_amdgcn_perm(x3_.y, x2_.y, 0x07030602u); \
              a4 = __builtin_amdgcn_sdot4((int)__builtin_amdgcn_perm(tl23, tl01, 0x05040100u), (int)cq_, a4, false); a5 = __builtin_amdgcn_sdot4((int)__builtin_amdgcn_perm(tl23, tl01, 0x07060302u), (int)cq_, a5, false); \
              a6 = __builtin_amdgcn_sdot4((int)__builtin_amdgcn_perm(th23, th01, 0x05040100u), (int)cq_, a6, false); a7 = __builtin_amdgcn_sdot4((int)__builtin_amdgcn_perm(th23, th01, 0x07060302u), (int)cq_, a7, false); } } while (0)
#define PV_BATCH(src) do { _Pragma("unroll") for (int q_ = 0; q_ < 16; ++q_) { PV_QUAD(src, q_); if ((q_ & 3) == 3) __builtin_amdgcn_sched_barrier(0); } } while (0)
        PV_LOAD(la, tid, 0);
        for (int t = tid; t < T; t += 512) {
            int a0 = 0, a1 = 0, a2 = 0, a3 = 0, a4 = 0, a5 = 0, a6 = 0, a7 = 0;
            const float ct = CT[t];
            const int tn = (t + 512 < T) ? t + 512 : t;
            PV_LOAD(lb, t, 1); PV_BATCH(la);
            PV_LOAD(la, tn, 0); PV_BATCH(lb);
            f32x4 o0 = {(float)a0 * ct, (float)a1 * ct, (float)a2 * ct, (float)a3 * ct}, o1 = {(float)a4 * ct, (float)a5 * ct, (float)a6 * ct, (float)a7 * ct};
            *(f32x4*)(FBUF + (size_t)t * D + u * 8) = o0; *(f32x4*)(FBUF + (size_t)t * D + u * 8 + 4) = o1;
        }
#undef PV_LOAD
#undef PV_QUAD
#undef PV_BATCH
    }
}
__device__ __forceinline__ void phase_peer_final(const Frame0& F0, int l) {
    PHASE_IDS(F0);
    const float* FBUF = (const float*)F.Z2;
    const float* lg = F.ln_g + (size_t)(l * 2 + 1) * D; const float* lb = F.ln_b + (size_t)(l * 2 + 1) * D;
    const float* lg0 = F.ln_g + (size_t)(l * 2 + 0) * D; const float* lb0 = F.ln_b + (size_t)(l * 2 + 0) * D;
    LAS float* PL = (LAS float*)F.lds;
    for (int i = F.tid; i < 2048; i += 512) { PL[i] = lg0[i]; PL[2048 + i] = lb0[i]; PL[4096 + i] = lg[i]; PL[6144 + i] = lb[i]; }
    __syncthreads();
    const int stride = F.nb * 8;
    int row = F.bid * 8 + F.wave;
    float4 xv[8], g2v[8]; int cci = -1;
    if (row < T) {
#pragma unroll
        for (int i = 0; i < 8; ++i) xv[i] = ld_bf4(B_T1(F) + (size_t)row * D + i * 256 + F.lane * 4); }
    for (; row < T; row += stride) {
        float4 xn[8], fv[8];
#pragma unroll
        for (int i = 0; i < 8; ++i) fv[i] = *(const float4*)(FBUF + (size_t)row * D + i * 256 + F.lane * 4);
        const int nrow = row + stride;
        if (nrow < T) {
#pragma unroll
            for (int i = 0; i < 8; ++i) xn[i] = ld_bf4(B_T1(F) + (size_t)nrow * D + i * 256 + F.lane * 4); }
        else {
#pragma unroll
            for (int i = 0; i < 8; ++i) xn[i] = xv[i]; }
        int lo4 = F.lane * 4; asm volatile("" : "+v"(lo4));
        {
            float s0 = 0.f;
#pragma unroll
            for (int i = 0; i < 8; ++i) s0 += (xv[i].x + xv[i].y) + (xv[i].z + xv[i].w);
            const float mean0 = wsum(s0) * (1.f / 2048.f); float q0 = 0.f;
#pragma unroll
            for (int i = 0; i < 8; ++i) { const float a = xv[i].x - mean0, b = xv[i].y - mean0, c = xv[i].z - mean0, d = xv[i].w - mean0; q0 += (a * a + b * b) + (c * c + d * d); }
            const float rstd0 = rsqrtf(wsum(q0) * (1.f / 2048.f) + LN_EPS);
#pragma unroll
            for (int i = 0; i < 8; ++i) { const f32x4 g = *(const LAS f32x4*)(PL + i * 256 + lo4), bb = *(const LAS f32x4*)(PL + 2048 + i * 256 + lo4);
                xv[i].x = (xv[i].x - mean0) * rstd0 * g.x + bb.x; xv[i].y = (xv[i].y - mean0) * rstd0 * g.y + bb.y; xv[i].z = (xv[i].z - mean0) * rstd0 * g.z + bb.z; xv[i].w = (xv[i].w - mean0) * rstd0 * g.w + bb.w; }
        }
        float* xr = F.XA + (size_t)row * D;
        const int ci = cond_of(row);
        if (ci != cci) { const float* g2 = F.MOD + (size_t)(l * 9 + ci) * NADA + 5 * 2048; cci = ci;
#pragma unroll
            for (int i = 0; i < 8; ++i) g2v[i] = *(const float4*)(g2 + i * 256 + F.lane * 4); }
        float4 v[8]; float s = 0.f;
#pragma unroll
        for (int i = 0; i < 8; ++i) { const float4 x = xv[i], g = g2v[i], f = fv[i];
            v[i].x = ALPHA * x.x + g.x * f.x; v[i].y = ALPHA * x.y + g.y * f.y; v[i].z = ALPHA * x.z + g.z * f.z; v[i].w = ALPHA * x.w + g.w * f.w; s += (v[i].x + v[i].y) + (v[i].z + v[i].w); }
        float mean = wsum(s) * (1.f / 2048.f); float q = 0.f;
#pragma unroll
        for (int i = 0; i < 8; ++i) { const float a = v[i].x - mean, b = v[i].y - mean, c = v[i].z - mean, d = v[i].w - mean; q += (a * a + b * b) + (c * c + d * d); }
        float rstd = rsqrtf(wsum(q) * (1.f / 2048.f) + LN_EPS);
        s = 0.f;
#pragma unroll
        for (int i = 0; i < 8; ++i) { const int col = i * 256 + F.lane * 4; const f32x4 g = *(const LAS f32x4*)(PL + 4096 + i * 256 + lo4), bb = *(const LAS f32x4*)(PL + 6144 + i * 256 + lo4);
            v[i].x = (v[i].x - mean) * rstd * g.x + bb.x; v[i].y = (v[i].y - mean) * rstd * g.y + bb.y; v[i].z = (v[i].z - mean) * rstd * g.z + bb.z; v[i].w = (v[i].w - mean) * rstd * g.w + bb.w;
            *(float4*)(xr + col) = v[i]; s += (v[i].x + v[i].y) + (v[i].z + v[i].w); }
        if (l == 0) {
            const float* md = F.MOD + (size_t)(9 + ci) * NADA;
            float4 shn[8], scn[8];
#pragma unroll
            for (int i = 0; i < 8; ++i) { shn[i] = *(const float4*)(md + i * 256 + F.lane * 4); scn[i] = *(const float4*)(md + 2048 + i * 256 + F.lane * 4); }
            mean = wsum(s) * (1.f / 2048.f); q = 0.f;
#pragma unroll
            for (int i = 0; i < 8; ++i) { const float a = v[i].x - mean, b = v[i].y - mean, c = v[i].z - mean, d = v[i].w - mean; q += (a * a + b * b) + (c * c + d * d); }
            rstd = rsqrtf(wsum(q) * (1.f / 2048.f) + LN_EPS);
            float am = 0.f;
#pragma unroll
            for (int i = 0; i < 8; ++i) { const int col = i * 256 + F.lane * 4;
                const float4 sh = shn[i], sc = scn[i];
                float4 h; h.x = (v[i].x - mean) * rstd * (1.f + sc.x) + sh.x; h.y = (v[i].y - mean) * rstd * (1.f + sc.y) + sh.y; h.z = (v[i].z - mean) * rstd * (1.f + sc.z) + sh.z; h.w = (v[i].w - mean) * rstd * (1.f + sc.w) + sh.w;
                if (row < TCTX) { u32x2 o; o.x = cvt_pk_bf16(h.x, h.y); o.y = cvt_pk_bf16(h.z, h.w); *(u32x2*)(F.H + (size_t)row * D + col) = o; }
                v[i] = h; am = fmaxf(am, fmaxf(fmaxf(fabsf(h.x), fabsf(h.y)), fmaxf(fabsf(h.z), fabsf(h.w)))); }
            am = wmax(am);
            const float hs = am > 0.f ? am * (1.f / 127.f) : 1.f, hinv = 1.f / hs;
#pragma unroll
            for (int i = 0; i < 8; ++i) *(unsigned*)(F.ws + WS_H8IN + (size_t)row * D + i * 256 + F.lane * 4) = pack_i8(v[i].x * hinv, v[i].y * hinv, v[i].z * hinv, v[i].w * hinv);
            if (F.lane == 0) ((float*)(F.ws + WS_HSIN))[row] = hs;
        }
#pragma unroll
        for (int i = 0; i < 8; ++i) xv[i] = xn[i];
    }
}

constexpr int N_PHASES = 25;
__global__ void __launch_bounds__(512, 2) hybrid_fwd(Args args) {
    extern __shared__ __attribute__((aligned(16))) unsigned char lds_raw[];
    Frame0 F; F.lds = (LAS unsigned char*)lds_raw;
    const int lo = args.ph_lo, hi = args.ph_hi;
#if MK_ONE_LAUNCH
    volatile LAS unsigned* misc = (volatile LAS unsigned*)(F.lds + MISC_OFF);
    if (threadIdx.x < 16) misc[threadIdx.x] = 0u;
    __syncthreads();
    XcdBarrier bar = xcd_barrier_post((unsigned*)(args.ws + WS_BAR), misc);
#define SEAM(k) do { xcd_barrier(bar); } while (0)
#else
#define SEAM(k) do { } while (0)
#endif
#define NREP(k) ((args.rep == (k)) ? 2 : 1)
#ifndef PH_ONLY
#define PH_ONLY -1
#endif
#define IN(k) (lo <= (k) && (k) < hi && (PH_ONLY < 0 || ((k) == 0 ? 0 : ((k) - 1) % 12 + 1) == PH_ONLY))
    if (IN(0)) { for (int r = NREP(13); r > 0; --r) { phase_prologue(F); SEAM(0); } }
    for (int l = 0; l < 2; ++l) {
        const int pb = 1 + 12 * l;
        if (IN(pb + 0) && l == 0) { for (int r = NREP(1); r > 0; --r) { phase_lnmod(F, l); SEAM(pb + 0); } }
        if (IN(pb + 1)) { for (int r = NREP(2); r > 0; --r) { phase_gemm_in(F, l); SEAM(pb + 1); } }
        if (IN(pb + 2)) { for (int r = NREP(3); r > 0; --r) { phase_conv(F, l); SEAM(pb + 2); } }
        if (IN(pb + 3)) { phase_gemm_a(F, l); SEAM(pb + 3); }
        if (IN(pb + 4)) {
#ifndef NO_PREP
            for (int r = NREP(4); r > 0; --r) { phase_gla_prep(F, l); SEAM(pb + 4); }
#endif
#ifndef NO_SCAN
            for (int r = NREP(5); r > 0; --r) { phase_gla_scan(F, l); SEAM(pb + 4); }
#endif
        }
        if (IN(pb + 5)) { for (int r = NREP(6); r > 0; --r) { phase_postgla(F, l); SEAM(pb + 5); } }
        if (IN(pb + 6)) { phase_gemm_b(F, l); SEAM(pb + 6); }
        if (IN(pb + 7)) { phase_gemm_o(F, l); SEAM(pb + 7); }
        if (IN(pb + 8)) { phase_ln2(F, l); conv_tables(F, l); SEAM(pb + 8); }
        if (IN(pb + 9)) { for (int r = NREP(10); r > 0; --r) { phase_gemm_pq(F, l); SEAM(pb + 9); } }
        if (IN(pb + 10)) { for (int r = NREP(11); r > 0; --r) { phase_peer_score(F, l); SEAM(pb + 10); } }
        if (IN(pb + 11)) {
            for (int r = NREP(20); r > 0; --r) { phase_peer_bucket(F); SEAM(pb + 11); }
            for (int r = NREP(21); r > 0; --r) { phase_peer_u(F, l); SEAM(pb + 11); }
            for (int r = NREP(22); r > 0; --r) { phase_peer_coef(F); SEAM(pb + 11); }
            phase_peer_pack(F); SEAM(pb + 11);
            for (int r = NREP(23); r > 0; --r) { phase_peer_v(F); SEAM(pb + 11); }
            phase_peer_final(F, l); SEAM(pb + 11); }
    }
#undef IN
#undef SEAM
}

extern "C" void kernel_launch(void* const* d_in, const int* in_sizes, int n_in, void* d_out, int out_size, void* d_ws, size_t ws_size, hipStream_t stream) {
    static int grid = 0;
    if (grid == 0) {
        if (n_in != 21 || ws_size < WS_END) { fprintf(stderr, "kernel_launch: unexpected inputs (n_in %d) or workspace %zu < %zu\n", n_in, ws_size, (size_t)WS_END); grid = -1; return; }
        int dev = 0, cus = 0, per_cu = 0;
        if (hipGetDevice(&dev) != hipSuccess || hipDeviceGetAttribute(&cus, hipDeviceAttributeMultiprocessorCount, dev) != hipSuccess) { grid = -1; return; }
        if (hipFuncSetAttribute((const void*)hybrid_fwd, hipFuncAttributeMaxDynamicSharedMemorySize, LDS_TOTAL) != hipSuccess) { fprintf(stderr, "kernel_launch: hipFuncSetAttribute failed\n"); grid = -1; return; }
        if (hipOccupancyMaxActiveBlocksPerMultiprocessor(&per_cu, (const void*)hybrid_fwd, 512, LDS_TOTAL) != hipSuccess || per_cu < 1) { fprintf(stderr, "kernel_launch: occupancy query says %d\n", per_cu); }
        (void)hipGetLastError();
        grid = cus;
    }
    if (grid < 0) return;
    (void)hipMemsetAsync((char*)d_ws + WS_BAR, 0, 16384, stream);
    Args a{};
    for (int i = 0; i < 21; ++i) a.in[i] = (const float*)d_in[i];
    a.out = (float*)d_out; a.ws = (unsigned char*)d_ws;
#ifndef PROBE_REP
#define PROBE_REP 0
#endif
    a.rep = PROBE_REP; a.pad = 0;
#if MK_ONE_LAUNCH
    a.ph_lo = 0; a.ph_hi = N_PHASES;
    hipLaunchKernelGGL(hybrid_fwd, dim3(grid), dim3(512), LDS_TOTAL, stream, a);
#else
    for (int p = 0; p < N_PHASES; ++p) { a.ph_lo = p; a.ph_hi = p + 1; hipLaunchKernelGGL(hybrid_fwd, dim3(grid), dim3(512), LDS_TOTAL, stream, a); }
#endif
}
```

```cpp
#include <hip/hip_runtime.h>
#include <cstdio>
#include <cstdint>

#ifndef STORE_POLICY
#define STORE_POLICY 1
#endif
#ifndef MK_ONE_LAUNCH
#define MK_ONE_LAUNCH 1
#endif

#define LAS __attribute__((address_space(3)))
typedef unsigned short bf16_t;
typedef short bf16x8 __attribute__((ext_vector_type(8)));
typedef float f32x4 __attribute__((ext_vector_type(4)));
typedef unsigned u32x4 __attribute__((ext_vector_type(4)));
typedef int i32x4 __attribute__((ext_vector_type(4)));
typedef unsigned u32x2 __attribute__((ext_vector_type(2)));
typedef __bf16 bf16x2_t __attribute__((ext_vector_type(2)));

constexpr int D = 2048, TCTX = 4096, TLAT = 32768, T = TCTX + TLAT;
constexpr int NINP = 13568;
constexpr int NADA = 12288;
constexpr float ALPHA = 1.41421356237f;
constexpr float LN_EPS = 1e-5f;
constexpr int LDS_TOTAL = 155648;
constexpr int MISC_OFF = LDS_TOTAL - 64;

constexpr size_t al256(size_t x) { return (x + 255) & ~(size_t)255; }
constexpr size_t WS_BAR = 0;
constexpr size_t WS_MOD = 16384;
constexpr size_t WS_WIN = WS_MOD + 1048576;
constexpr size_t WS_WA = WS_WIN + (size_t)2 * NINP * 2048 * 2;
constexpr size_t WS_WB = WS_WA + (size_t)2 * 2048 * 1024 * 2;
constexpr size_t WS_WO = WS_WB + (size_t)2 * 2048 * 2048 * 2;
constexpr size_t WS_WPQ = WS_WO + (size_t)2 * 2048 * 2048 * 2;
constexpr size_t WS_H = WS_WPQ + (size_t)2 * 2048 * 2048 * 2;
constexpr size_t WS_Z1 = WS_H + (size_t)T * 2048 * 2;
constexpr size_t WS_Z2 = WS_Z1 + (size_t)T * 3072 * 2;
constexpr size_t WS_Z3 = WS_Z2 + (size_t)T * 4096 * 2;
constexpr size_t WS_Z4 = WS_Z3 + (size_t)T * 2048 * 2;
constexpr size_t WS_U16 = WS_Z4;
constexpr size_t WS_V8 = WS_U16 + (size_t)16384 * 2048 * 2;
constexpr size_t WS_VS = WS_V8 + (size_t)16384 * 2048;
constexpr size_t WS_Z5 = WS_Z4 + (size_t)T * 4096 * 2;
constexpr size_t WS_END0 = WS_Z5 + (size_t)T * 32 * 4;
constexpr size_t WS_H8IN = al256(WS_END0);
constexpr size_t WS_W8IN = WS_H8IN + (size_t)T * 2048;
constexpr size_t WS_CSIN = WS_W8IN + (size_t)2 * NINP * 2048;
constexpr size_t WS_HSIN = WS_CSIN + (size_t)2 * NINP * 4;
constexpr size_t WS_ASIN = WS_HSIN + (size_t)T * 4;
constexpr size_t WS_END = WS_ASIN + (size_t)T * 4;

__device__ __forceinline__ unsigned cvt_pk_bf16(float lo, float hi) { unsigned r; asm("v_cvt_pk_bf16_f32 %0, %1, %2" : "=v"(r) : "v"(lo), "v"(hi)); return r; }
__device__ __forceinline__ bf16_t f2bf(float x) { return (bf16_t)(cvt_pk_bf16(x, 0.f) & 0xffffu); }
__device__ __forceinline__ float bf_lo(unsigned w) { return __uint_as_float(w << 16); }
__device__ __forceinline__ float bf_hi(unsigned w) { return __uint_as_float(w & 0xffff0000u); }
__device__ __forceinline__ float bf1(bf16_t u) { return __uint_as_float((unsigned)u << 16); }
__device__ __forceinline__ float wmax(float v) {
#pragma unroll
    for (int sh = 32; sh >= 1; sh >>= 1) v = fmaxf(v, __shfl_xor(v, sh));
    return v; }
__device__ __forceinline__ unsigned pack_i8(float a, float b, float c, float d) { const int q0 = __float2int_rn(a), q1 = __float2int_rn(b), q2 = __float2int_rn(c), q3 = __float2int_rn(d);
    return ((unsigned)q0 & 255u) | (((unsigned)q1 & 255u) << 8) | (((unsigned)q2 & 255u) << 16) | ((unsigned)q3 << 24); }
__device__ __forceinline__ float wsum(float v) {
#pragma unroll
    for (int m = 32; m >= 1; m >>= 1) v += __shfl_xor(v, m);
    return v;
}
__device__ __forceinline__ float sigmoidf_(float x) { return __builtin_amdgcn_rcpf(1.f + __expf(-x)); }
__device__ __forceinline__ float siluf_(float x) { return x * sigmoidf_(x); }
__device__ __forceinline__ float gelu_tanh(float x) {
    const float y = 0.7978845608028654f * (x + 0.044715f * x * x * x);
    const float e = __expf(2.f * y);
    const float th = 1.f - 2.f * __builtin_amdgcn_rcpf(e + 1.f);
    return 0.5f * x * (1.f + th);
}
__device__ __forceinline__ float dot2bf(unsigned a, unsigned b, float acc) { return __builtin_amdgcn_fdot2_f32_bf16(__builtin_bit_cast(bf16x2_t, a), __builtin_bit_cast(bf16x2_t, b), acc, false); }

#define XB_TMO      128
#define XB_XCNT(j)  (256  + 64 * (j))
#define XB_XSUB(j)  (1280 + 64 * (j))
#define XB_XGEN(j)  (2304 + 64 * (j))
#define XB_TOP      3328
#define XB_TOPGEN   3392
#define XCD_BAR_WORDS 3456
#define XB_SPIN_CAP (1u << 18)
__device__ __forceinline__ unsigned xb_ld(unsigned* p)              { return __hip_atomic_load(p, __ATOMIC_RELAXED, __HIP_MEMORY_SCOPE_AGENT); }
__device__ __forceinline__ unsigned xb_add(unsigned* p, unsigned v) { return __hip_atomic_fetch_add(p, v, __ATOMIC_RELAXED, __HIP_MEMORY_SCOPE_AGENT); }
__device__ __forceinline__ unsigned xb_xcc_id() { return (unsigned)__builtin_amdgcn_s_getreg((3 << 11) | 20) & 0xFu; }
#define XB_SPIN(cond, bar) do { unsigned _sp = 0; while (cond) { __builtin_amdgcn_s_sleep(1); \
    if ((++_sp & 255u) == 0u) { if (xb_ld(&(bar)[XB_TMO])) break; if (_sp > XB_SPIN_CAP) { atomicAdd(&(bar)[XB_TMO], 1u); break; } } } } while (0)
struct XcdBarrier { unsigned* bar; unsigned x; volatile LAS unsigned* st; };
__device__ __forceinline__ XcdBarrier xcd_barrier_post(unsigned* bar, volatile LAS unsigned* st) {
    XcdBarrier b; b.bar = bar; b.x = xb_xcc_id(); b.st = st;
    if (threadIdx.x == 0) (void)xb_add(&bar[XB_XCNT(b.x)], 1u);
    return b;
}
__device__ __forceinline__ void xcd_barrier_complete(unsigned* bar, unsigned x, unsigned& nloc, unsigned& nx) {
    const unsigned G = gridDim.x * gridDim.y * gridDim.z;
    unsigned sum, cnt, mine, sp = 0u;
    for (;;) {
        sum = 0u; cnt = 0u; mine = 0u;
#pragma unroll
        for (unsigned j = 0; j < 16; ++j) { const unsigned c = xb_ld(&bar[XB_XCNT(j)]); sum += c; cnt += (c > 0u) ? 1u : 0u; mine = (j == x) ? c : mine; }
        if (sum == G) break;
        __builtin_amdgcn_s_sleep(1);
        if ((++sp & 255u) == 0u) { if (xb_ld(&bar[XB_TMO])) break; if (sp > XB_SPIN_CAP) { atomicAdd(&bar[XB_TMO], 1u); break; } }
    }
    nloc = mine > 0u ? mine : 1u; nx = cnt > 0u ? cnt : 1u;
}
__device__ __forceinline__ void xcd_barrier(const XcdBarrier& b) {
    asm volatile("s_waitcnt vmcnt(0)" ::: "memory");
    __syncthreads();
    if (threadIdx.x == 0) {
        unsigned* bar = b.bar;
        __builtin_amdgcn_s_waitcnt(0);
        unsigned nloc = b.st[0], nx = b.st[1];
        if (nloc == 0u) { xcd_barrier_complete(bar, b.x, nloc, nx); b.st[0] = nloc; b.st[1] = nx; }
        const unsigned old = xb_add(&bar[XB_XSUB(b.x)], 1u);
        const unsigned gen = old / nloc;
        if (old + 1u == (gen + 1u) * nloc) {
            __builtin_amdgcn_fence(__ATOMIC_RELEASE, "agent");
            asm volatile("s_waitcnt vmcnt(0)" ::: "memory");
            const unsigned og = xb_add(&bar[XB_TOP], 1u);
            const unsigned tg = og / nx;
            if (og + 1u == (tg + 1u) * nx) xb_add(&bar[XB_TOPGEN], 1u);
            else XB_SPIN(xb_ld(&bar[XB_TOPGEN]) == tg, bar);
            __builtin_amdgcn_fence(__ATOMIC_ACQUIRE, "agent");
            xb_add(&bar[XB_XGEN(b.x)], 1u);
            asm volatile("s_waitcnt vmcnt(0)" ::: "memory");
        } else {
            XB_SPIN(xb_ld(&bar[XB_XGEN(b.x)]) == gen, bar);
            __builtin_amdgcn_fence(__ATOMIC_ACQUIRE, "agent");
            asm volatile("s_waitcnt vmcnt(0)" ::: "memory");
        }
    }
    __syncthreads();
}

namespace pg8 {
#define PG8_LAS __attribute__((address_space(3)))
constexpr int BM = 256, BK = 64, HALF = 128, HTB = HALF * BK * 2, STAGE_BYTES = 8 * HTB, NXCD = 8, WGM = 8;
__host__ __device__ __forceinline__ int lds_byte(int r, int c) { const int st = (r >> 4) * 2 + (c >> 5), rr = r & 15, cc = c & 31, ob = rr * 64 + cc * 2; return st * 1024 + (ob ^ (((ob >> 9) & 1) << 5)); }
__host__ __device__ __forceinline__ void stage_rc(int b, int& R, int& C) { const int st = b / 1024, sb = b % 1024, swz = sb ^ (((sb >> 9) & 1) << 5); R = (st >> 1) * 16 + swz / 64; C = (st & 1) * 32 + (swz % 64) / 2; }
__host__ __device__ __forceinline__ int perm32(int rho) { const int n = rho >> 4, i = rho & 15; return 8 * (i >> 2) + 4 * n + (i & 3); }
struct Unit { int pm, pn; };
struct Gemm { const bf16_t* A; const bf16_t* Bt; int M, N, K; };
struct StaticOrder {
    int nM, nN, nwg, G, c;
    __host__ __device__ void init(int M, int N, int G_, int c_) { nM = M / BM; nN = N / BM; nwg = nM * nN; G = G_; c = c_; }
    __host__ __device__ bool next(int i, Unit& u) const {
        const long L = (long)i * G + c; if (L >= nwg) return false;
        int wgid = (int)L; { const int q = nwg / NXCD, r = nwg % NXCD, xcd = wgid % NXCD, off = wgid / NXCD; wgid = (xcd < r ? xcd * (q + 1) : r * (q + 1) + (xcd - r) * q) + off; }
        const int nig = WGM * nN, gid = wgid / nig, fm = gid * WGM, gsz = (nM - fm) < WGM ? (nM - fm) : WGM;
        u.pm = fm + ((wgid % nig) % gsz); u.pn = (wgid % nig) / gsz; return true;
    }
    __device__ __forceinline__ void a_ready(const Unit&) const {}
    __device__ __forceinline__ void done(const Unit&) const {}
};

template <bool I8> struct AccT { typedef f32x4 type; };
template <> struct AccT<true> { typedef i32x4 type; };
template <class Epi, class Sched, bool ALIGN_EPI = false, bool SP2 = false, bool I8 = false>
__device__ __forceinline__ void gemm_phase(PG8_LAS unsigned char* lds, const Gemm g, const Sched& S, const Epi& E) {
    int tid_ = threadIdx.x; asm volatile("" : "+v"(tid_));
    const int tid = tid_, wid = __builtin_amdgcn_readfirstlane(tid >> 6), lane = tid & 63, wr = wid >> 2, wc = wid & 3, fr = lane & 15, fq = lane >> 4;
    const int K = g.K, nt = I8 ? K / (2 * BK) : K / BK; const unsigned KB = I8 ? (unsigned)K : 2u * (unsigned)K;
    typedef typename AccT<I8>::type acc_t;
    unsigned voffA[2], voffB[2];
#pragma unroll
    for (int i = 0; i < 2; ++i) { int R, C; stage_rc(tid * 16 + i * 8192, R, C); const int Rb = 64 * (R >> 5) + (Epi::PERM ? perm32(R & 31) : (R & 31));
        voffA[i] = (unsigned)R * KB + (unsigned)C * 2u; voffB[i] = (unsigned)Rb * KB + (unsigned)C * 2u; }
    const size_t kstep = (size_t)(BK * 2);
    const size_t hstep = (size_t)HALF * KB;
    const size_t hstepB = (size_t)32 * KB;
    const size_t tstep = 2 * hstep;
    const unsigned ldsw = (unsigned)wid * 1024u;
    const int aoff = lds_byte(wr * 64 + fr, fq * 8), boff = lds_byte(wc * 32 + fr, fq * 8);
#define PG8_SA(b, h) (((b) * 2 + (h)) * HTB)
#define PG8_SB(b, h) ((4 + (b) * 2 + (h)) * HTB)
#define PG8_STAGE(bufoff, gbase, voff) do { _Pragma("unroll") for (int _i = 0; _i < 2; ++_i) \
        __builtin_amdgcn_global_load_lds((const unsigned*)((const char*)(gbase) + (voff)[_i]), (PG8_LAS unsigned*)(lds + (bufoff) + ldsw + _i * 8192), 16, 0, 0); } while (0)
#define PG8_LDA(dst, b, h) do { _Pragma("unroll") for (int m = 0; m < 4; ++m) _Pragma("unroll") for (int k = 0; k < 2; ++k) dst[m][k] = *(const PG8_LAS bf16x8*)(lds + PG8_SA(b, h) + aoff + m * 2048 + k * 1024); } while (0)
#define PG8_LDB(dst, b, h) do { _Pragma("unroll") for (int n = 0; n < 2; ++n) _Pragma("unroll") for (int k = 0; k < 2; ++k) dst[n][k] = *(const PG8_LAS bf16x8*)(lds + PG8_SB(b, h) + boff + n * 2048 + k * 1024); } while (0)
#define PG8_MMA(ai, bj, At, Bt) do { __builtin_amdgcn_s_setprio(1); _Pragma("unroll") for (int m = 0; m < 4; ++m) _Pragma("unroll") for (int n = 0; n < 2; ++n) _Pragma("unroll") for (int k = 0; k < 2; ++k) \
        { if constexpr (I8) acc[ai][bj][m][n] = __builtin_amdgcn_mfma_i32_16x16x64_i8(__builtin_bit_cast(i32x4, Bt[n][k]), __builtin_bit_cast(i32x4, At[m][k]), acc[ai][bj][m][n], 0, 0, 0); \
          else acc[ai][bj][m][n] = __builtin_amdgcn_mfma_f32_16x16x32_bf16(Bt[n][k], At[m][k], acc[ai][bj][m][n], 0, 0, 0); } __builtin_amdgcn_s_setprio(0); } while (0)
#define PG8_WAIT_V(n) asm volatile("s_waitcnt vmcnt(" #n ")" ::: "memory")
#define PG8_WAIT_L(n) asm volatile("s_waitcnt lgkmcnt(" #n ")" ::: "memory")
#define PG8_BAR __builtin_amdgcn_s_barrier()
#define PG8_SCHED __builtin_amdgcn_sched_barrier(0)
    Unit cur, nxt; int ui = 0;
    if (!S.next(0, cur)) return;
    acc_t acc[2][2][4][2];
#pragma unroll
    for (int a = 0; a < 2; ++a)
#pragma unroll
        for (int b = 0; b < 2; ++b)
#pragma unroll
            for (int m = 0; m < 4; ++m)
#pragma unroll
                for (int n = 0; n < 2; ++n) acc[a][b][m][n] = (acc_t){0, 0, 0, 0};
    bf16x8 At[4][2], B0[2][2], B1[2][2];
    const char* cA = (const char*)g.A + (size_t)cur.pm * tstep; const char* cB = (const char*)g.Bt + (size_t)cur.pn * tstep;
    S.a_ready(cur);
    if constexpr (SP2) {
        PG8_STAGE(PG8_SB(0, 0), cB, voffB); PG8_STAGE(PG8_SB(0, 1), cB + hstepB, voffB); PG8_STAGE(PG8_SA(0, 0), cA, voffA); PG8_STAGE(PG8_SA(0, 1), cA + hstep, voffA);
        if (wr == 1) PG8_BAR;
        PG8_WAIT_V(2); PG8_BAR;
        PG8_STAGE(PG8_SB(1, 0), cB + kstep, voffB); PG8_STAGE(PG8_SA(1, 0), cA + kstep, voffA); PG8_STAGE(PG8_SB(1, 1), cB + hstepB + kstep, voffB);
        PG8_WAIT_V(6); PG8_BAR;
    } else {
        PG8_STAGE(PG8_SB(0, 0), cB, voffB); PG8_STAGE(PG8_SA(0, 0), cA, voffA); PG8_STAGE(PG8_SB(0, 1), cB + hstepB, voffB); PG8_STAGE(PG8_SA(0, 1), cA + hstep, voffA);
        if (wr == 1) PG8_BAR;
        PG8_WAIT_V(4); PG8_BAR;
        PG8_STAGE(PG8_SB(1, 0), cB + kstep, voffB); PG8_STAGE(PG8_SA(1, 0), cA + kstep, voffA); PG8_STAGE(PG8_SB(1, 1), cB + hstepB + kstep, voffB);
        PG8_WAIT_V(6); PG8_BAR;
    }
    for (;;) {
        const bool has_next = S.next(ui + 1, nxt);
        const char* nA = has_next ? (const char*)g.A + (size_t)nxt.pm * tstep : cA; const char* nB = has_next ? (const char*)g.Bt + (size_t)nxt.pn * tstep : cB;
        for (int t = 0; t < nt; t += 2) {
            const bool last = (t == nt - 2);
            const char* a1 = cA + (size_t)(t + 1) * kstep;
            const char* a2 = last ? nA : cA + (size_t)(t + 2) * kstep; const char* b2 = last ? nB : cB + (size_t)(t + 2) * kstep;
            const char* a3 = a2 + kstep; const char* b3 = b2 + kstep;
            if (last && has_next) S.a_ready(nxt);
            if constexpr (SP2) {
            PG8_LDB(B0, 0, 0); PG8_LDB(B1, 0, 1); PG8_SCHED; PG8_LDA(At, 0, 0); PG8_STAGE(PG8_SA(1, 1), a1 + hstep, voffA);
            PG8_WAIT_V(8); PG8_WAIT_L(0); PG8_BAR; PG8_MMA(0, 0, At, B0); PG8_MMA(0, 1, At, B1); PG8_BAR; PG8_SCHED;
            PG8_LDA(At, 0, 1); PG8_STAGE(PG8_SB(0, 0), b2, voffB); PG8_STAGE(PG8_SB(0, 1), b2 + hstepB, voffB); PG8_STAGE(PG8_SA(0, 0), a2, voffA);
            PG8_WAIT_V(8); PG8_WAIT_L(0); PG8_BAR; PG8_MMA(1, 0, At, B0); PG8_MMA(1, 1, At, B1); PG8_BAR; PG8_SCHED;
            PG8_LDB(B0, 1, 0); PG8_LDB(B1, 1, 1); PG8_SCHED; PG8_LDA(At, 1, 0); PG8_STAGE(PG8_SA(0, 1), a2 + hstep, voffA);
            PG8_WAIT_V(8); PG8_WAIT_L(0); PG8_BAR; PG8_MMA(0, 0, At, B0); PG8_MMA(0, 1, At, B1); PG8_BAR; PG8_SCHED;
            PG8_LDA(At, 1, 1); PG8_STAGE(PG8_SB(1, 0), b3, voffB); PG8_STAGE(PG8_SB(1, 1), b3 + hstepB, voffB); PG8_STAGE(PG8_SA(1, 0), a3, voffA);
            PG8_WAIT_V(8); PG8_WAIT_L(0); PG8_BAR; PG8_MMA(1, 0, At, B0); PG8_MMA(1, 1, At, B1); PG8_BAR; PG8_SCHED;
            } else {
            PG8_LDB(B0, 0, 0); PG8_SCHED; PG8_LDA(At, 0, 0); PG8_STAGE(PG8_SA(1, 1), a1 + hstep, voffA);
            PG8_WAIT_L(8); PG8_BAR; PG8_WAIT_L(0); PG8_MMA(0, 0, At, B0); PG8_BAR; PG8_SCHED;
            PG8_LDB(B1, 0, 1); PG8_STAGE(PG8_SB(0, 0), b2, voffB);
            PG8_BAR; PG8_WAIT_L(0); PG8_MMA(0, 1, At, B1); PG8_BAR;
            PG8_LDA(At, 0, 1); PG8_STAGE(PG8_SA(0, 0), a2, voffA);
            PG8_BAR; PG8_WAIT_L(0); PG8_MMA(1, 0, At, B0); PG8_BAR; PG8_SCHED;
            PG8_STAGE(PG8_SB(0, 1), b2 + hstepB, voffB);
            PG8_WAIT_V(6); PG8_BAR; PG8_MMA(1, 1, At, B1); PG8_BAR;
            PG8_LDB(B0, 1, 0); PG8_SCHED; PG8_LDA(At, 1, 0); PG8_STAGE(PG8_SA(0, 1), a2 + hstep, voffA);
            PG8_WAIT_L(8); PG8_BAR; PG8_WAIT_L(0); PG8_MMA(0, 0, At, B0); PG8_BAR; PG8_SCHED;
            PG8_LDB(B1, 1, 1); PG8_STAGE(PG8_SB(1, 0), b3, voffB);
            PG8_BAR; PG8_WAIT_L(0); PG8_MMA(0, 1, At, B1); PG8_BAR;
            PG8_LDA(At, 1, 1); PG8_STAGE(PG8_SA(1, 0), a3, voffA);
            PG8_BAR; PG8_WAIT_L(0); PG8_MMA(1, 0, At, B0); PG8_BAR; PG8_SCHED;
            PG8_STAGE(PG8_SB(1, 1), b3 + hstepB, voffB);
            PG8_WAIT_V(6); PG8_BAR; PG8_MMA(1, 1, At, B1); PG8_BAR;
            }
        }
        if constexpr (ALIGN_EPI) { if (wr == 0) PG8_BAR; }
        E(acc, cur, wr, wc, fr, fq); S.done(cur);
        if (!has_next) break;
#pragma unroll
        for (int a = 0; a < 2; ++a)
#pragma unroll
            for (int b = 0; b < 2; ++b)
#pragma unroll
                for (int m = 0; m < 4; ++m)
#pragma unroll
                    for (int n = 0; n < 2; ++n) acc[a][b][m][n] = (acc_t){0, 0, 0, 0};
        cur = nxt; cA = nA; cB = nB; ++ui;
        if constexpr (ALIGN_EPI) { if (wr == 1) PG8_BAR; }
    }
    PG8_WAIT_V(0);
    if constexpr (!ALIGN_EPI) { if (wr == 0) PG8_BAR; }
    PG8_BAR;
#undef PG8_SA
#undef PG8_SB
#undef PG8_STAGE
#undef PG8_LDA
#undef PG8_LDB
#undef PG8_MMA
#undef PG8_WAIT_V
#undef PG8_WAIT_L
#undef PG8_BAR
#undef PG8_SCHED
}
}

struct Args { const float* in[21]; float* out; unsigned char* ws; int ph_lo, ph_hi, rep, pad; };
struct Frame0 { LAS unsigned char* lds; };
struct Frame {
    LAS unsigned char* lds; int tid, lane, wave, bid, nb;
    const float *x_prompt, *x_sample, *state, *cvec, *cctx, *w_in, *w_conv, *w_a, *w_gk, *b_gk, *w_gn, *w_b, *w_o, *w_ada, *b_ada, *ln_g, *ln_b, *w_pq, *pkeys, *peer_u, *peer_v;
    float* out; unsigned char* ws;
    float* MOD; bf16_t *WIN, *WA, *WB, *WO, *WPQ, *U16; unsigned char* V8; float* VS; float* XA; bf16_t *H, *Z1, *Z2, *Z3, *Z4; float* Z5;
};
typedef const __attribute__((address_space(4))) Args* KArgs;
__device__ __forceinline__ void fill_frame(Frame& F, const Frame0& F0) {
    auto kp = __builtin_amdgcn_kernarg_segment_ptr();
    asm volatile("" : "+s"(kp));
    KArgs A = (KArgs)kp;
    int t_ = threadIdx.x; asm volatile("" : "+v"(t_));
    F.lds = F0.lds; F.tid = t_; F.lane = t_ & 63; F.wave = __builtin_amdgcn_readfirstlane(t_ >> 6); F.bid = blockIdx.x; F.nb = gridDim.x;
    F.x_prompt = A->in[0]; F.x_sample = A->in[1]; F.state = A->in[2]; F.cvec = A->in[3]; F.cctx = A->in[4]; F.w_in = A->in[5]; F.w_conv = A->in[6]; F.w_a = A->in[7];
    F.w_gk = A->in[8]; F.b_gk = A->in[9]; F.w_gn = A->in[10]; F.w_b = A->in[11]; F.w_o = A->in[12]; F.w_ada = A->in[13]; F.b_ada = A->in[14]; F.ln_g = A->in[15]; F.ln_b = A->in[16];
    F.w_pq = A->in[17]; F.pkeys = A->in[18]; F.peer_u = A->in[19]; F.peer_v = A->in[20];
    F.out = A->out; unsigned char* ws = A->ws; F.ws = ws;
    F.MOD = (float*)(ws + WS_MOD); F.WIN = (bf16_t*)(ws + WS_WIN); F.WA = (bf16_t*)(ws + WS_WA); F.WB = (bf16_t*)(ws + WS_WB); F.WO = (bf16_t*)(ws + WS_WO); F.WPQ = (bf16_t*)(ws + WS_WPQ);
    F.U16 = (bf16_t*)(ws + WS_U16); F.V8 = ws + WS_V8; F.VS = (float*)(ws + WS_VS); F.XA = A->out; F.H = (bf16_t*)(ws + WS_H);
    F.Z1 = (bf16_t*)(ws + WS_Z1); F.Z2 = (bf16_t*)(ws + WS_Z2); F.Z3 = (bf16_t*)(ws + WS_Z3); F.Z4 = (bf16_t*)(ws + WS_Z4); F.Z5 = (float*)(ws + WS_Z5);
}
#define PHASE_IDS(F0_) Frame F; fill_frame(F, F0_)
__device__ __forceinline__ const float* xrow_in(const Frame& F, int l, int row) {
    if (l == 0) return row < TCTX ? F.x_prompt + (size_t)row * D : F.x_sample + (size_t)(row - TCTX) * D;
    return F.out + (size_t)row * D;
}
__device__ __forceinline__ int cond_of(int row) { return row < TCTX ? 8 : ((row - TCTX) >> 12); }

__device__ __forceinline__ void phase_mod(const Frame0& F0) {
    PHASE_IDS(F0);
    LAS float* sl = (LAS float*)F.lds;
    LAS float* red = (LAS float*)(F.lds + 73728);
    for (int i = F.tid; i < 9 * 2048; i += 512) { const int ci = i >> 11, dd = i & 2047; const float c = ci < 8 ? F.cvec[ci * 2048 + dd] : F.cctx[dd]; sl[i] = siluf_(c); }
    __syncthreads();
    const int cg = F.tid & 15, ks = F.tid >> 4;
    for (int u = F.bid; u < 2 * 192; u += F.nb) {
        const int l = u / 192, c0 = (u % 192) * 64;
        float acc[9][4];
#pragma unroll
        for (int ci = 0; ci < 9; ++ci)
#pragma unroll
            for (int j = 0; j < 4; ++j) acc[ci][j] = 0.f;
        const float* wp = F.w_ada + ((size_t)l * 2048 + ks * 64) * NADA + c0 + cg * 4;
#pragma unroll 4
        for (int r = 0; r < 64; ++r) {
            const float4 w = *(const float4*)(wp + (size_t)r * NADA);
#pragma unroll
            for (int ci = 0; ci < 9; ++ci) { const float s = sl[ci * 2048 + ks * 64 + r]; acc[ci][0] += s * w.x; acc[ci][1] += s * w.y; acc[ci][2] += s * w.z; acc[ci][3] += s * w.w; }
        }
#pragma unroll
        for (int ci = 0; ci < 9; ++ci)
#pragma unroll
            for (int j = 0; j < 4; ++j) { float v = acc[ci][j]; v += __shfl_xor(v, 16); v += __shfl_xor(v, 32); acc[ci][j] = v; }
        if (F.lane < 16) {
#pragma unroll
            for (int ci = 0; ci < 9; ++ci)
#pragma unroll
                for (int j = 0; j < 4; ++j) red[(F.wave * 9 + ci) * 64 + cg * 4 + j] = acc[ci][j];
        }
        __syncthreads();
        for (int i = F.tid; i < 576; i += 512) { const int ci = i >> 6, c = i & 63; float s = 0.f;
#pragma unroll
            for (int w = 0; w < 8; ++w) s += red[(w * 9 + ci) * 64 + c];
            F.MOD[(size_t)(l * 9 + ci) * NADA + c0 + c] = s + F.b_ada[l * NADA + c0 + c]; }
        __syncthreads();
    }
}
template <class Map>
__device__ __forceinline__ void tr_convert(const Frame0& F0, const float* src, int ldsrc, bf16_t* dst, int K, int N, Map map) {
    PHASE_IDS(F0);
    LAS bf16_t* tile = (LAS bf16_t*)F.lds;
    const int ntn = N / 64, ntk = K / 256;
    for (int u = F.bid; u < ntn * ntk; u += F.nb) {
        const int n0 = (u / ntk) * 64, k0 = (u % ntk) * 256;
        const int nn = F.tid & 63, kq = F.tid >> 6;
        const int sc = map(n0 + nn);
        float vals[32];
#pragma unroll
        for (int i = 0; i < 32; ++i) { const int kk = i * 8 + kq; vals[i] = sc >= 0 ? src[(size_t)(k0 + kk) * ldsrc + sc] : 0.f; }
#pragma unroll
        for (int i = 0; i < 32; ++i) tile[nn * 258 + i * 8 + kq] = f2bf(vals[i]);
        __syncthreads();
#pragma unroll
        for (int i = 0; i < 4; ++i) { const int id = F.tid + 512 * i, r = id >> 5, kc = id & 31; const LAS unsigned* p = (const LAS unsigned*)(tile + r * 258 + kc * 8);
            uint4 o; o.x = p[0]; o.y = p[1]; o.z = p[2]; o.w = p[3];
            *(uint4*)(dst + (size_t)(n0 + r) * K + k0 + kc * 8) = o; }
        __syncthreads();
    }
}
template <class Map>
__device__ __forceinline__ void tr_strip8(const Frame& F, const float* src, int ldsrc, unsigned char* dst, float* scales, int K, int n0, Map map) {
    LAS unsigned char* tile = (LAS unsigned char*)F.lds;
    LAS float* red = (LAS float*)(F.lds + 64 * 272);
    const int nn = F.tid & 63, kq = F.tid >> 6;
    const int sc = map(n0 + nn);
    float m = 0.f;
    for (int i0 = 0; i0 < K / 8; i0 += 64) {
        float vals[64];
#pragma unroll
        for (int i = 0; i < 64; ++i) vals[i] = sc >= 0 ? src[(size_t)((i0 + i) * 8 + kq) * ldsrc + sc] : 0.f;
#pragma unroll
        for (int i = 0; i < 64; ++i) m = fmaxf(m, fabsf(vals[i]));
    }
    __syncthreads();
    red[kq * 64 + nn] = m;
    __syncthreads();
    if (F.tid < 64) { float mm = 0.f;
#pragma unroll
        for (int q = 0; q < 8; ++q) mm = fmaxf(mm, red[q * 64 + F.tid]);
        const float scl = mm > 0.f ? mm * (1.f / 127.f) : 1.f; scales[n0 + F.tid] = scl; red[512 + F.tid] = 1.f / scl; }
    __syncthreads();
    const float inv = red[512 + nn];
    for (int k0 = 0; k0 < K; k0 += 256) {
        float vals[32];
#pragma unroll
        for (int i = 0; i < 32; ++i) vals[i] = sc >= 0 ? src[(size_t)(k0 + i * 8 + kq) * ldsrc + sc] : 0.f;
#pragma unroll
        for (int i = 0; i < 32; ++i) tile[nn * 272 + i * 8 + kq] = (unsigned char)(__float2int_rn(vals[i] * inv) & 255);
        __syncthreads();
#pragma unroll
        for (int i = 0; i < 2; ++i) { const int id = F.tid + 512 * i, r = id >> 4, kc = id & 15; const u32x4 o = *(const LAS u32x4*)(tile + r * 272 + kc * 16);
            *(u32x4*)(dst + (size_t)(n0 + r) * K + k0 + kc * 16) = o; }
        __syncthreads();
    }
}
struct MapId { __device__ __forceinline__ int operator()(int n) const { return n; } };
struct MapInOff { int off; __device__ __forceinline__ int operator()(int n) const { n += off; return n < 9216 ? n : (n < 13312 ? n + 32 : (n < 13344 ? n - 13312 + 9216 : -1)); } };
struct MapIn { __device__ __forceinline__ int operator()(int n) const { return n < 9216 ? n : (n < 13312 ? n + 32 : (n < 13344 ? n - 13312 + 9216 : -1)); } };
__device__ __forceinline__ void conv_tables(const Frame0& F0, int l) {
    PHASE_IDS(F0);
    for (int e = F.bid * 8 + F.wave; e < 16384; e += F.nb * 8) {
        const float* s = F.peer_v + ((size_t)l * 16384 + e) * 2048;
        float4 v[8]; float m = 0.f;
#pragma unroll
        for (int i = 0; i < 8; ++i) { v[i] = *(const float4*)(s + i * 256 + F.lane * 4); m = fmaxf(m, fmaxf(fmaxf(fabsf(v[i].x), fabsf(v[i].y)), fmaxf(fabsf(v[i].z), fabsf(v[i].w)))); }
#pragma unroll
        for (int sh = 32; sh >= 1; sh >>= 1) m = fmaxf(m, __shfl_xor(m, sh));
        const float sc = m > 0.f ? m * (1.f / 127.f) : 1.f, inv = 1.f / sc;
#pragma unroll
        for (int i = 0; i < 8; ++i) *(unsigned*)(F.V8 + (size_t)e * 2048 + i * 256 + F.lane * 4) = pack_i8(v[i].x * inv, v[i].y * inv, v[i].z * inv, v[i].w * inv);
        if (F.lane == 0) F.VS[e] = sc;
    }
    for (int e = F.bid * 8 + F.wave; e < 16384; e += F.nb * 8) {
        const float* s = F.peer_u + ((size_t)l * 16384 + e) * 2048;
        float m = 0.f;
#pragma unroll
        for (int i = 0; i < 8; ++i) { const float4 v = *(const float4*)(s + i * 256 + F.lane * 4); m = fmaxf(m, fmaxf(fmaxf(fabsf(v.x), fabsf(v.y)), fmaxf(fabsf(v.z), fabsf(v.w)))); }
        m = wmax(m);
        if (F.lane == 0) F.VS[16384 + e] = m > 0.f ? m * (1.f / 127.f) : 1.f;
    }
}
__device__ __forceinline__ void phase_prologue(const Frame0& F0) {
    phase_mod(F0);
    {
        PHASE_IDS(F0);
        for (int sidx = F.bid; sidx < 2 * 308; sidx += F.nb) {
            const int l = sidx / 308, r = sidx % 308;
            if (r < 212) tr_strip8(F, F.w_in + (size_t)l * 2048 * 13344, 13344, F.ws + WS_W8IN + (size_t)l * NINP * 2048, (float*)(F.ws + WS_CSIN) + (size_t)l * NINP, 2048, r * 64, MapIn());
            else if (r < 244) tr_strip8(F, F.w_b + (size_t)l * 2048 * 2048, 2048, (unsigned char*)F.WB + (size_t)l * 2048 * 2048, (float*)((unsigned char*)F.WB + (size_t)2 * 2048 * 2048) + l * 2048, 2048, (r - 212) * 64, MapId());
            else if (r < 276) tr_strip8(F, F.w_pq + (size_t)l * 2048 * 2048, 2048, (unsigned char*)F.WPQ + (size_t)l * 2048 * 2048, (float*)((unsigned char*)F.WPQ + (size_t)2 * 2048 * 2048) + l * 2048, 2048, (r - 244) * 64, MapId());
            else tr_strip8(F, F.w_a + (size_t)l * 1024 * 2048, 2048, (unsigned char*)F.WA + (size_t)l * 2048 * 1024, (float*)((unsigned char*)F.WA + (size_t)2 * 2048 * 1024) + l * 2048, 1024, (r - 276) * 64, MapId());
        }
    }
    for (int l = 0; l < 2; ++l) {
        Frame P; fill_frame(P, F0);
        tr_convert(F0, P.w_in + (size_t)l * 2048 * 13344, 13344, P.WIN + ((size_t)l * NINP + 4096) * 2048, 2048, 3072, MapInOff{4096});
        tr_convert(F0, P.w_in + (size_t)l * 2048 * 13344, 13344, P.WIN + ((size_t)l * NINP + 13312) * 2048, 2048, 256, MapInOff{13312});
        tr_convert(F0, P.w_o + (size_t)l * 2048 * 2048, 2048, P.WO + (size_t)l * 2048 * 2048, 2048, 2048, MapId());
    }
}

__device__ __forceinline__ void phase_lnmod(const Frame0& F0, int l) {
    PHASE_IDS(F0);
    const int stride = F.nb * 8;
    int row = F.bid * 8 + F.wave;
    float4 v[8], shv[8], scv[8]; int cci = -1;
    if (row < T) { const float* xr = xrow_in(F, l, row);
#pragma unroll
        for (int i = 0; i < 8; ++i) v[i] = *(const float4*)(xr + i * 256 + F.lane * 4); }
    for (; row < T; row += stride) {
        float4 vn[8];
        const int nrow = row + stride;
        if (nrow < T) { const float* xn = xrow_in(F, l, nrow);
#pragma unroll
            for (int i = 0; i < 8; ++i) vn[i] = *(const float4*)(xn + i * 256 + F.lane * 4); }
        else {
#pragma unroll
            for (int i = 0; i < 8; ++i) vn[i] = v[i]; }
        const int ci = cond_of(row);
        if (ci != cci) { const float* md = F.MOD + (size_t)(l * 9 + ci) * NADA; cci = ci;
#pragma unroll
            for (int i = 0; i < 8; ++i) { shv[i] = *(const float4*)(md + i * 256 + F.lane * 4); scv[i] = *(const float4*)(md + 2048 + i * 256 + F.lane * 4); } }
        float s = 0.f;
#pragma unroll
        for (int i = 0; i < 8; ++i) s += (v[i].x + v[i].y) + (v[i].z + v[i].w);
        const float mean = wsum(s) * (1.f / 2048.f);
        float q = 0.f;
#pragma unroll
        for (int i = 0; i < 8; ++i) { const float a = v[i].x - mean, b = v[i].y - mean, c = v[i].z - mean, d = v[i].w - mean; q += (a * a + b * b) + (c * c + d * d); }
        const float rstd = rsqrtf(wsum(q) * (1.f / 2048.f) + LN_EPS);
        float am = 0.f;
#pragma unroll
        for (int i = 0; i < 8; ++i) { const int col = i * 256 + F.lane * 4;
            const float4 sh = shv[i], sc = scv[i];
            const float y0 = (v[i].x - mean) * rstd * (1.f + sc.x) + sh.x, y1 = (v[i].y - mean) * rstd * (1.f + sc.y) + sh.y;
            const float y2 = (v[i].z - mean) * rstd * (1.f + sc.z) + sh.z, y3 = (v[i].w - mean) * rstd * (1.f + sc.w) + sh.w;
            if (row < TCTX) { u32x2 o; o.x = cvt_pk_bf16(y0, y1); o.y = cvt_pk_bf16(y2, y3); *(u32x2*)(F.H + (size_t)row * D + col) = o; }
            v[i].x = y0; v[i].y = y1; v[i].z = y2; v[i].w = y3; am = fmaxf(am, fmaxf(fmaxf(fabsf(y0), fabsf(y1)), fmaxf(fabsf(y2), fabsf(y3)))); }
        am = wmax(am);
        const float hs = am > 0.f ? am * (1.f / 127.f) : 1.f, hinv = 1.f / hs;
#pragma unroll
        for (int i = 0; i < 8; ++i) *(unsigned*)(F.ws + WS_H8IN + (size_t)row * D + i * 256 + F.lane * 4) = pack_i8(v[i].x * hinv, v[i].y * hinv, v[i].z * hinv, v[i].w * hinv);
        if (F.lane == 0) ((float*)(F.ws + WS_HSIN))[row] = hs;
#pragma unroll
        for (int i = 0; i < 8; ++i) v[i] = vn[i];
    }
}

__device__ __forceinline__ unsigned dpp_ror8(unsigned x) { return (unsigned)__builtin_amdgcn_update_dpp(0, (int)x, 0x128, 0xf, 0xf, true); }
__device__ __forceinline__ void store_rows128(bf16_t* base, size_t ld, int fr, int fq, const u32x4 w0, const u32x4 w1) {
    const bool lo = fr < 8;
    u32x4 a, b;
#pragma unroll
    for (int j = 0; j < 4; ++j) { const unsigned t0 = dpp_ror8(w0[j]), t1 = dpp_ror8(w1[j]); a[j] = lo ? w0[j] : t1; b[j] = lo ? t0 : w1[j]; }
    bf16_t* p = base + (size_t)(fr & 7) * ld + (lo ? 0 : 32) + 8 * fq;
#if STORE_POLICY == 1
    __builtin_nontemporal_store(a, (u32x4*)p); __builtin_nontemporal_store(b, (u32x4*)(p + 8 * ld));
#elif STORE_POLICY == 2
    asm volatile("global_store_dwordx4 %0, %1, off sc1" :: "v"(p), "v"(a) : "memory"); asm volatile("global_store_dwordx4 %0, %1, off sc1" :: "v"(p + 8 * ld), "v"(b) : "memory");
#elif STORE_POLICY == 3
    asm volatile("global_store_dwordx4 %0, %1, off sc0 sc1" :: "v"(p), "v"(a) : "memory"); asm volatile("global_store_dwordx4 %0, %1, off sc0 sc1" :: "v"(p + 8 * ld), "v"(b) : "memory");
#else
    *(u32x4*)p = a; *(u32x4*)(p + 8 * ld) = b;
#endif
}
__device__ __forceinline__ void store_rows128_f32(float* base, size_t ld, int fr, int fq, const f32x4 v0, const f32x4 v1) {
    const bool lo = fr < 8;
    f32x4 a, b;
#pragma unroll
    for (int j = 0; j < 4; ++j) { const float t0 = __uint_as_float(dpp_ror8(__float_as_uint(v0[j]))), t1 = __uint_as_float(dpp_ror8(__float_as_uint(v1[j]))); a[j] = lo ? v0[j] : t1; b[j] = lo ? t0 : v1[j]; }
    float* p = base + (size_t)(fr & 7) * ld + (lo ? 0 : 16) + 4 * fq;
    *(f32x4*)p = a; *(f32x4*)(p + 8 * ld) = b;
}
__device__ __forceinline__ float4 ld_bf4(const bf16_t* p) { const u32x2 w = *(const u32x2*)p; float4 r; r.x = __uint_as_float(w.x << 16); r.y = __uint_as_float(w.x & 0xffff0000u); r.z = __uint_as_float(w.y << 16); r.w = __uint_as_float(w.y & 0xffff0000u); return r; }
__device__ __forceinline__ u32x4 pack8(const f32x4 v0, const f32x4 v1) { u32x4 w; w.x = cvt_pk_bf16(v0[0], v0[1]); w.y = cvt_pk_bf16(v0[2], v0[3]); w.z = cvt_pk_bf16(v1[0], v1[1]); w.w = cvt_pk_bf16(v1[2], v1[3]); return w; }
struct EpiIn {
    static constexpr bool PERM = true;
    bf16_t *Z1, *ZQ, *ZK, *ZV, *Z3, *GA, *GB; float* Z5;
    __device__ __forceinline__ void operator()(const f32x4 (&acc)[2][2][4][2], const pg8::Unit& u, int wr, int wc, int fr0, int fq0) const {
        int fr = fr0, fq = fq0; asm volatile("" : "+v"(fr), "+v"(fq));
        const int rw = u.pm * 256 + wr * 64;
        if (u.pn < 52) {
            bf16_t* base; int ld, c;
            const int colt = u.pn * 256;
            if (u.pn < 12) { base = Z1; ld = 3072; c = colt; }
            else if (u.pn < 16) { base = ZQ; ld = 1024; c = colt - 3072; }
            else if (u.pn < 20) { base = ZK; ld = 1024; c = colt - 4096; }
            else if (u.pn < 28) { base = ZV; ld = 2048; c = colt - 5120; }
            else if (u.pn < 36) { base = Z3; ld = 2048; c = colt - 7168; }
            else if (u.pn < 44) { base = GA; ld = 2048; c = colt - 9216; }
            else { base = GB; ld = 2048; c = colt - 11264; }
#pragma unroll
            for (int ai = 0; ai < 2; ++ai)
#pragma unroll
                for (int m = 0; m < 4; ++m)
                    store_rows128(base + (size_t)(rw + ai * 128 + m * 16) * ld + c + wc * 64, (size_t)ld, fr, fq, pack8(acc[ai][0][m][0], acc[ai][0][m][1]), pack8(acc[ai][1][m][0], acc[ai][1][m][1]));
        } else if (wc == 0) {
#pragma unroll
            for (int ai = 0; ai < 2; ++ai)
#pragma unroll
                for (int m = 0; m < 4; ++m) { float* rowp = Z5 + (size_t)(rw + fr + ai * 128 + m * 16) * 32 + 8 * fq;
                    *(f32x4*)(rowp) = acc[ai][0][m][0]; *(f32x4*)(rowp + 4) = acc[ai][0][m][1]; }
        }
    }
};
struct SubsetOrder {
    int mode, G, c;
    __device__ __forceinline__ bool next(int i, pg8::Unit& u) const {
        const long L = (long)i * G + c;
        if (mode == 0) { if (L >= 208) return false; const int k = (int)L >> 4; u.pm = (int)L & 15; u.pn = k < 12 ? 16 + k : 52; return true; }
        if (L >= 7424) return false;
        const int w = ((int)L & 7) * 928 + ((int)L >> 3);
        if (w < 6784) { const int r = w % 424; u.pm = 16 + (w / 424) * 8 + (r & 7); u.pn = r >> 3; }
        else { const int v = w - 6784, q = v >> 4; u.pm = v & 15; u.pn = q < 16 ? q : q + 12; }
        return true;
    }
    __device__ __forceinline__ void a_ready(const pg8::Unit&) const {}
    __device__ __forceinline__ void done(const pg8::Unit&) const {}
};
struct EpiInS {
    static constexpr bool PERM = true;
    bf16_t *Z1, *ZQ, *ZK, *ZV, *Z3, *GA, *GB; float* Z5; const float* RS; const float* CS;
    __device__ __forceinline__ void operator()(const i32x4 (&acc)[2][2][4][2], const pg8::Unit& u, int wr, int wc, int fr0, int fq0) const {
        int fr = fr0, fq = fq0; asm volatile("" : "+v"(fr), "+v"(fq));
        const int rw = u.pm * 256 + wr * 64;
        const int colt = u.pn * 256;
        f32x4 cs[2][2];
#pragma unroll
        for (int bj = 0; bj < 2; ++bj)
#pragma unroll
            for (int n = 0; n < 2; ++n) cs[bj][n] = *(const f32x4*)(CS + colt + wc * 64 + bj * 32 + 8 * fq + 4 * n);
        if (u.pn < 52) {
            bf16_t* base; int ld, c;
            if (u.pn < 12) { base = Z1; ld = 3072; c = colt; }
            else if (u.pn < 16) { base = ZQ; ld = 1024; c = colt - 3072; }
            else if (u.pn < 20) { base = ZK; ld = 1024; c = colt - 4096; }
            else if (u.pn < 28) { base = ZV; ld = 2048; c = colt - 5120; }
            else if (u.pn < 36) { base = Z3; ld = 2048; c = colt - 7168; }
            else if (u.pn < 44) { base = GA; ld = 2048; c = colt - 9216; }
            else { base = GB; ld = 2048; c = colt - 11264; }
#pragma unroll
            for (int ai = 0; ai < 2; ++ai)
#pragma unroll
                for (int m = 0; m < 4; ++m) { const float rs = RS[rw + ai * 128 + m * 16 + fr]; f32x4 v[2][2];
#pragma unroll
                    for (int bj = 0; bj < 2; ++bj)
#pragma unroll
                        for (int n = 0; n < 2; ++n)
#pragma unroll
                            for (int j = 0; j < 4; ++j) v[bj][n][j] = (float)acc[ai][bj][m][n][j] * rs * cs[bj][n][j];
                    store_rows128(base + (size_t)(rw + ai * 128 + m * 16) * ld + c + wc * 64, (size_t)ld, fr, fq, pack8(v[0][0], v[0][1]), pack8(v[1][0], v[1][1])); }
        } else if (wc == 0) {
#pragma unroll
            for (int ai = 0; ai < 2; ++ai)
#pragma unroll
                for (int m = 0; m < 4; ++m) { const float rs = RS[rw + ai * 128 + m * 16 + fr]; float* rowp = Z5 + (size_t)(rw + fr + ai * 128 + m * 16) * 32 + 8 * fq; f32x4 v0, v1;
#pragma unroll
                    for (int j = 0; j < 4; ++j) { v0[j] = (float)acc[ai][0][m][0][j] * rs * cs[0][0][j]; v1[j] = (float)acc[ai][0][m][1][j] * rs * cs[0][1][j]; }
                    *(f32x4*)(rowp) = v0; *(f32x4*)(rowp + 4) = v1; }
        }
    }
};
struct EpiA {
    static constexpr bool PERM = true;
    const bf16_t* Z4; bf16_t* Y;
    __device__ __forceinline__ void operator()(const f32x4 (&acc)[2][2][4][2], const pg8::Unit& u, int wr, int wc, int fr0, int fq0) const {
        int fr = fr0, fq = fq0; asm volatile("" : "+v"(fr), "+v"(fq));
        const int rw = u.pm * 256 + wr * 64, cw = u.pn * 256 + wc * 64;
#pragma unroll
        for (int ai = 0; ai < 2; ++ai)
#pragma unroll
            for (int m = 0; m < 4; ++m) { const size_t row = (size_t)(rw + fr + ai * 128 + m * 16);
                u32x4 w[2];
#pragma unroll
                for (int bj = 0; bj < 2; ++bj) { const int col = cw + bj * 32 + 8 * fq;
                    const u32x4 g = *(const u32x4*)(Z4 + row * 2048 + col);
                    const f32x4 v0 = acc[ai][bj][m][0], v1 = acc[ai][bj][m][1];
                    w[bj].x = cvt_pk_bf16(sigmoidf_(bf_lo(g.x)) * v0[0], sigmoidf_(bf_hi(g.x)) * v0[1]);
                    w[bj].y = cvt_pk_bf16(sigmoidf_(bf_lo(g.y)) * v0[2], sigmoidf_(bf_hi(g.y)) * v0[3]);
                    w[bj].z = cvt_pk_bf16(sigmoidf_(bf_lo(g.z)) * v1[0], sigmoidf_(bf_hi(g.z)) * v1[1]);
                    w[bj].w = cvt_pk_bf16(sigmoidf_(bf_lo(g.w)) * v1[2], sigmoidf_(bf_hi(g.w)) * v1[3]); }
                store_rows128(Y + (size_t)(rw + ai * 128 + m * 16) * 2048 + cw, 2048, fr, fq, w[0], w[1]); }
    }
};
struct EpiAS {
    static constexpr bool PERM = true;
    const bf16_t* Z4; bf16_t* Y; const float* RS; const float* CS;
    __device__ __forceinline__ void operator()(const i32x4 (&acc)[2][2][4][2], const pg8::Unit& u, int wr, int wc, int fr0, int fq0) const {
        int fr = fr0, fq = fq0; asm volatile("" : "+v"(fr), "+v"(fq));
        const int rw = u.pm * 256 + wr * 64, cw = u.pn * 256 + wc * 64;
#pragma unroll
        for (int ai = 0; ai < 2; ++ai)
#pragma unroll
            for (int m = 0; m < 4; ++m) { const size_t row = (size_t)(rw + fr + ai * 128 + m * 16); const float rs = RS[row];
                u32x4 w[2];
#pragma unroll
                for (int bj = 0; bj < 2; ++bj) { const int col = cw + bj * 32 + 8 * fq;
                    const u32x4 g = *(const u32x4*)(Z4 + row * 2048 + col);
                    const f32x4 c0 = *(const f32x4*)(CS + col), c1 = *(const f32x4*)(CS + col + 4); f32x4 v0, v1;
#pragma unroll
                    for (int jj = 0; jj < 4; ++jj) { v0[jj] = (float)acc[ai][bj][m][0][jj] * rs * c0[jj]; v1[jj] = (float)acc[ai][bj][m][1][jj] * rs * c1[jj]; }
                    w[bj].x = cvt_pk_bf16(sigmoidf_(bf_lo(g.x)) * v0[0], sigmoidf_(bf_hi(g.x)) * v0[1]);
                    w[bj].y = cvt_pk_bf16(sigmoidf_(bf_lo(g.y)) * v0[2], sigmoidf_(bf_hi(g.y)) * v0[3]);
                    w[bj].z = cvt_pk_bf16(sigmoidf_(bf_lo(g.z)) * v1[0], sigmoidf_(bf_hi(g.z)) * v1[1]);
                    w[bj].w = cvt_pk_bf16(sigmoidf_(bf_lo(g.w)) * v1[2], sigmoidf_(bf_hi(g.w)) * v1[3]); }
                store_rows128(Y + (size_t)(rw + ai * 128 + m * 16) * 2048 + cw, 2048, fr, fq, w[0], w[1]); }
    }
};
struct EpiB {
    static constexpr bool PERM = true;
    const bf16_t* Z4; bf16_t* Y;
    __device__ __forceinline__ void operator()(const f32x4 (&acc)[2][2][4][2], const pg8::Unit& u, int wr, int wc, int fr0, int fq0) const {
        int fr = fr0, fq = fq0; asm volatile("" : "+v"(fr), "+v"(fq));
        const int rw = u.pm * 256 + wr * 64, cw = u.pn * 256 + wc * 64;
#pragma unroll
        for (int ai = 0; ai < 2; ++ai)
#pragma unroll
            for (int m = 0; m < 4; ++m) { const size_t row = (size_t)(rw + fr + ai * 128 + m * 16);
                u32x4 w[2];
#pragma unroll
                for (int bj = 0; bj < 2; ++bj) { const int col = cw + bj * 32 + 8 * fq;
                    const u32x4 g = *(const u32x4*)(Z4 + row * 2048 + col);
                    const u32x4 y = *(const u32x4*)(Y + row * 2048 + col);
                    const f32x4 v0 = acc[ai][bj][m][0], v1 = acc[ai][bj][m][1];
                    w[bj].x = cvt_pk_bf16(bf_lo(y.x) + sigmoidf_(bf_lo(g.x)) * v0[0], bf_hi(y.x) + sigmoidf_(bf_hi(g.x)) * v0[1]);
                    w[bj].y = cvt_pk_bf16(bf_lo(y.y) + sigmoidf_(bf_lo(g.y)) * v0[2], bf_hi(y.y) + sigmoidf_(bf_hi(g.y)) * v0[3]);
                    w[bj].z = cvt_pk_bf16(bf_lo(y.z) + sigmoidf_(bf_lo(g.z)) * v1[0], bf_hi(y.z) + sigmoidf_(bf_hi(g.z)) * v1[1]);
                    w[bj].w = cvt_pk_bf16(bf_lo(y.w) + sigmoidf_(bf_lo(g.w)) * v1[2], bf_hi(y.w) + sigmoidf_(bf_hi(g.w)) * v1[3]); }
                store_rows128(Y + (size_t)(rw + ai * 128 + m * 16) * 2048 + cw, 2048, fr, fq, w[0], w[1]); }
    }
};
struct EpiO {
    static constexpr bool PERM = true;
    const float *xp, *xs, *xo; const float* MODl; bf16_t* T1; int l;
    __device__ __forceinline__ void operator()(const f32x4 (&acc)[2][2][4][2], const pg8::Unit& u, int wr, int wc, int fr0, int fq0) const {
        int fr = fr0, fq = fq0; asm volatile("" : "+v"(fr), "+v"(fq));
        const int cw = u.pn * 256 + wc * 64;
        const int rbase = u.pm * 256;
        const float* g1 = MODl + (size_t)cond_of(rbase) * NADA + 2 * 2048;
        const float* xb = (l == 0) ? (rbase < TCTX ? xp + (size_t)rbase * D : xs + (size_t)(rbase - TCTX) * D) : xo + (size_t)rbase * D;
#pragma unroll
        for (int ai = 0; ai < 2; ++ai)
#pragma unroll
            for (int m = 0; m < 4; ++m) { const int rl0 = wr * 64 + ai * 128 + m * 16, rl = rl0 + fr; u32x4 w[2];
#pragma unroll
                for (int bj = 0; bj < 2; ++bj) { f32x4 r[2]; const int col = cw + bj * 32 + 8 * fq;
#pragma unroll
                    for (int n = 0; n < 2; ++n) {
                        const f32x4 xv = *(const f32x4*)(xb + (size_t)rl * D + col + 4 * n);
                        const f32x4 gvv = *(const f32x4*)(g1 + col + 4 * n);
                        r[n] = xv * ALPHA + gvv * acc[ai][bj][m][n]; }
                    w[bj] = pack8(r[0], r[1]); }
                store_rows128(T1 + (size_t)(rbase + rl0) * D + cw, (size_t)D, fr, fq, w[0], w[1]);
                __builtin_amdgcn_sched_barrier(0); }
    }
};
struct EpiPlain {
    static constexpr bool PERM = true;
    bf16_t* O; int ld;
    __device__ __forceinline__ void operator()(const f32x4 (&acc)[2][2][4][2], const pg8::Unit& u, int wr, int wc, int fr0, int fq0) const {
        int fr = fr0, fq = fq0; asm volatile("" : "+v"(fr), "+v"(fq));
        const int rw = u.pm * 256 + wr * 64, cw = u.pn * 256 + wc * 64;
#pragma unroll
        for (int ai = 0; ai < 2; ++ai)
#pragma unroll
            for (int m = 0; m < 4; ++m)
                store_rows128(O + (size_t)(rw + ai * 128 + m * 16) * ld + cw, (size_t)ld, fr, fq, pack8(acc[ai][0][m][0], acc[ai][0][m][1]), pack8(acc[ai][1][m][0], acc[ai][1][m][1]));
    }
};
struct EpiPlainS {
    static constexpr bool PERM = true;
    bf16_t* O; int ld; const float* RS; const float* CS;
    __device__ __forceinline__ void operator()(const i32x4 (&acc)[2][2][4][2], const pg8::Unit& u, int wr, int wc, int fr0, int fq0) const {
        int fr = fr0, fq = fq0; asm volatile("" : "+v"(fr), "+v"(fq));
        const int rw = u.pm * 256 + wr * 64, cw = u.pn * 256 + wc * 64;
        f32x4 cs[2][2];
#pragma unroll
        for (int bj = 0; bj < 2; ++bj)
#pragma unroll
            for (int n = 0; n < 2; ++n) cs[bj][n] = *(const f32x4*)(CS + cw + bj * 32 + 8 * fq + 4 * n);
#pragma unroll
        for (int ai = 0; ai < 2; ++ai)
#pragma unroll
            for (int m = 0; m < 4; ++m) { const float rs = RS[rw + ai * 128 + m * 16 + fr]; f32x4 v[2][2];
#pragma unroll
                for (int bj = 0; bj < 2; ++bj)
#pragma unroll
                    for (int n = 0; n < 2; ++n)
#pragma unroll
                        for (int j = 0; j < 4; ++j) v[bj][n][j] = (float)acc[ai][bj][m][n][j] * rs * cs[bj][n][j];
                store_rows128(O + (size_t)(rw + ai * 128 + m * 16) * ld + cw, (size_t)ld, fr, fq, pack8(v[0][0], v[0][1]), pack8(v[1][0], v[1][1])); }
    }
};
struct EpiBS {
    static constexpr bool PERM = true;
    const bf16_t* Z4; bf16_t* Y; const float* RS; const float* CS;
    __device__ __forceinline__ void operator()(const i32x4 (&acc)[2][2][4][2], const pg8::Unit& u, int wr, int wc, int fr0, int fq0) const {
        int fr = fr0, fq = fq0; asm volatile("" : "+v"(fr), "+v"(fq));
        const int rw = u.pm * 256 + wr * 64, cw = u.pn * 256 + wc * 64;
        f32x4 cs[2][2];
#pragma unroll
        for (int bj = 0; bj < 2; ++bj)
#pragma unroll
            for (int n = 0; n < 2; ++n) cs[bj][n] = *(const f32x4*)(CS + cw + bj * 32 + 8 * fq + 4 * n);
#pragma unroll
        for (int ai = 0; ai < 2; ++ai)
#pragma unroll
            for (int m = 0; m < 4; ++m) { const size_t row = (size_t)(rw + fr + ai * 128 + m * 16); const float rs = RS[row];
                u32x4 w[2];
#pragma unroll
                for (int bj = 0; bj < 2; ++bj) { const int col = cw + bj * 32 + 8 * fq;
                    const u32x4 g = *(const u32x4*)(Z4 + row * 2048 + col);
                    const u32x4 y = *(const u32x4*)(Y + row * 2048 + col);
                    f32x4 v0, v1;
#pragma unroll
                    for (int j = 0; j < 4; ++j) { v0[j] = (float)acc[ai][bj][m][0][j] * rs * cs[bj][0][j]; v1[j] = (float)acc[ai][bj][m][1][j] * rs * cs[bj][1][j]; }
                    w[bj].x = cvt_pk_bf16(bf_lo(y.x) + sigmoidf_(bf_lo(g.x)) * v0[0], bf_hi(y.x) + sigmoidf_(bf_hi(g.x)) * v0[1]);
                    w[bj].y = cvt_pk_bf16(bf_lo(y.y) + sigmoidf_(bf_lo(g.y)) * v0[2], bf_hi(y.y) + sigmoidf_(bf_hi(g.y)) * v0[3]);
                    w[bj].z = cvt_pk_bf16(bf_lo(y.z) + sigmoidf_(bf_lo(g.z)) * v1[0], bf_hi(y.z) + sigmoidf_(bf_hi(g.z)) * v1[1]);
                    w[bj].w = cvt_pk_bf16(bf_lo(y.w) + sigmoidf_(bf_lo(g.w)) * v1[2], bf_hi(y.w) + sigmoidf_(bf_hi(g.w)) * v1[3]); }
                store_rows128(Y + (size_t)(rw + ai * 128 + m * 16) * 2048 + cw, 2048, fr, fq, w[0], w[1]); }
    }
};
template <class Epi, bool I8 = false>
__device__ __forceinline__ void run_gemm(const Frame& F, const bf16_t* A, const bf16_t* Bt, int N, int K, const Epi& E) {
    pg8::Gemm g{A, Bt, T, N, K}; pg8::StaticOrder S; S.init(T, N, F.nb, F.bid);
    pg8::gemm_phase<Epi, pg8::StaticOrder, true, true, I8>(F.lds, g, S, E);
}
#define B_ZQ(F) ((F).Z2)
#define B_ZK(F) ((F).Z2 + (size_t)T * 1024)
#define B_ZV(F) ((F).Z2 + (size_t)T * 2048)
#define B_GA(F) ((F).Z4)
#define B_GB(F) ((F).Z4 + (size_t)T * 2048)
#define B_Y(F)  ((F).Z1 + (size_t)T * 1024)
#define B_QDF(F) ((F).H)
#define B_KDF(F) ((F).H + (size_t)T * 1024)
#define B_QDB(F) ((F).H + (size_t)T * 2048)
#define B_KDB(F) ((F).Z4)
#define B_DEC(F) ((float*)((F).Z4 + (size_t)T * 1024))
#define B_OF(F) ((F).Z2)
#define B_BIN(F) ((F).H)
#define B_QQ(F) ((F).Z2 + (size_t)T * 2048)
#define B_T1(F) ((F).Z4 + (size_t)T * 2048)
__device__ __forceinline__ void phase_gemm_in(const Frame0& F0, int l) {
    {
        PHASE_IDS(F0); EpiIn E{F.Z1, B_ZQ(F), B_ZK(F), B_ZV(F), F.Z3, B_GA(F), B_GB(F), F.Z5};
        pg8::Gemm g{F.H, F.WIN + (size_t)l * NINP * 2048, T, NINP, 2048}; SubsetOrder S{0, F.nb, F.bid};
        pg8::gemm_phase<EpiIn, SubsetOrder, true, true, false>(F.lds, g, S, E); }
    {
        PHASE_IDS(F0); EpiInS E{F.Z1, B_ZQ(F), B_ZK(F), B_ZV(F), F.Z3, B_GA(F), B_GB(F), F.Z5, (const float*)(F.ws + WS_HSIN), (const float*)(F.ws + WS_CSIN) + (size_t)l * NINP};
        pg8::Gemm g{(const bf16_t*)(F.ws + WS_H8IN), (const bf16_t*)(F.ws + WS_W8IN + (size_t)l * NINP * 2048), T, NINP, 2048}; SubsetOrder S{1, F.nb, F.bid};
        pg8::gemm_phase<EpiInS, SubsetOrder, true, true, true>(F.lds, g, S, E); }
}
__device__ __forceinline__ void phase_gemm_a(const Frame0& F0, int l) { PHASE_IDS(F0);
    EpiAS E{B_GA(F), B_Y(F), (const float*)(F.ws + WS_ASIN), (const float*)((const unsigned char*)F.WA + (size_t)2 * 2048 * 1024) + l * 2048};
    run_gemm<EpiAS, true>(F, F.H, (const bf16_t*)((const unsigned char*)F.WA + (size_t)l * 2048 * 1024), 2048, 1024, E); }
__device__ __forceinline__ void phase_gemm_b(const Frame0& F0, int l) { PHASE_IDS(F0);
    EpiBS E{B_GB(F), B_Y(F), F.VS + 110592, (const float*)((const unsigned char*)F.WB + (size_t)2 * 2048 * 2048) + l * 2048};
    run_gemm<EpiBS, true>(F, B_BIN(F), (const bf16_t*)((const unsigned char*)F.WB + (size_t)l * 2048 * 2048), 2048, 2048, E); }
__device__ __forceinline__ void phase_gemm_o(const Frame0& F0, int l) { PHASE_IDS(F0); EpiO E{F.x_prompt, F.x_sample, F.out, F.MOD + (size_t)l * 9 * NADA, B_T1(F), l}; run_gemm(F, B_Y(F), F.WO + (size_t)l * 2048 * 2048, 2048, 2048, E); }
__device__ __forceinline__ void phase_gemm_pq(const Frame0& F0, int l) { PHASE_IDS(F0);
    EpiPlainS E{B_QQ(F), 2048, F.VS + 32768, (const float*)((const unsigned char*)F.WPQ + (size_t)2 * 2048 * 2048) + l * 2048};
    run_gemm<EpiPlainS, true>(F, (const bf16_t*)((const unsigned char*)F.Z3 + ((size_t)64 << 20)), (const bf16_t*)((const unsigned char*)F.WPQ + (size_t)l * 2048 * 2048), 2048, 2048, E); }

__device__ __forceinline__ void phase_conv(const Frame0& F0, int l) {
    PHASE_IDS(F0);
    const bf16_t* Z1 = F.Z1; unsigned char* AIN = (unsigned char*)F.H;
    float* AS = (float*)(F.ws + WS_ASIN);
    LAS float* red = (LAS float*)F.lds;
    const size_t gth = (size_t)F.nb * 512;
    int par = 0;
    for (size_t it = (size_t)F.bid * 512 + F.tid; it < (size_t)T * 128; it += gth, par ^= 8) {
        const int t = (int)(it >> 7), ch = (int)(it & 127) * 8;
        int dlt; bool vm, vp;
        if (t < TCTX) { const int pos = t & 255; dlt = 1; vm = pos > 0; vp = pos < 255; }
        else { const int tau = (t - TCTX) & 4095;
            if (ch < 512) { dlt = 1; vm = (tau & 63) > 0; vp = (tau & 63) < 63; } else { dlt = 64; vm = tau >= 64; vp = tau < 4032; } }
        const bf16_t* zr = Z1 + (size_t)t * 3072;
        const u32x4 zero = {0u, 0u, 0u, 0u};
        const u32x4 cb = *(const u32x4*)(zr + ch), cc0 = *(const u32x4*)(zr + 1024 + ch), cx0 = *(const u32x4*)(zr + 2048 + ch);
        const u32x4 ccm = vm ? *(const u32x4*)(zr - (size_t)dlt * 3072 + 1024 + ch) : zero, cxm = vm ? *(const u32x4*)(zr - (size_t)dlt * 3072 + 2048 + ch) : zero;
        const u32x4 ccp = vp ? *(const u32x4*)(zr + (size_t)dlt * 3072 + 1024 + ch) : zero, cxp = vp ? *(const u32x4*)(zr + (size_t)dlt * 3072 + 2048 + ch) : zero;
        const float* wc = F.w_conv + (size_t)l * 3072 + ch;
        const float4 w0a = *(const float4*)(wc), w0b = *(const float4*)(wc + 4), w1a = *(const float4*)(wc + 1024), w1b = *(const float4*)(wc + 1028), w2a = *(const float4*)(wc + 2048), w2b = *(const float4*)(wc + 2052);
        const float w0[8] = {w0a.x, w0a.y, w0a.z, w0a.w, w0b.x, w0b.y, w0b.z, w0b.w};
        const float w1[8] = {w1a.x, w1a.y, w1a.z, w1a.w, w1b.x, w1b.y, w1b.z, w1b.w};
        const float w2[8] = {w2a.x, w2a.y, w2a.z, w2a.w, w2b.x, w2b.y, w2b.z, w2b.w};
        float o[8]; float am = 0.f;
#pragma unroll
        for (int j = 0; j < 4; ++j) {
            const float um0 = bf_lo(ccm[j]) * bf_lo(cxm[j]), um1 = bf_hi(ccm[j]) * bf_hi(cxm[j]);
            const float u00 = bf_lo(cc0[j]) * bf_lo(cx0[j]), u01 = bf_hi(cc0[j]) * bf_hi(cx0[j]);
            const float up0 = bf_lo(ccp[j]) * bf_lo(cxp[j]), up1 = bf_hi(ccp[j]) * bf_hi(cxp[j]);
            o[2 * j] = bf_lo(cb[j]) * (um0 * w0[2 * j] + u00 * w1[2 * j] + up0 * w2[2 * j]);
            o[2 * j + 1] = bf_hi(cb[j]) * (um1 * w0[2 * j + 1] + u01 * w1[2 * j + 1] + up1 * w2[2 * j + 1]);
            am = fmaxf(am, fmaxf(fabsf(o[2 * j]), fabsf(o[2 * j + 1])));
        }
        am = wmax(am);
        if (F.lane == 0) red[par + F.wave] = am;
        __syncthreads();
        am = fmaxf(red[par + (F.wave & 6)], red[par + (F.wave & 6) + 1]);
        const float as = am > 0.f ? am * (1.f / 127.f) : 1.f, ainv = 1.f / as;
        u32x2 w; w.x = pack_i8(o[0] * ainv, o[1] * ainv, o[2] * ainv, o[3] * ainv); w.y = pack_i8(o[4] * ainv, o[5] * ainv, o[6] * ainv, o[7] * ainv);
        *(u32x2*)(AIN + (size_t)t * 1024 + ch) = w;
        if ((F.tid & 127) == 0) AS[t] = as;
    }
}

__device__ __forceinline__ float logsig_(float x) { return fminf(x, 0.f) - __logf(1.f + __expf(-fabsf(x))); }
__device__ __forceinline__ void phase_gla_prep(const Frame0& F0, int l) {
    PHASE_IDS(F0);
    LAS float* LF = (LAS float*)F.lds;
    LAS float* HT = LF + 2048;
    const int tid = F.tid;
    const int d = tid & 255, half = tid >> 8, p0 = half * 32;
    const bf16_t* ZQ = B_ZQ(F); const bf16_t* ZK = B_ZK(F); const float* Z5 = F.Z5;
    for (int u = F.bid; u < (T / 64) * 4; u += F.nb) {
        const int ch = u >> 2, head = u & 3, tb = ch * 64;
        __syncthreads();
        { const int row = tid >> 3, part = tid & 7; const f32x4 v = *(const f32x4*)(Z5 + (size_t)(tb + row) * 32 + part * 4);
          *(LAS f32x4*)(LF + (part >> 2) * 1024 + row * 16 + (part & 3) * 4) = v; }
        bf16_t qv[32], kv[32];
#pragma unroll
        for (int i = 0; i < 32; ++i) { const size_t ro = (size_t)(tb + p0 + i) * 1024 + head * 256 + d; qv[i] = ZQ[ro]; kv[i] = ZK[ro]; }
        __syncthreads();
#pragma unroll 1
        for (int dir = 0; dir < 2; ++dir) {
            float wg[16];
#pragma unroll
            for (int r = 0; r < 16; ++r) wg[r] = F.w_gk[((size_t)(l * 2 + dir) * 16 + r) * 1024 + head * 256 + d];
            const float gbias = F.b_gk[(size_t)(l * 2 + dir) * 1024 + head * 256 + d];
            float b[32];
#pragma unroll
            for (int i = 0; i < 32; ++i) { float x = gbias; const LAS float* lf = LF + dir * 1024 + (p0 + i) * 16;
#pragma unroll
                for (int r = 0; r < 16; ++r) x += lf[r] * wg[r];
                b[i] = fmaxf(logsig_(x) * 0.0625f, -1.0f); }
            float tot;
            if (!dir) {
#pragma unroll
                for (int i = 1; i < 32; ++i) b[i] += b[i - 1];
                tot = b[31];
            } else {
#pragma unroll
                for (int i = 30; i >= 0; --i) b[i] += b[i + 1];
                tot = b[0];
            }
            HT[half * 256 + d] = tot;
            __syncthreads();
            const float other = HT[(1 - half) * 256 + d];
            const float blast = tot + other;
            const float addv = (dir == 0) ? (half ? other : 0.f) : (half ? 0.f : other);
            bf16_t* QD = dir ? B_QDB(F) : B_QDF(F); bf16_t* KD = dir ? B_KDB(F) : B_KDF(F);
#pragma unroll
            for (int i = 0; i < 32; ++i) {
                const float bb = b[i] + addv; const size_t ro = (size_t)(tb + p0 + i) * 1024 + head * 256 + d;
                QD[ro] = f2bf(bf1(qv[i]) * 0.0625f * __expf(bb - blast));
                KD[ro] = f2bf(bf1(kv[i]) * __expf(blast - bb));
            }
            if (half == 0) B_DEC(F)[((size_t)dir * (T / 64) * 4 + u) * 256 + d] = __expf(blast);
            __syncthreads();
        }
    }
}
__device__ __forceinline__ void phase_gla_scan(const Frame0& F0, int l) {
    PHASE_IDS(F0);
    LAS unsigned char* L = F.lds;
    constexpr int QD_OFF = 0, KD_OFF = 33792, V_OFF = 67584, ST_OFF = 76800, ATT_OFF = 110592, DEC_OFF = 119808;
    const int tid = F.tid, lane = F.lane, wave = F.wave;
    const int fr = lane & 15, fq = lane >> 4;
    const unsigned lbase = (unsigned)(size_t)L;
    const unsigned tr_lane_v = lbase + V_OFF + (unsigned)((8 * fq + (fr >> 2)) * 144 + 8 * (lane & 3));
    const unsigned tr_lane_k = lbase + KD_OFF + (unsigned)((8 * fq + (fr >> 2)) * 528 + 8 * (lane & 3) + wave * 64);
    const bf16_t* ZV = B_ZV(F); bf16_t* OF = B_OF(F);
    const int ti = wave >> 1;
    for (int u0 = F.bid; u0 < 768; u0 += F.nb) {
        const int u = (F.nb == 256) ? (u0 & ~255) + (u0 & 7) * 32 + ((u0 & 255) >> 3) : u0;
        int seq, head, slice, tok0, nch; bool lat;
        if (u < 256) { lat = true; slice = u & 7; head = (u >> 3) & 3; seq = u >> 5; tok0 = TCTX + seq * 4096; nch = 64; }
        else { const int uc = u - 256; lat = false; slice = uc & 7; head = (uc >> 3) & 3; seq = uc >> 5; tok0 = seq * 256; nch = 4; }
#pragma unroll 1
      for (int dir = 0; dir < 2; ++dir) {
        const bf16_t* QD = dir ? B_QDB(F) : B_QDF(F); const bf16_t* KD = dir ? B_KDB(F) : B_KDF(F);
        const float* DEC = B_DEC(F) + (size_t)dir * (T / 64) * 4 * 256;
        const size_t soff = ((((size_t)seq * 2 + l) * 2 + dir) * 4 + head) * 256 * 512;
        f32x4 accS[2][4];
#pragma unroll
        for (int tdi = 0; tdi < 2; ++tdi)
#pragma unroll
            for (int te = 0; te < 4; ++te)
#pragma unroll
                for (int reg = 0; reg < 4; ++reg) {
                    const int dd = (2 * wave + tdi) * 16 + 4 * fq + reg, e = slice * 64 + te * 16 + fr;
                    accS[tdi][te][reg] = lat ? F.state[soff + (size_t)dd * 512 + e] : 0.f;
                }
        u32x4 rq[4], rk[4], rv; f32x4 rdec = {0.f, 0.f, 0.f, 0.f}; bf16_t ro[2][4];
#define GS_LOAD(cc_) do { const int c_ = dir ? nch - 1 - (cc_) : (cc_); const int tb_ = tok0 + c_ * 64; int tl_ = tid; asm volatile("" : "+v"(tl_));   \
            _Pragma("unroll") for (int i_ = 0; i_ < 4; ++i_) { const int id_ = tl_ + 512 * i_, row_ = id_ >> 5, c16_ = id_ & 31; const size_t go_ = (size_t)(tb_ + row_) * 1024 + head * 256 + c16_ * 8; \
                rq[i_] = *(const u32x4*)(QD + go_); rk[i_] = *(const u32x4*)(KD + go_); } \
            rv = *(const u32x4*)(ZV + (size_t)(tb_ + (tl_ >> 3)) * 2048 + head * 512 + slice * 64 + (tl_ & 7) * 8); \
            if (tl_ < 64) rdec = *(const f32x4*)(DEC + ((size_t)(tb_ >> 6) * 4 + head) * 256 + tl_ * 4); \
            if (dir) { const int ln_ = tl_ & 63, wv_ = tl_ >> 6; const bf16_t* ob_ = OF + (size_t)(tb_ + (wv_ >> 1) * 16 + 4 * (ln_ >> 4)) * 2048 + head * 512 + slice * 64 + 2 * (wv_ & 1) * 16 + (ln_ & 15); \
                _Pragma("unroll") for (int t2_ = 0; t2_ < 2; ++t2_) _Pragma("unroll") for (int reg_ = 0; reg_ < 4; ++reg_) ro[t2_][reg_] = ob_[reg_ * 2048 + t2_ * 16]; } } while (0)
        GS_LOAD(0);
#define GS_BAR() do { asm volatile("s_waitcnt lgkmcnt(0)" ::: "memory"); __builtin_amdgcn_s_barrier(); asm volatile("" ::: "memory"); } while (0)
        for (int cc = 0; cc < nch; ++cc) {
            const int c = dir ? nch - 1 - cc : cc; const int tb = tok0 + c * 64;
            GS_BAR();
#pragma unroll
            for (int i = 0; i < 4; ++i) { const int id = tid + 512 * i, row = id >> 5, c16 = id & 31;
                *(LAS u32x4*)(L + QD_OFF + row * 528 + c16 * 16) = rq[i]; *(LAS u32x4*)(L + KD_OFF + row * 528 + c16 * 16) = rk[i]; }
            *(LAS u32x4*)(L + V_OFF + (tid >> 3) * 144 + (tid & 7) * 16) = rv;
            if (tid < 64) *(LAS f32x4*)(L + DEC_OFF + tid * 16) = rdec;
            bf16_t oold[2][4];
#pragma unroll
            for (int t2 = 0; t2 < 2; ++t2)
#pragma unroll
                for (int reg = 0; reg < 4; ++reg) oold[t2][reg] = ro[t2][reg];
            GS_BAR();
            { const int nx = (cc + 1 < nch) ? cc + 1 : cc; GS_LOAD(nx); }
#pragma unroll
            for (int tdi = 0; tdi < 2; ++tdi) {
                const f32x4 dec = *(const LAS f32x4*)(L + DEC_OFF + ((2 * wave + tdi) * 16 + 4 * fq) * 4);
#pragma unroll
                for (int te = 0; te < 4; ++te) { accS[tdi][te] = accS[tdi][te] * dec;
                    u32x2 w; w.x = cvt_pk_bf16(accS[tdi][te][0], accS[tdi][te][1]); w.y = cvt_pk_bf16(accS[tdi][te][2], accS[tdi][te][3]);
                    *(LAS u32x2*)(L + ST_OFF + (te * 16 + fr) * 528 + ((2 * wave + tdi) * 16 + 4 * fq) * 2) = w; }
            }
#pragma unroll
            for (int t2 = 0; t2 < 2; ++t2) {
                const int tj = 2 * (wave & 1) + t2;
                const bool live = dir ? (tj >= ti) : (tj <= ti);
                f32x4 a4 = {0.f, 0.f, 0.f, 0.f};
                if (live) {
#pragma unroll
                    for (int ks = 0; ks < 8; ++ks) {
                        const bf16x8 a = *(const LAS bf16x8*)(L + QD_OFF + (ti * 16 + fr) * 528 + ks * 64 + fq * 16);
                        const bf16x8 bb = *(const LAS bf16x8*)(L + KD_OFF + (tj * 16 + fr) * 528 + ks * 64 + fq * 16);
                        a4 = __builtin_amdgcn_mfma_f32_16x16x32_bf16(a, bb, a4, 0, 0, 0);
                    }
                }
#pragma unroll
                for (int reg = 0; reg < 4; ++reg) { const int i = ti * 16 + 4 * fq + reg, j = tj * 16 + fr; const bool keep = dir ? (j >= i) : (j <= i);
                    *(LAS bf16_t*)(L + ATT_OFF + i * 144 + j * 2) = f2bf(keep ? a4[reg] : 0.f); }
            }
            GS_BAR();
            u32x2 vt[2][4][2], kt[2][2][2];
            asm volatile(
                "ds_read_b64_tr_b16 %0, %16 offset:0\n\tds_read_b64_tr_b16 %1, %16 offset:576\n\tds_read_b64_tr_b16 %2, %16 offset:32\n\tds_read_b64_tr_b16 %3, %16 offset:608\n\t"
                "ds_read_b64_tr_b16 %4, %16 offset:64\n\tds_read_b64_tr_b16 %5, %16 offset:640\n\tds_read_b64_tr_b16 %6, %16 offset:96\n\tds_read_b64_tr_b16 %7, %16 offset:672\n\t"
                "ds_read_b64_tr_b16 %8, %16 offset:4608\n\tds_read_b64_tr_b16 %9, %16 offset:5184\n\tds_read_b64_tr_b16 %10, %16 offset:4640\n\tds_read_b64_tr_b16 %11, %16 offset:5216\n\t"
                "ds_read_b64_tr_b16 %12, %16 offset:4672\n\tds_read_b64_tr_b16 %13, %16 offset:5248\n\tds_read_b64_tr_b16 %14, %16 offset:4704\n\tds_read_b64_tr_b16 %15, %16 offset:5280\n\t"
                "s_waitcnt lgkmcnt(0)"
                : "=&v"(vt[0][0][0]), "=&v"(vt[0][0][1]), "=&v"(vt[0][1][0]), "=&v"(vt[0][1][1]), "=&v"(vt[0][2][0]), "=&v"(vt[0][2][1]), "=&v"(vt[0][3][0]), "=&v"(vt[0][3][1]),
                  "=&v"(vt[1][0][0]), "=&v"(vt[1][0][1]), "=&v"(vt[1][1][0]), "=&v"(vt[1][1][1]), "=&v"(vt[1][2][0]), "=&v"(vt[1][2][1]), "=&v"(vt[1][3][0]), "=&v"(vt[1][3][1])
                : "v"(tr_lane_v) : "memory");
            asm volatile(
                "ds_read_b64_tr_b16 %0, %8 offset:0\n\tds_read_b64_tr_b16 %1, %8 offset:2112\n\tds_read_b64_tr_b16 %2, %8 offset:16896\n\tds_read_b64_tr_b16 %3, %8 offset:19008\n\t"
                "ds_read_b64_tr_b16 %4, %8 offset:32\n\tds_read_b64_tr_b16 %5, %8 offset:2144\n\tds_read_b64_tr_b16 %6, %8 offset:16928\n\tds_read_b64_tr_b16 %7, %8 offset:19040\n\t"
                "s_waitcnt lgkmcnt(0)"
                : "=&v"(kt[0][0][0]), "=&v"(kt[0][0][1]), "=&v"(kt[0][1][0]), "=&v"(kt[0][1][1]), "=&v"(kt[1][0][0]), "=&v"(kt[1][0][1]), "=&v"(kt[1][1][0]), "=&v"(kt[1][1][1])
                : "v"(tr_lane_k) : "memory");
#define GS_FRAG(x_) __builtin_bit_cast(bf16x8, (u32x4){(x_)[0].x, (x_)[0].y, (x_)[1].x, (x_)[1].y})
#pragma unroll
            for (int t2 = 0; t2 < 2; ++t2) {
                const int te = 2 * (wave & 1) + t2;
                f32x4 o4 = {0.f, 0.f, 0.f, 0.f};
#pragma unroll
                for (int ks = 0; ks < 8; ++ks) {
                    const bf16x8 a = *(const LAS bf16x8*)(L + QD_OFF + (ti * 16 + fr) * 528 + ks * 64 + fq * 16);
                    const bf16x8 bb = *(const LAS bf16x8*)(L + ST_OFF + (te * 16 + fr) * 528 + ks * 64 + fq * 16);
                    o4 = __builtin_amdgcn_mfma_f32_16x16x32_bf16(a, bb, o4, 0, 0, 0);
                }
#pragma unroll
                for (int ks = 0; ks < 2; ++ks) {
                    const bf16x8 a = *(const LAS bf16x8*)(L + ATT_OFF + (ti * 16 + fr) * 144 + ks * 64 + fq * 16);
                    const bf16x8 bb = (t2 == 0) ? ((wave & 1) ? GS_FRAG(vt[ks][2]) : GS_FRAG(vt[ks][0])) : ((wave & 1) ? GS_FRAG(vt[ks][3]) : GS_FRAG(vt[ks][1]));
                    o4 = __builtin_amdgcn_mfma_f32_16x16x32_bf16(a, bb, o4, 0, 0, 0);
                }
#pragma unroll
                for (int reg = 0; reg < 4; ++reg) { bf16_t* op = OF + (size_t)(tb + ti * 16 + 4 * fq + reg) * 2048 + head * 512 + slice * 64 + te * 16 + fr;
                    *op = f2bf(dir ? bf1(oold[t2][reg]) + o4[reg] : o4[reg]); }
            }
#pragma unroll
            for (int tdi = 0; tdi < 2; ++tdi)
#pragma unroll
                for (int te = 0; te < 4; ++te) {
                    f32x4 s4 = accS[tdi][te];
                    s4 = __builtin_amdgcn_mfma_f32_16x16x32_bf16(GS_FRAG(kt[tdi][0]), GS_FRAG(vt[0][te]), s4, 0, 0, 0);
                    s4 = __builtin_amdgcn_mfma_f32_16x16x32_bf16(GS_FRAG(kt[tdi][1]), GS_FRAG(vt[1][te]), s4, 0, 0, 0);
                    accS[tdi][te] = s4;
                }
        }
#undef GS_BAR
#undef GS_LOAD
#undef GS_FRAG
        if (!lat) {
            float* so = F.out + (size_t)T * D + soff;
#pragma unroll
            for (int tdi = 0; tdi < 2; ++tdi)
#pragma unroll
                for (int te = 0; te < 4; ++te)
#pragma unroll
                    for (int reg = 0; reg < 4; ++reg) {
                        const int dd = (2 * wave + tdi) * 16 + 4 * fq + reg, e = slice * 64 + te * 16 + fr;
                        so[(size_t)dd * 512 + e] = accS[tdi][te][reg];
                    }
        }
        __syncthreads();
      }
    }
}

__device__ __forceinline__ void phase_postgla(const Frame0& F0, int l) {
    PHASE_IDS(F0);
    const bf16_t* OF = B_OF(F); const bf16_t* R = F.Z3; unsigned char* BIN = (unsigned char*)B_BIN(F);
    float* BS = F.VS + 110592;
    for (int row = F.bid * 8 + F.wave; row < T; row += F.nb * 8) {
        float y[4][8]; float am = 0.f;
#pragma unroll
        for (int hh = 0; hh < 4; ++hh) {
            const int col = hh * 512 + F.lane * 8;
            const u32x4 a = *(const u32x4*)(OF + (size_t)row * D + col), r = *(const u32x4*)(R + (size_t)row * D + col);
            float o[8]; float ss = 0.f;
#pragma unroll
            for (int j = 0; j < 4; ++j) { o[2 * j] = bf_lo(a[j]); o[2 * j + 1] = bf_hi(a[j]); ss += o[2 * j] * o[2 * j] + o[2 * j + 1] * o[2 * j + 1]; }
            const float rn = rsqrtf(wsum(ss) * (1.f / 512.f) + LN_EPS);
            const float4 g0 = *(const float4*)(F.w_gn + (size_t)l * D + col), g1 = *(const float4*)(F.w_gn + (size_t)l * D + col + 4);
            const float gn[8] = {g0.x, g0.y, g0.z, g0.w, g1.x, g1.y, g1.z, g1.w};
#pragma unroll
            for (int j = 0; j < 4; ++j) { y[hh][2 * j] = o[2 * j] * rn * gn[2 * j] * siluf_(bf_lo(r[j])); y[hh][2 * j + 1] = o[2 * j + 1] * rn * gn[2 * j + 1] * siluf_(bf_hi(r[j]));
                am = fmaxf(am, fmaxf(fabsf(y[hh][2 * j]), fabsf(y[hh][2 * j + 1]))); }
        }
        am = wmax(am);
        const float bs = am > 0.f ? am * (1.f / 127.f) : 1.f, binv = 1.f / bs;
#pragma unroll
        for (int hh = 0; hh < 4; ++hh) { u32x2 w; w.x = pack_i8(y[hh][0] * binv, y[hh][1] * binv, y[hh][2] * binv, y[hh][3] * binv); w.y = pack_i8(y[hh][4] * binv, y[hh][5] * binv, y[hh][6] * binv, y[hh][7] * binv);
            *(u32x2*)(BIN + (size_t)row * D + hh * 512 + F.lane * 8) = w; }
        if (F.lane == 0) BS[row] = bs;
    }
}

__device__ __forceinline__ void phase_ln2(const Frame0& F0, int l) {
    PHASE_IDS(F0);
    const float* lg = F.ln_g + (size_t)(l * 2 + 0) * D; const float* lb = F.ln_b + (size_t)(l * 2 + 0) * D;
    const int stride = F.nb * 8;
    int row = F.bid * 8 + F.wave;
    unsigned char* H8 = (unsigned char*)F.Z3 + ((size_t)64 << 20);
    float4 v[8], lgv[8], lbv[8], shv[8], scv[8]; int cci = -1;
#pragma unroll
    for (int i = 0; i < 8; ++i) { lgv[i] = *(const float4*)(lg + i * 256 + F.lane * 4); lbv[i] = *(const float4*)(lb + i * 256 + F.lane * 4); }
    if (row < T) {
#pragma unroll
        for (int i = 0; i < 8; ++i) v[i] = ld_bf4(B_T1(F) + (size_t)row * D + i * 256 + F.lane * 4); }
    for (; row < T; row += stride) {
        float4 vn[8];
        const int nrow = row + stride;
        if (nrow < T) {
#pragma unroll
            for (int i = 0; i < 8; ++i) vn[i] = ld_bf4(B_T1(F) + (size_t)nrow * D + i * 256 + F.lane * 4); }
        else {
#pragma unroll
            for (int i = 0; i < 8; ++i) vn[i] = v[i]; }
        const int ci = cond_of(row);
        if (ci != cci) { const float* md = F.MOD + (size_t)(l * 9 + ci) * NADA; cci = ci;
#pragma unroll
            for (int i = 0; i < 8; ++i) { shv[i] = *(const float4*)(md + 3 * 2048 + i * 256 + F.lane * 4); scv[i] = *(const float4*)(md + 4 * 2048 + i * 256 + F.lane * 4); } }
        float s = 0.f;
#pragma unroll
        for (int i = 0; i < 8; ++i) s += (v[i].x + v[i].y) + (v[i].z + v[i].w);
        float mean = wsum(s) * (1.f / 2048.f); float q = 0.f;
#pragma unroll
        for (int i = 0; i < 8; ++i) { const float a = v[i].x - mean, b = v[i].y - mean, c = v[i].z - mean, d = v[i].w - mean; q += (a * a + b * b) + (c * c + d * d); }
        float rstd = rsqrtf(wsum(q) * (1.f / 2048.f) + LN_EPS);
        s = 0.f;
#pragma unroll
        for (int i = 0; i < 8; ++i) { const float4 g = lgv[i], bb = lbv[i];
            v[i].x = (v[i].x - mean) * rstd * g.x + bb.x; v[i].y = (v[i].y - mean) * rstd * g.y + bb.y; v[i].z = (v[i].z - mean) * rstd * g.z + bb.z; v[i].w = (v[i].w - mean) * rstd * g.w + bb.w;
            s += (v[i].x + v[i].y) + (v[i].z + v[i].w); }
        mean = wsum(s) * (1.f / 2048.f); q = 0.f;
#pragma unroll
        for (int i = 0; i < 8; ++i) { const float a = v[i].x - mean, b = v[i].y - mean, c = v[i].z - mean, d = v[i].w - mean; q += (a * a + b * b) + (c * c + d * d); }
        rstd = rsqrtf(wsum(q) * (1.f / 2048.f) + LN_EPS);
        float am = 0.f;
#pragma unroll
        for (int i = 0; i < 8; ++i) { const int col = i * 256 + F.lane * 4;
            const float4 sh = shv[i], sc = scv[i]; float4 h;
            h.x = (v[i].x - mean) * rstd * (1.f + sc.x) + sh.x; h.y = (v[i].y - mean) * rstd * (1.f + sc.y) + sh.y; h.z = (v[i].z - mean) * rstd * (1.f + sc.z) + sh.z; h.w = (v[i].w - mean) * rstd * (1.f + sc.w) + sh.w;
            u32x2 o; o.x = cvt_pk_bf16(h.x, h.y); o.y = cvt_pk_bf16(h.z, h.w);
            *(u32x2*)(F.H + (size_t)row * D + col) = o;
            v[i] = h; am = fmaxf(am, fmaxf(fmaxf(fabsf(h.x), fabsf(h.y)), fmaxf(fabsf(h.z), fabsf(h.w)))); }
        am = wmax(am);
        const float hs = am > 0.f ? am * (1.f / 127.f) : 1.f, hinv = 1.f / hs;
#pragma unroll
        for (int i = 0; i < 8; ++i) *(unsigned*)(H8 + (size_t)row * D + i * 256 + F.lane * 4) = pack_i8(v[i].x * hinv, v[i].y * hinv, v[i].z * hinv, v[i].w * hinv);
        if (F.lane == 0) F.VS[32768 + row] = hs;
#pragma unroll
        for (int i = 0; i < 8; ++i) v[i] = vn[i];
    }
}

__device__ __forceinline__ unsigned ord_u32(float f) { const unsigned u = __float_as_uint(f); return (u & 0x80000000u) ? ~u : (u | 0x80000000u); }
__device__ __forceinline__ float unord_f32(unsigned u) { return (u & 0x80000000u) ? __uint_as_float(u & 0x7fffffffu) : __uint_as_float(~u); }
__device__ __forceinline__ unsigned umax_(unsigned a, unsigned b) { return a > b ? a : b; }
__device__ __forceinline__ unsigned xmax4(unsigned m) { m = umax_(m, (unsigned)__shfl_xor((int)m, 16)); m = umax_(m, (unsigned)__shfl_xor((int)m, 32)); return m; }
__device__ __forceinline__ void phase_peer_score(const Frame0& F0, int l) {
    PHASE_IDS(F0);
    LAS unsigned char* L = F.lds;
    constexpr int KL_ROW = 272, LW_OFF = 2 * 128 * KL_ROW;
    constexpr int CA[52] = {0, 0, 0, 0, 0, 0, 0, 0, 0, 0, 0, 0, 0, 0, 0, 0, 1, 1, 1, 1, 1, 1, 1, 1, 2, 2, 2, 2, 2, 3, 3, 3, 3, 4, 4, 4, 5, 5, 6, 6, 7, 7, 8, 9, 10, 11, 12, 13, 14, 15, 0, 0};
    constexpr int CB[52] = {0, 1, 2, 3, 4, 5, 6, 7, 8, 9, 10, 11, 12, 13, 14, 15, 0, 1, 2, 3, 4, 5, 6, 7, 0, 1, 2, 3, 4, 0, 1, 2, 3, 0, 1, 2, 0, 1, 0, 1, 0, 1, 0, 0, 0, 0, 0, 0, 0, 0, 0, 0};
    const int tid = F.tid, lane = F.lane, wave = F.wave, fr = lane & 15, fq = lane >> 4;
    const bf16_t* QQ = B_QQ(F);
    int* PIDX = (int*)F.Z3; float* PGATE = (float*)((unsigned char*)F.Z3 + (size_t)T * 128 * 4);
    for (int i = tid; i < 2 * 128 * 128 / 4; i += 512) {
        const int idx = i * 4, side = idx >> 14, n = (idx >> 7) & 127, dd = idx & 127;
        const float4 v = *(const float4*)(F.pkeys + (size_t)l * 2 * 128 * 128 + idx);
        u32x2 w; w.x = cvt_pk_bf16(v.x, v.y); w.y = cvt_pk_bf16(v.z, v.w);
        *(LAS u32x2*)(L + (side * 128 + n) * KL_ROW + dd * 2) = w;
    }
    __syncthreads();
    LAS int* nbuf = (LAS int*)(L + LW_OFF + wave * 4096);
    LAS float* vbuf = (LAS float*)(L + LW_OFF + wave * 4096 + 2048);
    bf16x8 bqn[2][4];
    { const int task0 = F.bid * 8 + wave; if (task0 < (T / 16) * 8) { const int tok0 = (task0 >> 3) * 16 + fr, h0 = task0 & 7;
#pragma unroll
        for (int side = 0; side < 2; ++side)
#pragma unroll
            for (int ks = 0; ks < 4; ++ks) bqn[side][ks] = *(const bf16x8*)(QQ + (size_t)tok0 * D + h0 * 256 + side * 128 + ks * 32 + fq * 8); } }
    for (int task = F.bid * 8 + wave; task < (T / 16) * 8; task += F.nb * 8) {
        const int tg = task >> 3, h = task & 7, tok = tg * 16 + fr;
        unsigned key0[32], key1[32];
#pragma unroll
        for (int side = 0; side < 2; ++side)
#pragma unroll
            for (int tile = 0; tile < 8; ++tile) {
                f32x4 s4 = {0.f, 0.f, 0.f, 0.f};
#pragma unroll
                for (int ks = 0; ks < 4; ++ks) {
                    const bf16x8 a = *(const LAS bf16x8*)(L + (side * 128 + tile * 16 + fr) * KL_ROW + ks * 64 + fq * 16);
                    s4 = __builtin_amdgcn_mfma_f32_16x16x32_bf16(a, bqn[side][ks], s4, 0, 0, 0);
                }
#pragma unroll
                for (int reg = 0; reg < 4; ++reg) { const unsigned kv = (ord_u32(s4[reg]) & ~127u) | (unsigned)(127 - (tile * 16 + 4 * fq + reg)); if (side == 0) key0[tile * 4 + reg] = kv; else key1[tile * 4 + reg] = kv; }
                if (tile & 1) __builtin_amdgcn_sched_barrier(0);
            }
        { const int ntask = task + F.nb * 8; if (ntask < (T / 16) * 8) { const int tokn = (ntask >> 3) * 16 + fr, hn = ntask & 7;
#pragma unroll
            for (int side = 0; side < 2; ++side)
#pragma unroll
                for (int ks = 0; ks < 4; ++ks) bqn[side][ks] = *(const bf16x8*)(QQ + (size_t)tokn * D + hn * 256 + side * 128 + ks * 32 + fq * 8); } }
        float v1[16], v2[16];
#pragma unroll
        for (int side = 0; side < 2; ++side) {
#pragma unroll
            for (int r = 0; r < 16; ++r) {
                unsigned m = side == 0 ? key0[0] : key1[0];
#pragma unroll
                for (int i = 1; i < 32; ++i) m = umax_(m, side == 0 ? key0[i] : key1[i]);
                m = xmax4(m);
#pragma unroll
                for (int i = 0; i < 32; ++i) { if (side == 0) key0[i] = (key0[i] == m) ? 0u : key0[i]; else key1[i] = (key1[i] == m) ? 0u : key1[i]; }
                const float val = unord_f32(m & ~127u);
                if (side == 0) v1[r] = val; else v2[r] = val;
                if (fq == 0) { nbuf[fr * 32 + side * 16 + r] = 127 - (int)(m & 127u); vbuf[fr * 32 + side * 16 + r] = val; }
            }
        }
        unsigned ck[13];
#pragma unroll
        for (int s = 0; s < 13; ++s) {
            const float x0 = v1[CA[4 * s]] + v2[CB[4 * s]], x1 = v1[CA[4 * s + 1]] + v2[CB[4 * s + 1]], x2 = v1[CA[4 * s + 2]] + v2[CB[4 * s + 2]], x3 = v1[CA[4 * s + 3]] + v2[CB[4 * s + 3]];
            const int c0 = CA[4 * s] * 16 + CB[4 * s], c1 = CA[4 * s + 1] * 16 + CB[4 * s + 1], c2 = CA[4 * s + 2] * 16 + CB[4 * s + 2], c3 = CA[4 * s + 3] * 16 + CB[4 * s + 3];
            const float xv = fq == 0 ? x0 : (fq == 1 ? x1 : (fq == 2 ? x2 : x3));
            const int cv = fq == 0 ? c0 : (fq == 1 ? c1 : (fq == 2 ? c2 : c3));
            const bool valid = (4 * s + fq) < 50;
            ck[s] = valid ? ((ord_u32(xv) & ~255u) | (unsigned)(255 - cv)) : 0u;
        }
        unsigned cw[16];
#pragma unroll
        for (int r = 0; r < 16; ++r) {
            unsigned m = ck[0];
#pragma unroll
            for (int i = 1; i < 13; ++i) m = umax_(m, ck[i]);
            m = xmax4(m);
#pragma unroll
            for (int i = 0; i < 13; ++i) ck[i] = (ck[i] == m) ? 0u : ck[i];
            cw[r] = m;
        }
        asm volatile("s_waitcnt lgkmcnt(0)" ::: "memory");
        __builtin_amdgcn_wave_barrier();
        float sv[4]; int ix[4];
#pragma unroll
        for (int i = 0; i < 4; ++i) {
            const unsigned m = fq == 0 ? cw[4 * i] : (fq == 1 ? cw[4 * i + 1] : (fq == 2 ? cw[4 * i + 2] : cw[4 * i + 3]));
            const int code = 255 - (int)(m & 255u), a = code >> 4, b = code & 15;
            ix[i] = nbuf[fr * 32 + a] * 128 + nbuf[fr * 32 + 16 + b];
            sv[i] = vbuf[fr * 32 + a] + vbuf[fr * 32 + 16 + b];
        }
        float mx = fmaxf(fmaxf(sv[0], sv[1]), fmaxf(sv[2], sv[3]));
        mx = fmaxf(mx, __shfl_xor(mx, 16)); mx = fmaxf(mx, __shfl_xor(mx, 32));
        float ev[4], es = 0.f;
#pragma unroll
        for (int i = 0; i < 4; ++i) { ev[i] = __expf(sv[i] - mx); es += ev[i]; }
        es += __shfl_xor(es, 16); es += __shfl_xor(es, 32);
        const float inv = 1.f / es;
#pragma unroll
        for (int i = 0; i < 4; ++i) { const size_t o = ((size_t)tok * 8 + h) * 16 + 4 * i + fq; PIDX[o] = ix[i]; PGATE[o] = ev[i] * inv; }
        asm volatile("s_waitcnt lgkmcnt(0)" ::: "memory");
        __builtin_amdgcn_wave_barrier();
    }
}

constexpr int PE_NG = 32, PE_NJ = 8, PE_NTB = T / 128, PE_BI = 16384;
constexpr size_t NPAIR = (size_t)T * 128;
constexpr size_t PE_ITEMS_OFF = 0, PE_VLIST_OFF = (size_t)32 << 20, PE_BLKOFF_OFF = (size_t)64 << 20, PE_GATES_OFF = (size_t)72 << 20;
__device__ __forceinline__ unsigned lds_add(LAS unsigned* p, unsigned v) { return __hip_atomic_fetch_add(p, v, __ATOMIC_RELAXED, __HIP_MEMORY_SCOPE_WORKGROUP); }
__device__ __forceinline__ void phase_peer_bucket(const Frame0& F0) {
    PHASE_IDS(F0);
    LAS unsigned* cnt = (LAS unsigned*)F.lds;
    LAS unsigned* base = cnt + 256;
    LAS unsigned* gstart = base + 256;
    const int* PIDX = (const int*)F.Z3;
    unsigned* ITEMS = (unsigned*)((unsigned char*)F.Z1 + PE_ITEMS_OFF); int* BLKOFF = (int*)((unsigned char*)F.Z1 + PE_BLKOFF_OFF);
    float* GATES = (float*)((unsigned char*)F.Z1 + PE_GATES_OFF); const float* PGATE = (const float*)((const unsigned char*)F.Z3 + (size_t)T * 128 * 4);
    const int tid = F.tid, lane = F.lane, wave = F.wave;
    for (int tb = F.bid; tb < PE_NTB; tb += F.nb) {
        if (tid < 256) cnt[tid] = 0u;
        __syncthreads();
        unsigned myidx[32];
#pragma unroll
        for (int k = 0; k < 32; ++k) { myidx[k] = (unsigned)PIDX[(size_t)tb * PE_BI + tid + 512 * k]; (void)lds_add(&cnt[wave * 32 + (myidx[k] >> 9)], 1u); }
        __syncthreads();
        if (tid < 64) {
            unsigned s = 0u;
            if (tid < 32) {
#pragma unroll
                for (int w = 0; w < 8; ++w) { const unsigned c = cnt[w * 32 + tid]; base[w * 32 + tid] = s; s += c; }
            }
            unsigned incl = s;
#pragma unroll
            for (int off = 1; off < 32; off <<= 1) { const unsigned v = (unsigned)__shfl_up((int)incl, off); if (lane >= off) incl += v; }
            if (tid < 32) {
                const unsigned excl = incl - s; gstart[tid] = excl; if (tid == 31) gstart[32] = incl;
#pragma unroll
                for (int w = 0; w < 8; ++w) base[w * 32 + tid] += excl;
            }
        }
        __syncthreads();
        if (tid < 33) BLKOFF[tb * 33 + tid] = (int)gstart[tid];
        if (tid < 256) cnt[tid] = 0u;
        __syncthreads();
#pragma unroll
        for (int k = 0; k < 32; ++k) { const int i = tid + 512 * k; const unsigned g = myidx[k] >> 9; const unsigned p = lds_add(&cnt[wave * 32 + g], 1u); const unsigned pos = base[wave * 32 + g] + p;
            ITEMS[(size_t)tb * PE_BI + pos] = ((unsigned)(i >> 7) << 21) | ((unsigned)(i & 127) << 14) | myidx[k]; }
        __syncthreads();
    }
}
__device__ __forceinline__ void phase_peer_u(const Frame0& F0, int l) {
    PHASE_IDS(F0);
    const float* PU = F.peer_u + (size_t)l * 16384 * D;
    LAS unsigned char* L = F.lds;
    constexpr int WROW = 272, P_OFF = 512 * WROW;
    LAS int* P = (LAS int*)(L + P_OFF);
    LAS int* B0 = P + 292;
    LAS int* WT = B0 + 288;
    const unsigned char* H2 = (const unsigned char*)F.Z3 + ((size_t)64 << 20);
    const unsigned* ITEMS = (const unsigned*)((unsigned char*)F.Z1 + PE_ITEMS_OFF); const int* BLKOFF = (const int*)((unsigned char*)F.Z1 + PE_BLKOFF_OFF);
    bf16_t* PART = (bf16_t*)F.Z2;
    const int tid = F.tid, lane = F.lane, wave = F.wave;
    for (int u = F.bid; u < PE_NG * PE_NJ; u += F.nb) {
        const int j = u & 7, g = u >> 3;
        __syncthreads();
        for (int i = tid; i < 512 * 16; i += 512) { const int row = i >> 4, c = i & 15;
            const float* sp = PU + (size_t)(g * 512 + row) * D + j * 256 + c * 16; const float4 a = ((const float4*)sp)[0], b = ((const float4*)sp)[1], cq = ((const float4*)sp)[2], dq = ((const float4*)sp)[3];
            const float ui = 1.f / F.VS[16384 + g * 512 + row];
            u32x4 v; v.x = pack_i8(a.x * ui, a.y * ui, a.z * ui, a.w * ui); v.y = pack_i8(b.x * ui, b.y * ui, b.z * ui, b.w * ui); v.z = pack_i8(cq.x * ui, cq.y * ui, cq.z * ui, cq.w * ui); v.w = pack_i8(dq.x * ui, dq.y * ui, dq.z * ui, dq.w * ui);
            *(LAS u32x4*)(L + row * WROW + c * 16) = v; }
        int c = 0;
        if (tid < PE_NTB) { const int b0 = BLKOFF[tid * 33 + g]; c = BLKOFF[tid * 33 + g + 1] - b0; B0[tid] = b0; }
        int incl = c;
#pragma unroll
        for (int off = 1; off < 64; off <<= 1) { const int v = __shfl_up(incl, off); if (lane >= off) incl += v; }
        if (lane == 63) WT[wave] = incl;
        __syncthreads();
        int woff = 0;
#pragma unroll
        for (int w = 0; w < 8; ++w) woff += (w < wave) ? WT[w] : 0;
        if (tid < PE_NTB) P[tid + 1] = incl + woff;
        if (tid == 0) P[0] = 0;
        __syncthreads();
        const int total = P[PE_NTB];
        const int sub = lane & 3;
        int tbw = 0;
        const unsigned char* hbase = H2 + j * 256 + sub * 16;
        const LAS unsigned char* wbase = L + sub * 16;
        bf16_t* partj = PART + (size_t)j * NPAIR;
#define PU_ISSUE(qb_, S) do { const int q_ = (qb_) + lane; S##ok = q_ < total; S##pp = 0; S##tb = 0; S##raw = 0u; \
            if (S##ok) { while (q_ >= P[tbw + 1]) ++tbw; S##pp = tbw * PE_BI + B0[tbw] + (q_ - P[tbw]); S##tb = tbw * 128; S##raw = ITEMS[S##pp]; } } while (0)
#define PU_BCAST(x_, r_) __builtin_amdgcn_update_dpp(0, (x_), (r_) * 0x55, 0xf, 0xf, true)
#define PU_LH1(TE_, H0_, H1_, r_) { const int bc_ = PU_BCAST(TE_, r_); TE_##e[r_] = bc_ & 511; const unsigned char* hp_ = hbase + (size_t)(bc_ >> 9) * D; H0_[2 * (r_)] = *(const u32x4*)(hp_); H0_[2 * (r_) + 1] = *(const u32x4*)(hp_ + 64); H1_[2 * (r_)] = *(const u32x4*)(hp_ + 128); H1_[2 * (r_) + 1] = *(const u32x4*)(hp_ + 192); }
#define PU_LOADH(S, TE_, H0_, H1_) do { TE_ = (int)(((unsigned)(S##tb + (int)(S##raw >> 21)) << 9) | (S##raw & 511u)); \
            PU_LH1(TE_, H0_, H1_, 0) PU_LH1(TE_, H0_, H1_, 1) PU_LH1(TE_, H0_, H1_, 2) PU_LH1(TE_, H0_, H1_, 3) } while (0)
#define PU_DPP_ADD(x_, ctrl_) ((x_) + __builtin_amdgcn_update_dpp(0, (x_), (ctrl_), 0xf, 0xf, true))
#define PU_D4(h_, w_) s0_ = __builtin_amdgcn_sdot4((int)(h_).x, (int)(w_).x, s0_, false); s1_ = __builtin_amdgcn_sdot4((int)(h_).y, (int)(w_).y, s1_, false); \
                s0_ = __builtin_amdgcn_sdot4((int)(h_).z, (int)(w_).z, s0_, false); s1_ = __builtin_amdgcn_sdot4((int)(h_).w, (int)(w_).w, s1_, false);
#define PU_C1(TE_, H0_, H1_, r_) { const LAS unsigned char* wp_ = wbase + TE_##e[r_] * WROW; \
                const u32x4 w0_ = *(const LAS u32x4*)(wp_), w1_ = *(const LAS u32x4*)(wp_ + 64), w2_ = *(const LAS u32x4*)(wp_ + 128), w3_ = *(const LAS u32x4*)(wp_ + 192); int s0_ = 0, s1_ = 0; \
                PU_D4(H0_[2 * (r_)], w0_) PU_D4(H0_[2 * (r_) + 1], w1_) PU_D4(H1_[2 * (r_)], w2_) PU_D4(H1_[2 * (r_) + 1], w3_) \
                int sm_ = s0_ + s1_; sm_ = PU_DPP_ADD(sm_, 0x4e); sm_ = PU_DPP_ADD(sm_, 0xb1);   \
                keep_ = (sub == r_) ? sm_ : keep_; }
#define PU_COMPUTE(S, TE_, H0_, H1_) do { int keep_ = 0; \
            PU_C1(TE_, H0_, H1_, 0) PU_C1(TE_, H0_, H1_, 1) PU_C1(TE_, H0_, H1_, 2) PU_C1(TE_, H0_, H1_, 3) \
            if (S##ok) partj[S##pp] = f2bf((float)keep_); } while (0)
        u32x4 hA0[8], hA1[8], hB0[8], hB1[8]; int teA, teB, teAe[8], teBe[8];
        bool s0ok, s1ok, s2ok, s3ok; int s0pp, s1pp, s2pp, s3pp, s0tb, s1tb, s2tb, s3tb; unsigned s0raw, s1raw, s2raw, s3raw;
        int qb = wave * 64;
        PU_ISSUE(qb, s0); PU_ISSUE(qb + 512, s1); PU_ISSUE(qb + 1024, s2);
        PU_LOADH(s0, teA, hA0, hA1);
        for (; qb < total; qb += 2048) {
            PU_ISSUE(qb + 1536, s3); PU_LOADH(s1, teB, hB0, hB1); PU_COMPUTE(s0, teA, hA0, hA1);
            PU_ISSUE(qb + 2048, s0); PU_LOADH(s2, teA, hA0, hA1); PU_COMPUTE(s1, teB, hB0, hB1);
            PU_ISSUE(qb + 2560, s1); PU_LOADH(s3, teB, hB0, hB1); PU_COMPUTE(s2, teA, hA0, hA1);
            PU_ISSUE(qb + 3072, s2); PU_LOADH(s0, teA, hA0, hA1); PU_COMPUTE(s3, teB, hB0, hB1);
        }
#undef PU_ISSUE
#undef PU_BCAST
#undef PU_LOADH
#undef PU_LH1
#undef PU_C1
#undef PU_D4
#undef PU_DPP_ADD
#undef PU_COMPUTE
    }
}
__device__ __forceinline__ void phase_peer_coef(const Frame0& F0) {
    PHASE_IDS(F0);
    const unsigned* ITEMS = (const unsigned*)((unsigned char*)F.Z1 + PE_ITEMS_OFF); unsigned* VLIST = (unsigned*)((unsigned char*)F.Z1 + PE_VLIST_OFF);
    const bf16_t* PART = (const bf16_t*)F.Z2; const float* PGATE = (const float*)((const unsigned char*)F.Z3 + (size_t)T * 128 * 4);
    for (int Lu = F.bid; Lu < PE_NTB * 8; Lu += F.nb) {
        int tb, su;
        if (F.nb == 256) { const int k = Lu >> 8, b = Lu & 255; tb = k * 32 + (b & 7) * 4 + (b >> 6); su = (b >> 3) & 7; } else { tb = Lu >> 3; su = Lu & 7; }
        const size_t p0 = (size_t)tb * PE_BI + su * 2048 + F.tid;
        unsigned item[4]; float s[4], gt[4], vs[4], qs[4];
#pragma unroll
        for (int r = 0; r < 4; ++r) { item[r] = ITEMS[p0 + r * 512]; s[r] = 0.f; }
#pragma unroll
        for (int r = 0; r < 4; ++r) { const size_t p = p0 + r * 512;
#pragma unroll
            for (int j = 0; j < PE_NJ; ++j) s[r] += bf1(PART[(size_t)j * NPAIR + p]); }
#pragma unroll
        for (int r = 0; r < 4; ++r) { const int t = tb * 128 + (int)(item[r] >> 21), slot = (int)((item[r] >> 14) & 127u);
            gt[r] = PGATE[(size_t)t * 128 + slot]; vs[r] = F.VS[item[r] & 16383u]; qs[r] = F.VS[16384 + (item[r] & 16383u)] * F.VS[32768 + t]; }
#pragma unroll
        for (int r = 0; r < 4; ++r) { const int t = tb * 128 + (int)(item[r] >> 21), slot = (int)((item[r] >> 14) & 127u); const unsigned idx = item[r] & 16383u;
            const float coef = gt[r] * gelu_tanh(s[r] * qs[r]) * vs[r];
            VLIST[((size_t)(t >> 6) * 128 + slot) * 64 + (t & 63)] = (idx << 16) | (unsigned)f2bf(coef); }
    }
}
constexpr size_t PE_PK_OFF = (size_t)80 << 20;
__device__ __forceinline__ void phase_peer_pack(const Frame0& F0) {
    PHASE_IDS(F0);
    const unsigned* VLIST = (const unsigned*)((unsigned char*)F.Z1 + PE_VLIST_OFF); unsigned* PK = (unsigned*)((unsigned char*)F.Z1 + PE_PK_OFF);
    float* CT = F.VS + 73728;
    for (int tw = F.bid + F.wave * F.nb; tw < T / 64; tw += 8 * F.nb) {
        const int t = tw * 64 + F.lane;
        const unsigned* vl = VLIST + (size_t)(t >> 6) * 8192 + (t & 63);
        float cm = 0.f;
#pragma unroll 1
        for (int kh = 0; kh < 2; ++kh) {
            unsigned it[64];
#pragma unroll
            for (int k = 0; k < 64; ++k) it[k] = vl[(kh * 64 + k) * 64];
#pragma unroll
            for (int k = 0; k < 64; ++k) cm = fmaxf(cm, fabsf(__uint_as_float(it[k] << 16)));
        }
        const float ct = cm > 0.f ? cm * (1.f / 127.f) : 1.f, cinv = 1.f / ct;
        unsigned* pk = PK + (size_t)(t >> 6) * (32 * 3 * 64) + (t & 63);
#pragma unroll 1
        for (int kh = 0; kh < 2; ++kh) {
            unsigned it[64];
#pragma unroll
            for (int k = 0; k < 64; ++k) it[k] = vl[(kh * 64 + k) * 64];
#pragma unroll
            for (int q = 0; q < 16; ++q) { const unsigned w0 = it[4 * q], w1 = it[4 * q + 1], w2 = it[4 * q + 2], w3 = it[4 * q + 3];
                unsigned* o = pk + (size_t)((kh * 16 + q) * 3) * 64;
                o[0] = (w0 >> 16) | (w1 & 0xffff0000u); o[64] = (w2 >> 16) | (w3 & 0xffff0000u);
                o[128] = pack_i8(__uint_as_float(w0 << 16) * cinv, __uint_as_float(w1 << 16) * cinv, __uint_as_float(w2 << 16) * cinv, __uint_as_float(w3 << 16) * cinv); }
        }
        CT[t] = ct;
    }
}
__device__ __forceinline__ void phase_peer_v(const Frame0& F0) {
    PHASE_IDS(F0);
    LAS unsigned char* L = F.lds;
    const unsigned char* V8 = F.V8; const unsigned* PK = (const unsigned*)((unsigned char*)F.Z1 + PE_PK_OFF);
    const float* CT = F.VS + 73728;
    float* FBUF = (float*)F.Z2;
    const int tid = F.tid;
    for (int u0 = F.bid; u0 < 256; u0 += F.nb) {
        const int u = (F.nb == 256) ? (u0 & 7) * 32 + (u0 >> 3) : u0;
        __syncthreads();
        for (int e = tid; e < 16384; e += 512) { const u32x2 v = *(const u32x2*)(V8 + (size_t)e * 2048 + u * 8); *(LAS u32x2*)(L + e * 8) = v; }
        __syncthreads();
        unsigned la[48], lb[48];
#define PV_LOAD(dst, t_, kb_) do { const unsigned* pk_ = PK + (size_t)((t_) >> 6) * (32 * 3 * 64) + ((t_) & 63) + (size_t)(kb_) * 48 * 64; \
            _Pragma("unroll") for (int i_ = 0; i_ < 48; ++i_) dst[i_] = pk_[i_ * 64]; } while (0)
#define PV_QUAD(src, q_) do { const unsigned d0_ = src[3 * (q_)], d1_ = src[3 * (q_) + 1], cq_ = src[3 * (q_) + 2]; \
            const u32x2 x0_ = *(const LAS u32x2*)(L + (d0_ & 0xffffu) * 8), x1_ = *(const LAS u32x2*)(L + (d0_ >> 16) * 8), x2_ = *(const LAS u32x2*)(L + (d1_ & 0xffffu) * 8), x3_ = *(const LAS u32x2*)(L + (d1_ >> 16) * 8); \
            { const unsigned tl01 = __builtin_amdgcn_perm(x1_.x, x0_.x, 0x05010400u), th01 = __builtin_amdgcn_perm(x1_.x, x0_.x, 0x07030602u), tl23 = __builtin_amdgcn_perm(x3_.x, x2_.x, 0x05010400u), th23 = __builtin_amdgcn_perm(x3_.x, x2_.x, 0x07030602u); \
              a0 = __builtin_amdgcn_sdot4((int)__builtin_amdgcn_perm(tl23, tl01, 0x05040100u), (int)cq_, a0, false); a1 = __builtin_amdgcn_sdot4((int)__builtin_amdgcn_perm(tl23, tl01, 0x07060302u), (int)cq_, a1, false); \
              a2 = __builtin_amdgcn_sdot4((int)__builtin_amdgcn_perm(th23, th01, 0x05040100u), (int)cq_, a2, false); a3 = __builtin_amdgcn_sdot4((int)__builtin_amdgcn_perm(th23, th01, 0x07060302u), (int)cq_, a3, false); } \
            { const unsigned tl01 = __builtin_amdgcn_perm(x1_.y, x0_.y, 0x05010400u), th01 = __builtin_amdgcn_perm(x1_.y, x0_.y, 0x07030602u), tl23 = __builtin_amdgcn_perm(x3_.y, x2_.y, 0x05010400u), th23 = __builtin_amdgcn_perm(x3_.y, x2_.y, 0x07030602u); \
              a4 = __builtin_amdgcn_sdot4((int)__builtin_amdgcn_perm(tl23, tl01, 0x05040100u), (int)cq_, a4, false); a5 = __builtin_amdgcn_sdot4((int)__builtin_amdgcn_perm(tl23, tl01, 0x07060302u), (int)cq_, a5, false); \
              a6 = __builtin_amdgcn_sdot4((int)__builtin_amdgcn_perm(th23, th01, 0x05040100u), (int)cq_, a6, false); a7 = __builtin_amdgcn_sdot4((int)__builtin_amdgcn_perm(th23, th01, 0x07060302u), (int)cq_, a7, false); } } while (0)
#define PV_BATCH(src) do { _Pragma("unroll") for (int q_ = 0; q_ < 16; ++q_) { PV_QUAD(src, q_); if ((q_ & 3) == 3) __builtin_amdgcn_sched_barrier(0); } } while (0)
        PV_LOAD(la, tid, 0);
        for (int t = tid; t < T; t += 512) {
            int a0 = 0, a1 = 0, a2 = 0, a3 = 0, a4 = 0, a5 = 0, a6 = 0, a7 = 0;
            const float ct = CT[t];
            const int tn = (t + 512 < T) ? t + 512 : t;
            PV_LOAD(lb, t, 1); PV_BATCH(la);
            PV_LOAD(la, tn, 0); PV_BATCH(lb);
            f32x4 o0 = {(float)a0 * ct, (float)a1 * ct, (float)a2 * ct, (float)a3 * ct}, o1 = {(float)a4 * ct, (float)a5 * ct, (float)a6 * ct, (float)a7 * ct};
            *(f32x4*)(FBUF + (size_t)t * D + u * 8) = o0; *(f32x4*)(FBUF + (size_t)t * D + u * 8 + 4) = o1;
        }
#undef PV_LOAD
#undef PV_QUAD
#undef PV_BATCH
    }
}
__device__ __forceinline__ void phase_peer_final(const Frame0& F0, int l) {
    PHASE_IDS(F0);
    const float* FBUF = (const float*)F.Z2;
    const float* lg = F.ln_g + (size_t)(l * 2 + 1) * D; const float* lb = F.ln_b + (size_t)(l * 2 + 1) * D;
    const float* lg0 = F.ln_g + (size_t)(l * 2 + 0) * D; const float* lb0 = F.ln_b + (size_t)(l * 2 + 0) * D;
    LAS float* PL = (LAS float*)F.lds;
    for (int i = F.tid; i < 2048; i += 512) { PL[i] = lg0[i]; PL[2048 + i] = lb0[i]; PL[4096 + i] = lg[i]; PL[6144 + i] = lb[i]; }
    __syncthreads();
    const int stride = F.nb * 8;
    int row = F.bid * 8 + F.wave;
    float4 xv[8], g2v[8]; int cci = -1;
    if (row < T) {
#pragma unroll
        for (int i = 0; i < 8; ++i) xv[i] = ld_bf4(B_T1(F) + (size_t)row * D + i * 256 + F.lane * 4); }
    for (; row < T; row += stride) {
        float4 xn[8], fv[8];
#pragma unroll
        for (int i = 0; i < 8; ++i) fv[i] = *(const float4*)(FBUF + (size_t)row * D + i * 256 + F.lane * 4);
        const int nrow = row + stride;
        if (nrow < T) {
#pragma unroll
            for (int i = 0; i < 8; ++i) xn[i] = ld_bf4(B_T1(F) + (size_t)nrow * D + i * 256 + F.lane * 4); }
        else {
#pragma unroll
            for (int i = 0; i < 8; ++i) xn[i] = xv[i]; }
        int lo4 = F.lane * 4; asm volatile("" : "+v"(lo4));
        {
            float s0 = 0.f;
#pragma unroll
            for (int i = 0; i < 8; ++i) s0 += (xv[i].x + xv[i].y) + (xv[i].z + xv[i].w);
            const float mean0 = wsum(s0) * (1.f / 2048.f); float q0 = 0.f;
#pragma unroll
            for (int i = 0; i < 8; ++i) { const float a = xv[i].x - mean0, b = xv[i].y - mean0, c = xv[i].z - mean0, d = xv[i].w - mean0; q0 += (a * a + b * b) + (c * c + d * d); }
            const float rstd0 = rsqrtf(wsum(q0) * (1.f / 2048.f) + LN_EPS);
#pragma unroll
            for (int i = 0; i < 8; ++i) { const f32x4 g = *(const LAS f32x4*)(PL + i * 256 + lo4), bb = *(const LAS f32x4*)(PL + 2048 + i * 256 + lo4);
                xv[i].x = (xv[i].x - mean0) * rstd0 * g.x + bb.x; xv[i].y = (xv[i].y - mean0) * rstd0 * g.y + bb.y; xv[i].z = (xv[i].z - mean0) * rstd0 * g.z + bb.z; xv[i].w = (xv[i].w - mean0) * rstd0 * g.w + bb.w; }
        }
        float* xr = F.XA + (size_t)row * D;
        const int ci = cond_of(row);
        if (ci != cci) { const float* g2 = F.MOD + (size_t)(l * 9 + ci) * NADA + 5 * 2048; cci = ci;
#pragma unroll
            for (int i = 0; i < 8; ++i) g2v[i] = *(const float4*)(g2 + i * 256 + F.lane * 4); }
        float4 v[8]; float s = 0.f;
#pragma unroll
        for (int i = 0; i < 8; ++i) { const float4 x = xv[i], g = g2v[i], f = fv[i];
            v[i].x = ALPHA * x.x + g.x * f.x; v[i].y = ALPHA * x.y + g.y * f.y; v[i].z = ALPHA * x.z + g.z * f.z; v[i].w = ALPHA * x.w + g.w * f.w; s += (v[i].x + v[i].y) + (v[i].z + v[i].w); }
        float mean = wsum(s) * (1.f / 2048.f); float q = 0.f;
#pragma unroll
        for (int i = 0; i < 8; ++i) { const float a = v[i].x - mean, b = v[i].y - mean, c = v[i].z - mean, d = v[i].w - mean; q += (a * a + b * b) + (c * c + d * d); }
        float rstd = rsqrtf(wsum(q) * (1.f / 2048.f) + LN_EPS);
        s = 0.f;
#pragma unroll
        for (int i = 0; i < 8; ++i) { const int col = i * 256 + F.lane * 4; const f32x4 g = *(const LAS f32x4*)(PL + 4096 + i * 256 + lo4), bb = *(const LAS f32x4*)(PL + 6144 + i * 256 + lo4);
            v[i].x = (v[i].x - mean) * rstd * g.x + bb.x; v[i].y = (v[i].y - mean) * rstd * g.y + bb.y; v[i].z = (v[i].z - mean) * rstd * g.z + bb.z; v[i].w = (v[i].w - mean) * rstd * g.w + bb.w;
            *(float4*)(xr + col) = v[i]; s += (v[i].x + v[i].y) + (v[i].z + v[i].w); }
        if (l == 0) {
            const float* md = F.MOD + (size_t)(9 + ci) * NADA;
            float4 shn[8], scn[8];
#pragma unroll
            for (int i = 0; i < 8; ++i) { shn[i] = *(const float4*)(md + i * 256 + F.lane * 4); scn[i] = *(const float4*)(md + 2048 + i * 256 + F.lane * 4); }
            mean = wsum(s) * (1.f / 2048.f); q = 0.f;
#pragma unroll
            for (int i = 0; i < 8; ++i) { const float a = v[i].x - mean, b = v[i].y - mean, c = v[i].z - mean, d = v[i].w - mean; q += (a * a + b * b) + (c * c + d * d); }
            rstd = rsqrtf(wsum(q) * (1.f / 2048.f) + LN_EPS);
            float am = 0.f;
#pragma unroll
            for (int i = 0; i < 8; ++i) { const int col = i * 256 + F.lane * 4;
                const float4 sh = shn[i], sc = scn[i];
                float4 h; h.x = (v[i].x - mean) * rstd * (1.f + sc.x) + sh.x; h.y = (v[i].y - mean) * rstd * (1.f + sc.y) + sh.y; h.z = (v[i].z - mean) * rstd * (1.f + sc.z) + sh.z; h.w = (v[i].w - mean) * rstd * (1.f + sc.w) + sh.w;
                if (row < TCTX) { u32x2 o; o.x = cvt_pk_bf16(h.x, h.y); o.y = cvt_pk_bf16(h.z, h.w); *(u32x2*)(F.H + (size_t)row * D + col) = o; }
                v[i] = h; am = fmaxf(am, fmaxf(fmaxf(fabsf(h.x), fabsf(h.y)), fmaxf(fabsf(h.z), fabsf(h.w)))); }
            am = wmax(am);
            const float hs = am > 0.f ? am * (1.f / 127.f) : 1.f, hinv = 1.f / hs;
#pragma unroll
            for (int i = 0; i < 8; ++i) *(unsigned*)(F.ws + WS_H8IN + (size_t)row * D + i * 256 + F.lane * 4) = pack_i8(v[i].x * hinv, v[i].y * hinv, v[i].z * hinv, v[i].w * hinv);
            if (F.lane == 0) ((float*)(F.ws + WS_HSIN))[row] = hs;
        }
#pragma unroll
        for (int i = 0; i < 8; ++i) xv[i] = xn[i];
    }
}

constexpr int N_PHASES = 25;
__global__ void __launch_bounds__(512, 2) hybrid_fwd(Args args) {
    extern __shared__ __attribute__((aligned(16))) unsigned char lds_raw[];
    Frame0 F; F.lds = (LAS unsigned char*)lds_raw;
    const int lo = args.ph_lo, hi = args.ph_hi;
#if MK_ONE_LAUNCH
    volatile LAS unsigned* misc = (volatile LAS unsigned*)(F.lds + MISC_OFF);
    if (threadIdx.x < 16) misc[threadIdx.x] = 0u;
    __syncthreads();
    XcdBarrier bar = xcd_barrier_post((unsigned*)(args.ws + WS_BAR), misc);
#define SEAM(k) do { xcd_barrier(bar); } while (0)
#else
#define SEAM(k) do { } while (0)
#endif
#define NREP(k) ((args.rep == (k)) ? 2 : 1)
#ifndef PH_ONLY
#define PH_ONLY -1
#endif
#define IN(k) (lo <= (k) && (k) < hi && (PH_ONLY < 0 || ((k) == 0 ? 0 : ((k) - 1) % 12 + 1) == PH_ONLY))
    if (IN(0)) { for (int r = NREP(13); r > 0; --r) { phase_prologue(F); SEAM(0); } }
    for (int l = 0; l < 2; ++l) {
        const int pb = 1 + 12 * l;
        if (IN(pb + 0) && l == 0) { for (int r = NREP(1); r > 0; --r) { phase_lnmod(F, l); SEAM(pb + 0); } }
        if (IN(pb + 1)) { for (int r = NREP(2); r > 0; --r) { phase_gemm_in(F, l); SEAM(pb + 1); } }
        if (IN(pb + 2)) { for (int r = NREP(3); r > 0; --r) { phase_conv(F, l); SEAM(pb + 2); } }
        if (IN(pb + 3)) { phase_gemm_a(F, l); SEAM(pb + 3); }
        if (IN(pb + 4)) {
#ifndef NO_PREP
            for (int r = NREP(4); r > 0; --r) { phase_gla_prep(F, l); SEAM(pb + 4); }
#endif
#ifndef NO_SCAN
            for (int r = NREP(5); r > 0; --r) { phase_gla_scan(F, l); SEAM(pb + 4); }
#endif
        }
        if (IN(pb + 5)) { for (int r = NREP(6); r > 0; --r) { phase_postgla(F, l); SEAM(pb + 5); } }
        if (IN(pb + 6)) { phase_gemm_b(F, l); SEAM(pb + 6); }
        if (IN(pb + 7)) { phase_gemm_o(F, l); SEAM(pb + 7); }
        if (IN(pb + 8)) { phase_ln2(F, l); conv_tables(F, l); SEAM(pb + 8); }
        if (IN(pb + 9)) { for (int r = NREP(10); r > 0; --r) { phase_gemm_pq(F, l); SEAM(pb + 9); } }
        if (IN(pb + 10)) { for (int r = NREP(11); r > 0; --r) { phase_peer_score(F, l); SEAM(pb + 10); } }
        if (IN(pb + 11)) {
            for (int r = NREP(20); r > 0; --r) { phase_peer_bucket(F); SEAM(pb + 11); }
            for (int r = NREP(21); r > 0; --r) { phase_peer_u(F, l); SEAM(pb + 11); }
            for (int r = NREP(22); r > 0; --r) { phase_peer_coef(F); SEAM(pb + 11); }
            phase_peer_pack(F); SEAM(pb + 11);
            for (int r = NREP(23); r > 0; --r) { phase_peer_v(F); SEAM(pb + 11); }
            phase_peer_final(F, l); SEAM(pb + 11); }
    }
#undef IN
#undef SEAM
}

extern "C" void kernel_launch(void* const* d_in, const int* in_sizes, int n_in, void* d_out, int out_size, void* d_ws, size_t ws_size, hipStream_t stream) {
    static int grid = 0;
    if (grid == 0) {
        if (n_in != 21 || ws_size < WS_END) { fprintf(stderr, "kernel_launch: unexpected inputs (n_in %d) or workspace %zu < %zu\n", n_in, ws_size, (size_t)WS_END); grid = -1; return; }
        int dev = 0, cus = 0, per_cu = 0;
        if (hipGetDevice(&dev) != hipSuccess || hipDeviceGetAttribute(&cus, hipDeviceAttributeMultiprocessorCount, dev) != hipSuccess) { grid = -1; return; }
        if (hipFuncSetAttribute((const void*)hybrid_fwd, hipFuncAttributeMaxDynamicSharedMemorySize, LDS_TOTAL) != hipSuccess) { fprintf(stderr, "kernel_launch: hipFuncSetAttribute failed\n"); grid = -1; return; }
        if (hipOccupancyMaxActiveBlocksPerMultiprocessor(&per_cu, (const void*)hybrid_fwd, 512, LDS_TOTAL) != hipSuccess || per_cu < 1) { fprintf(stderr, "kernel_launch: occupancy query says %d\n", per_cu); }
        (void)hipGetLastError();
        grid = cus;
    }
    if (grid < 0) return;
    (void)hipMemsetAsync((char*)d_ws + WS_BAR, 0, 16384, stream);
    Args a{};
    for (int i = 0; i < 21; ++i) a.in[i] = (const float*)d_in[i];
    a.out = (float*)d_out; a.ws = (unsigned char*)d_ws;
#ifndef PROBE_REP
#define PROBE_REP 0
#endif
    a.rep = PROBE_REP; a.pad = 0;
#if MK_ONE_LAUNCH
    a.ph_lo = 0; a.ph_hi = N_PHASES;
    hipLaunchKernelGGL(hybrid_fwd, dim3(grid), dim3(512), LDS_TOTAL, stream, a);
#else
    for (int p = 0; p < N_PHASES; ++p) { a.ph_lo = p; a.ph_hi = p + 1; hipLaunchKernelGGL(hybrid_fwd, dim3(grid), dim3(512), LDS_TOTAL, stream, a); }
#endif
}
```

```cpp
#include <hip/hip_runtime.h>
#include <cstdio>
#include <cstdint>

#ifndef STORE_POLICY
#define STORE_POLICY 1
#endif
#ifndef MK_ONE_LAUNCH
#define MK_ONE_LAUNCH 1
#endif

#define LAS __attribute__((address_space(3)))
typedef unsigned short bf16_t;
typedef short bf16x8 __attribute__((ext_vector_type(8)));
typedef float f32x4 __attribute__((ext_vector_type(4)));
typedef unsigned u32x4 __attribute__((ext_vector_type(4)));
typedef int i32x4 __attribute__((ext_vector_type(4)));
typedef unsigned u32x2 __attribute__((ext_vector_type(2)));
typedef __bf16 bf16x2_t __attribute__((ext_vector_type(2)));

constexpr int D = 2048, TCTX = 4096, TLAT = 32768, T = TCTX + TLAT;
constexpr int NINP = 13568;
constexpr int NADA = 12288;
constexpr float ALPHA = 1.41421356237f;
constexpr float LN_EPS = 1e-5f;
constexpr int LDS_TOTAL = 155648;
constexpr int MISC_OFF = LDS_TOTAL - 64;

constexpr size_t al256(size_t x) { return (x + 255) & ~(size_t)255; }
constexpr size_t WS_BAR = 0;
constexpr size_t WS_MOD = 16384;
constexpr size_t WS_WIN = WS_MOD + 1048576;
constexpr size_t WS_WA = WS_WIN + (size_t)2 * NINP * 2048 * 2;
constexpr size_t WS_WB = WS_WA + (size_t)2 * 2048 * 1024 * 2;
constexpr size_t WS_WO = WS_WB + (size_t)2 * 2048 * 2048 * 2;
constexpr size_t WS_WPQ = WS_WO + (size_t)2 * 2048 * 2048 * 2;
constexpr size_t WS_H = WS_WPQ + (size_t)2 * 2048 * 2048 * 2;
constexpr size_t WS_Z1 = WS_H + (size_t)T * 2048 * 2;
constexpr size_t WS_Z2 = WS_Z1 + (size_t)T * 3072 * 2;
constexpr size_t WS_Z3 = WS_Z2 + (size_t)T * 4096 * 2;
constexpr size_t WS_Z4 = WS_Z3 + (size_t)T * 2048 * 2;
constexpr size_t WS_U16 = WS_Z4;
constexpr size_t WS_V8 = WS_U16 + (size_t)16384 * 2048 * 2;
constexpr size_t WS_VS = WS_V8 + (size_t)16384 * 2048;
constexpr size_t WS_Z5 = WS_Z4 + (size_t)T * 4096 * 2;
constexpr size_t WS_END0 = WS_Z5 + (size_t)T * 32 * 4;
constexpr size_t WS_H8IN = al256(WS_END0);
constexpr size_t WS_W8IN = WS_H8IN + (size_t)T * 2048;
constexpr size_t WS_CSIN = WS_W8IN + (size_t)2 * NINP * 2048;
constexpr size_t WS_HSIN = WS_CSIN + (size_t)2 * NINP * 4;
constexpr size_t WS_ASIN = WS_HSIN + (size_t)T * 4;
constexpr size_t WS_YS = WS_ASIN + (size_t)T * 4;
constexpr size_t WS_END = WS_YS + (size_t)T * 4;

__device__ __forceinline__ unsigned cvt_pk_bf16(float lo, float hi) { unsigned r; asm("v_cvt_pk_bf16_f32 %0, %1, %2" : "=v"(r) : "v"(lo), "v"(hi)); return r; }
__device__ __forceinline__ bf16_t f2bf(float x) { return (bf16_t)(cvt_pk_bf16(x, 0.f) & 0xffffu); }
__device__ __forceinline__ float bf_lo(unsigned w) { return __uint_as_float(w << 16); }
__device__ __forceinline__ float bf_hi(unsigned w) { return __uint_as_float(w & 0xffff0000u); }
__device__ __forceinline__ float bf1(bf16_t u) { return __uint_as_float((unsigned)u << 16); }
__device__ __forceinline__ float wmax(float v) {
#pragma unroll
    for (int sh = 32; sh >= 1; sh >>= 1) v = fmaxf(v, __shfl_xor(v, sh));
    return v; }
__device__ __forceinline__ unsigned pack_i8(float a, float b, float c, float d) { const int q0 = __float2int_rn(a), q1 = __float2int_rn(b), q2 = __float2int_rn(c), q3 = __float2int_rn(d);
    return ((unsigned)q0 & 255u) | (((unsigned)q1 & 255u) << 8) | (((unsigned)q2 & 255u) << 16) | ((unsigned)q3 << 24); }
__device__ __forceinline__ float wsum(float v) {
#pragma unroll
    for (int m = 32; m >= 1; m >>= 1) v += __shfl_xor(v, m);
    return v;
}
__device__ __forceinline__ float sigmoidf_(float x) { return __builtin_amdgcn_rcpf(1.f + __expf(-x)); }
__device__ __forceinline__ float siluf_(float x) { return x * sigmoidf_(x); }
__device__ __forceinline__ float gelu_tanh(float x) {
    const float y = 0.7978845608028654f * (x + 0.044715f * x * x * x);
    const float e = __expf(2.f * y);
    const float th = 1.f - 2.f * __builtin_amdgcn_rcpf(e + 1.f);
    return 0.5f * x * (1.f + th);
}
__device__ __forceinline__ float dot2bf(unsigned a, unsigned b, float acc) { return __builtin_amdgcn_fdot2_f32_bf16(__builtin_bit_cast(bf16x2_t, a), __builtin_bit_cast(bf16x2_t, b), acc, false); }

#define XB_TMO      128
#define XB_XCNT(j)  (256  + 64 * (j))
#define XB_XSUB(j)  (1280 + 64 * (j))
#define XB_XGEN(j)  (2304 + 64 * (j))
#define XB_TOP      3328
#define XB_TOPGEN   3392
#define XCD_BAR_WORDS 3456
#define XB_SPIN_CAP (1u << 18)
__device__ __forceinline__ unsigned xb_ld(unsigned* p)              { return __hip_atomic_load(p, __ATOMIC_RELAXED, __HIP_MEMORY_SCOPE_AGENT); }
__device__ __forceinline__ unsigned xb_add(unsigned* p, unsigned v) { return __hip_atomic_fetch_add(p, v, __ATOMIC_RELAXED, __HIP_MEMORY_SCOPE_AGENT); }
__device__ __forceinline__ unsigned xb_xcc_id() { return (unsigned)__builtin_amdgcn_s_getreg((3 << 11) | 20) & 0xFu; }
#define XB_SPIN(cond, bar) do { unsigned _sp = 0; while (cond) { __builtin_amdgcn_s_sleep(1); \
    if ((++_sp & 255u) == 0u) { if (xb_ld(&(bar)[XB_TMO])) break; if (_sp > XB_SPIN_CAP) { atomicAdd(&(bar)[XB_TMO], 1u); break; } } } } while (0)
struct XcdBarrier { unsigned* bar; unsigned x; volatile LAS unsigned* st; };
__device__ __forceinline__ XcdBarrier xcd_barrier_post(unsigned* bar, volatile LAS unsigned* st) {
    XcdBarrier b; b.bar = bar; b.x = xb_xcc_id(); b.st = st;
    if (threadIdx.x == 0) (void)xb_add(&bar[XB_XCNT(b.x)], 1u);
    return b;
}
__device__ __forceinline__ void xcd_barrier_complete(unsigned* bar, unsigned x, unsigned& nloc, unsigned& nx) {
    const unsigned G = gridDim.x * gridDim.y * gridDim.z;
    unsigned sum, cnt, mine, sp = 0u;
    for (;;) {
        sum = 0u; cnt = 0u; mine = 0u;
#pragma unroll
        for (unsigned j = 0; j < 16; ++j) { const unsigned c = xb_ld(&bar[XB_XCNT(j)]); sum += c; cnt += (c > 0u) ? 1u : 0u; mine = (j == x) ? c : mine; }
        if (sum == G) break;
        __builtin_amdgcn_s_sleep(1);
        if ((++sp & 255u) == 0u) { if (xb_ld(&bar[XB_TMO])) break; if (sp > XB_SPIN_CAP) { atomicAdd(&bar[XB_TMO], 1u); break; } }
    }
    nloc = mine > 0u ? mine : 1u; nx = cnt > 0u ? cnt : 1u;
}
__device__ __forceinline__ void xcd_barrier(const XcdBarrier& b) {
    asm volatile("s_waitcnt vmcnt(0)" ::: "memory");
    __syncthreads();
    if (threadIdx.x == 0) {
        unsigned* bar = b.bar;
        __builtin_amdgcn_s_waitcnt(0);
        unsigned nloc = b.st[0], nx = b.st[1];
        if (nloc == 0u) { xcd_barrier_complete(bar, b.x, nloc, nx); b.st[0] = nloc; b.st[1] = nx; }
        const unsigned old = xb_add(&bar[XB_XSUB(b.x)], 1u);
        const unsigned gen = old / nloc;
        if (old + 1u == (gen + 1u) * nloc) {
            __builtin_amdgcn_fence(__ATOMIC_RELEASE, "agent");
            asm volatile("s_waitcnt vmcnt(0)" ::: "memory");
            const unsigned og = xb_add(&bar[XB_TOP], 1u);
            const unsigned tg = og / nx;
            if (og + 1u == (tg + 1u) * nx) xb_add(&bar[XB_TOPGEN], 1u);
            else XB_SPIN(xb_ld(&bar[XB_TOPGEN]) == tg, bar);
            __builtin_amdgcn_fence(__ATOMIC_ACQUIRE, "agent");
            xb_add(&bar[XB_XGEN(b.x)], 1u);
            asm volatile("s_waitcnt vmcnt(0)" ::: "memory");
        } else {
            XB_SPIN(xb_ld(&bar[XB_XGEN(b.x)]) == gen, bar);
            __builtin_amdgcn_fence(__ATOMIC_ACQUIRE, "agent");
            asm volatile("s_waitcnt vmcnt(0)" ::: "memory");
        }
    }
    __syncthreads();
}

namespace pg8 {
#define PG8_LAS __attribute__((address_space(3)))
constexpr int BM = 256, BK = 64, HALF = 128, HTB = HALF * BK * 2, STAGE_BYTES = 8 * HTB, NXCD = 8, WGM = 8;
__host__ __device__ __forceinline__ int lds_byte(int r, int c) { const int st = (r >> 4) * 2 + (c >> 5), rr = r & 15, cc = c & 31, ob = rr * 64 + cc * 2; return st * 1024 + (ob ^ (((ob >> 9) & 1) << 5)); }
__host__ __device__ __forceinline__ void stage_rc(int b, int& R, int& C) { const int st = b / 1024, sb = b % 1024, swz = sb ^ (((sb >> 9) & 1) << 5); R = (st >> 1) * 16 + swz / 64; C = (st & 1) * 32 + (swz % 64) / 2; }
__host__ __device__ __forceinline__ int perm32(int rho) { const int n = rho >> 4, i = rho & 15; return 8 * (i >> 2) + 4 * n + (i & 3); }
struct Unit { int pm, pn; };
struct Gemm { const bf16_t* A; const bf16_t* Bt; int M, N, K; };
struct StaticOrder {
    int nM, nN, nwg, G, c;
    __host__ __device__ void init(int M, int N, int G_, int c_) { nM = M / BM; nN = N / BM; nwg = nM * nN; G = G_; c = c_; }
    __host__ __device__ bool next(int i, Unit& u) const {
        const long L = (long)i * G + c; if (L >= nwg) return false;
        int wgid = (int)L; { const int q = nwg / NXCD, r = nwg % NXCD, xcd = wgid % NXCD, off = wgid / NXCD; wgid = (xcd < r ? xcd * (q + 1) : r * (q + 1) + (xcd - r) * q) + off; }
        const int nig = WGM * nN, gid = wgid / nig, fm = gid * WGM, gsz = (nM - fm) < WGM ? (nM - fm) : WGM;
        u.pm = fm + ((wgid % nig) % gsz); u.pn = (wgid % nig) / gsz; return true;
    }
    __device__ __forceinline__ void a_ready(const Unit&) const {}
    __device__ __forceinline__ void done(const Unit&) const {}
};

template <bool I8> struct AccT { typedef f32x4 type; };
template <> struct AccT<true> { typedef i32x4 type; };
template <class Epi, class Sched, bool ALIGN_EPI = false, bool SP2 = false, bool I8 = false>
__device__ __forceinline__ void gemm_phase(PG8_LAS unsigned char* lds, const Gemm g, const Sched& S, const Epi& E) {
    int tid_ = threadIdx.x; asm volatile("" : "+v"(tid_));
    const int tid = tid_, wid = __builtin_amdgcn_readfirstlane(tid >> 6), lane = tid & 63, wr = wid >> 2, wc = wid & 3, fr = lane & 15, fq = lane >> 4;
    const int K = g.K, nt = I8 ? K / (2 * BK) : K / BK; const unsigned KB = I8 ? (unsigned)K : 2u * (unsigned)K;
    typedef typename AccT<I8>::type acc_t;
    unsigned voffA[2], voffB[2];
#pragma unroll
    for (int i = 0; i < 2; ++i) { int R, C; stage_rc(tid * 16 + i * 8192, R, C); const int Rb = 64 * (R >> 5) + (Epi::PERM ? perm32(R & 31) : (R & 31));
        voffA[i] = (unsigned)R * KB + (unsigned)C * 2u; voffB[i] = (unsigned)Rb * KB + (unsigned)C * 2u; }
    const size_t kstep = (size_t)(BK * 2);
    const size_t hstep = (size_t)HALF * KB;
    const size_t hstepB = (size_t)32 * KB;
    const size_t tstep = 2 * hstep;
    const unsigned ldsw = (unsigned)wid * 1024u;
    const int aoff = lds_byte(wr * 64 + fr, fq * 8), boff = lds_byte(wc * 32 + fr, fq * 8);
#define PG8_SA(b, h) (((b) * 2 + (h)) * HTB)
#define PG8_SB(b, h) ((4 + (b) * 2 + (h)) * HTB)
#define PG8_STAGE(bufoff, gbase, voff) do { _Pragma("unroll") for (int _i = 0; _i < 2; ++_i) \
        __builtin_amdgcn_global_load_lds((const unsigned*)((const char*)(gbase) + (voff)[_i]), (PG8_LAS unsigned*)(lds + (bufoff) + ldsw + _i * 8192), 16, 0, 0); } while (0)
#define PG8_LDA(dst, b, h) do { _Pragma("unroll") for (int m = 0; m < 4; ++m) _Pragma("unroll") for (int k = 0; k < 2; ++k) dst[m][k] = *(const PG8_LAS bf16x8*)(lds + PG8_SA(b, h) + aoff + m * 2048 + k * 1024); } while (0)
#define PG8_LDB(dst, b, h) do { _Pragma("unroll") for (int n = 0; n < 2; ++n) _Pragma("unroll") for (int k = 0; k < 2; ++k) dst[n][k] = *(const PG8_LAS bf16x8*)(lds + PG8_SB(b, h) + boff + n * 2048 + k * 1024); } while (0)
#define PG8_MMA(ai, bj, At, Bt) do { __builtin_amdgcn_s_setprio(1); _Pragma("unroll") for (int m = 0; m < 4; ++m) _Pragma("unroll") for (int n = 0; n < 2; ++n) _Pragma("unroll") for (int k = 0; k < 2; ++k) \
        { if constexpr (I8) acc[ai][bj][m][n] = __builtin_amdgcn_mfma_i32_16x16x64_i8(__builtin_bit_cast(i32x4, Bt[n][k]), __builtin_bit_cast(i32x4, At[m][k]), acc[ai][bj][m][n], 0, 0, 0); \
          else acc[ai][bj][m][n] = __builtin_amdgcn_mfma_f32_16x16x32_bf16(Bt[n][k], At[m][k], acc[ai][bj][m][n], 0, 0, 0); } __builtin_amdgcn_s_setprio(0); } while (0)
#define PG8_WAIT_V(n) asm volatile("s_waitcnt vmcnt(" #n ")" ::: "memory")
#define PG8_WAIT_L(n) asm volatile("s_waitcnt lgkmcnt(" #n ")" ::: "memory")
#define PG8_BAR __builtin_amdgcn_s_barrier()
#define PG8_SCHED __builtin_amdgcn_sched_barrier(0)
    Unit cur, nxt; int ui = 0;
    if (!S.next(0, cur)) return;
    acc_t acc[2][2][4][2];
#pragma unroll
    for (int a = 0; a < 2; ++a)
#pragma unroll
        for (int b = 0; b < 2; ++b)
#pragma unroll
            for (int m = 0; m < 4; ++m)
#pragma unroll
                for (int n = 0; n < 2; ++n) acc[a][b][m][n] = (acc_t){0, 0, 0, 0};
    bf16x8 At[4][2], B0[2][2], B1[2][2];
    const char* cA = (const char*)g.A + (size_t)cur.pm * tstep; const char* cB = (const char*)g.Bt + (size_t)cur.pn * tstep;
    S.a_ready(cur);
    if constexpr (SP2) {
        PG8_STAGE(PG8_SB(0, 0), cB, voffB); PG8_STAGE(PG8_SB(0, 1), cB + hstepB, voffB); PG8_STAGE(PG8_SA(0, 0), cA, voffA); PG8_STAGE(PG8_SA(0, 1), cA + hstep, voffA);
        if (wr == 1) PG8_BAR;
        PG8_WAIT_V(2); PG8_BAR;
        PG8_STAGE(PG8_SB(1, 0), cB + kstep, voffB); PG8_STAGE(PG8_SA(1, 0), cA + kstep, voffA); PG8_STAGE(PG8_SB(1, 1), cB + hstepB + kstep, voffB);
        PG8_WAIT_V(6); PG8_BAR;
    } else {
        PG8_STAGE(PG8_SB(0, 0), cB, voffB); PG8_STAGE(PG8_SA(0, 0), cA, voffA); PG8_STAGE(PG8_SB(0, 1), cB + hstepB, voffB); PG8_STAGE(PG8_SA(0, 1), cA + hstep, voffA);
        if (wr == 1) PG8_BAR;
        PG8_WAIT_V(4); PG8_BAR;
        PG8_STAGE(PG8_SB(1, 0), cB + kstep, voffB); PG8_STAGE(PG8_SA(1, 0), cA + kstep, voffA); PG8_STAGE(PG8_SB(1, 1), cB + hstepB + kstep, voffB);
        PG8_WAIT_V(6); PG8_BAR;
    }
    for (;;) {
        const bool has_next = S.next(ui + 1, nxt);
        const char* nA = has_next ? (const char*)g.A + (size_t)nxt.pm * tstep : cA; const char* nB = has_next ? (const char*)g.Bt + (size_t)nxt.pn * tstep : cB;
        for (int t = 0; t < nt; t += 2) {
            const bool last = (t == nt - 2);
            const char* a1 = cA + (size_t)(t + 1) * kstep;
            const char* a2 = last ? nA : cA + (size_t)(t + 2) * kstep; const char* b2 = last ? nB : cB + (size_t)(t + 2) * kstep;
            const char* a3 = a2 + kstep; const char* b3 = b2 + kstep;
            if (last && has_next) S.a_ready(nxt);
            if constexpr (SP2) {
            PG8_LDB(B0, 0, 0); PG8_LDB(B1, 0, 1); PG8_SCHED; PG8_LDA(At, 0, 0); PG8_STAGE(PG8_SA(1, 1), a1 + hstep, voffA);
            PG8_WAIT_V(8); PG8_WAIT_L(0); PG8_BAR; PG8_MMA(0, 0, At, B0); PG8_MMA(0, 1, At, B1); PG8_BAR; PG8_SCHED;
            PG8_LDA(At, 0, 1); PG8_STAGE(PG8_SB(0, 0), b2, voffB); PG8_STAGE(PG8_SB(0, 1), b2 + hstepB, voffB); PG8_STAGE(PG8_SA(0, 0), a2, voffA);
            PG8_WAIT_V(8); PG8_WAIT_L(0); PG8_BAR; PG8_MMA(1, 0, At, B0); PG8_MMA(1, 1, At, B1); PG8_BAR; PG8_SCHED;
            PG8_LDB(B0, 1, 0); PG8_LDB(B1, 1, 1); PG8_SCHED; PG8_LDA(At, 1, 0); PG8_STAGE(PG8_SA(0, 1), a2 + hstep, voffA);
            PG8_WAIT_V(8); PG8_WAIT_L(0); PG8_BAR; PG8_MMA(0, 0, At, B0); PG8_MMA(0, 1, At, B1); PG8_BAR; PG8_SCHED;
            PG8_LDA(At, 1, 1); PG8_STAGE(PG8_SB(1, 0), b3, voffB); PG8_STAGE(PG8_SB(1, 1), b3 + hstepB, voffB); PG8_STAGE(PG8_SA(1, 0), a3, voffA);
            PG8_WAIT_V(8); PG8_WAIT_L(0); PG8_BAR; PG8_MMA(1, 0, At, B0); PG8_MMA(1, 1, At, B1); PG8_BAR; PG8_SCHED;
            } else {
            PG8_LDB(B0, 0, 0); PG8_SCHED; PG8_LDA(At, 0, 0); PG8_STAGE(PG8_SA(1, 1), a1 + hstep, voffA);
            PG8_WAIT_L(8); PG8_BAR; PG8_WAIT_L(0); PG8_MMA(0, 0, At, B0); PG8_BAR; PG8_SCHED;
            PG8_LDB(B1, 0, 1); PG8_STAGE(PG8_SB(0, 0), b2, voffB);
            PG8_BAR; PG8_WAIT_L(0); PG8_MMA(0, 1, At, B1); PG8_BAR;
            PG8_LDA(At, 0, 1); PG8_STAGE(PG8_SA(0, 0), a2, voffA);
            PG8_BAR; PG8_WAIT_L(0); PG8_MMA(1, 0, At, B0); PG8_BAR; PG8_SCHED;
            PG8_STAGE(PG8_SB(0, 1), b2 + hstepB, voffB);
            PG8_WAIT_V(6); PG8_BAR; PG8_MMA(1, 1, At, B1); PG8_BAR;
            PG8_LDB(B0, 1, 0); PG8_SCHED; PG8_LDA(At, 1, 0); PG8_STAGE(PG8_SA(0, 1), a2 + hstep, voffA);
            PG8_WAIT_L(8); PG8_BAR; PG8_WAIT_L(0); PG8_MMA(0, 0, At, B0); PG8_BAR; PG8_SCHED;
            PG8_LDB(B1, 1, 1); PG8_STAGE(PG8_SB(1, 0), b3, voffB);
            PG8_BAR; PG8_WAIT_L(0); PG8_MMA(0, 1, At, B1); PG8_BAR;
            PG8_LDA(At, 1, 1); PG8_STAGE(PG8_SA(1, 0), a3, voffA);
            PG8_BAR; PG8_WAIT_L(0); PG8_MMA(1, 0, At, B0); PG8_BAR; PG8_SCHED;
            PG8_STAGE(PG8_SB(1, 1), b3 + hstepB, voffB);
            PG8_WAIT_V(6); PG8_BAR; PG8_MMA(1, 1, At, B1); PG8_BAR;
            }
        }
        if constexpr (ALIGN_EPI) { if (wr == 0) PG8_BAR; }
        E(acc, cur, wr, wc, fr, fq); S.done(cur);
        if (!has_next) break;
#pragma unroll
        for (int a = 0; a < 2; ++a)
#pragma unroll
            for (int b = 0; b < 2; ++b)
#pragma unroll
                for (int m = 0; m < 4; ++m)
#pragma unroll
                    for (int n = 0; n < 2; ++n) acc[a][b][m][n] = (acc_t){0, 0, 0, 0};
        cur = nxt; cA = nA; cB = nB; ++ui;
        if constexpr (ALIGN_EPI) { if (wr == 1) PG8_BAR; }
    }
    PG8_WAIT_V(0);
    if constexpr (!ALIGN_EPI) { if (wr == 0) PG8_BAR; }
    PG8_BAR;
#undef PG8_SA
#undef PG8_SB
#undef PG8_STAGE
#undef PG8_LDA
#undef PG8_LDB
#undef PG8_MMA
#undef PG8_WAIT_V
#undef PG8_WAIT_L
#undef PG8_BAR
#undef PG8_SCHED
}
}

struct Args { const float* in[21]; float* out; unsigned char* ws; int ph_lo, ph_hi, rep, pad; };
struct Frame0 { LAS unsigned char* lds; };
struct Frame {
    LAS unsigned char* lds; int tid, lane, wave, bid, nb;
    const float *x_prompt, *x_sample, *state, *cvec, *cctx, *w_in, *w_conv, *w_a, *w_gk, *b_gk, *w_gn, *w_b, *w_o, *w_ada, *b_ada, *ln_g, *ln_b, *w_pq, *pkeys, *peer_u, *peer_v;
    float* out; unsigned char* ws;
    float* MOD; bf16_t *WIN, *WA, *WB, *WO, *WPQ, *U16; unsigned char* V8; float* VS; float* XA; bf16_t *H, *Z1, *Z2, *Z3, *Z4; float* Z5;
};
typedef const __attribute__((address_space(4))) Args* KArgs;
__device__ __forceinline__ void fill_frame(Frame& F, const Frame0& F0) {
    auto kp = __builtin_amdgcn_kernarg_segment_ptr();
    asm volatile("" : "+s"(kp));
    KArgs A = (KArgs)kp;
    int t_ = threadIdx.x; asm volatile("" : "+v"(t_));
    F.lds = F0.lds; F.tid = t_; F.lane = t_ & 63; F.wave = __builtin_amdgcn_readfirstlane(t_ >> 6); F.bid = blockIdx.x; F.nb = gridDim.x;
    F.x_prompt = A->in[0]; F.x_sample = A->in[1]; F.state = A->in[2]; F.cvec = A->in[3]; F.cctx = A->in[4]; F.w_in = A->in[5]; F.w_conv = A->in[6]; F.w_a = A->in[7];
    F.w_gk = A->in[8]; F.b_gk = A->in[9]; F.w_gn = A->in[10]; F.w_b = A->in[11]; F.w_o = A->in[12]; F.w_ada = A->in[13]; F.b_ada = A->in[14]; F.ln_g = A->in[15]; F.ln_b = A->in[16];
    F.w_pq = A->in[17]; F.pkeys = A->in[18]; F.peer_u = A->in[19]; F.peer_v = A->in[20];
    F.out = A->out; unsigned char* ws = A->ws; F.ws = ws;
    F.MOD = (float*)(ws + WS_MOD); F.WIN = (bf16_t*)(ws + WS_WIN); F.WA = (bf16_t*)(ws + WS_WA); F.WB = (bf16_t*)(ws + WS_WB); F.WO = (bf16_t*)(ws + WS_WO); F.WPQ = (bf16_t*)(ws + WS_WPQ);
    F.U16 = (bf16_t*)(ws + WS_U16); F.V8 = ws + WS_V8; F.VS = (float*)(ws + WS_VS); F.XA = A->out; F.H = (bf16_t*)(ws + WS_H);
    F.Z1 = (bf16_t*)(ws + WS_Z1); F.Z2 = (bf16_t*)(ws + WS_Z2); F.Z3 = (bf16_t*)(ws + WS_Z3); F.Z4 = (bf16_t*)(ws + WS_Z4); F.Z5 = (float*)(ws + WS_Z5);
}
#define PHASE_IDS(F0_) Frame F; fill_frame(F, F0_)
__device__ __forceinline__ const float* xrow_in(const Frame& F, int l, int row) {
    if (l == 0) return row < TCTX ? F.x_prompt + (size_t)row * D : F.x_sample + (size_t)(row - TCTX) * D;
    return F.out + (size_t)row * D;
}
__device__ __forceinline__ int cond_of(int row) { return row < TCTX ? 8 : ((row - TCTX) >> 12); }

__device__ __forceinline__ void phase_mod(const Frame0& F0) {
    PHASE_IDS(F0);
    LAS float* sl = (LAS float*)F.lds;
    LAS float* red = (LAS float*)(F.lds + 73728);
    for (int i = F.tid; i < 9 * 2048; i += 512) { const int ci = i >> 11, dd = i & 2047; const float c = ci < 8 ? F.cvec[ci * 2048 + dd] : F.cctx[dd]; sl[i] = siluf_(c); }
    __syncthreads();
    const int cg = F.tid & 15, ks = F.tid >> 4;
    for (int u = F.bid; u < 2 * 192; u += F.nb) {
        const int l = u / 192, c0 = (u % 192) * 64;
        float acc[9][4];
#pragma unroll
        for (int ci = 0; ci < 9; ++ci)
#pragma unroll
            for (int j = 0; j < 4; ++j) acc[ci][j] = 0.f;
        const float* wp = F.w_ada + ((size_t)l * 2048 + ks * 64) * NADA + c0 + cg * 4;
#pragma unroll 4
        for (int r = 0; r < 64; ++r) {
            const float4 w = *(const float4*)(wp + (size_t)r * NADA);
#pragma unroll
            for (int ci = 0; ci < 9; ++ci) { const float s = sl[ci * 2048 + ks * 64 + r]; acc[ci][0] += s * w.x; acc[ci][1] += s * w.y; acc[ci][2] += s * w.z; acc[ci][3] += s * w.w; }
        }
#pragma unroll
        for (int ci = 0; ci < 9; ++ci)
#pragma unroll
            for (int j = 0; j < 4; ++j) { float v = acc[ci][j]; v += __shfl_xor(v, 16); v += __shfl_xor(v, 32); acc[ci][j] = v; }
        if (F.lane < 16) {
#pragma unroll
            for (int ci = 0; ci < 9; ++ci)
#pragma unroll
                for (int j = 0; j < 4; ++j) red[(F.wave * 9 + ci) * 64 + cg * 4 + j] = acc[ci][j];
        }
        __syncthreads();
        for (int i = F.tid; i < 576; i += 512) { const int ci = i >> 6, c = i & 63; float s = 0.f;
#pragma unroll
            for (int w = 0; w < 8; ++w) s += red[(w * 9 + ci) * 64 + c];
            F.MOD[(size_t)(l * 9 + ci) * NADA + c0 + c] = s + F.b_ada[l * NADA + c0 + c]; }
        __syncthreads();
    }
}
template <class Map>
__device__ __forceinline__ void tr_convert(const Frame0& F0, const float* src, int ldsrc, bf16_t* dst, int K, int N, Map map) {
    PHASE_IDS(F0);
    LAS bf16_t* tile = (LAS bf16_t*)F.lds;
    const int ntn = N / 64, ntk = K / 256;
    for (int u = F.bid; u < ntn * ntk; u += F.nb) {
        const int n0 = (u / ntk) * 64, k0 = (u % ntk) * 256;
        const int nn = F.tid & 63, kq = F.tid >> 6;
        const int sc = map(n0 + nn);
        float vals[32];
#pragma unroll
        for (int i = 0; i < 32; ++i) { const int kk = i * 8 + kq; vals[i] = sc >= 0 ? src[(size_t)(k0 + kk) * ldsrc + sc] : 0.f; }
#pragma unroll
        for (int i = 0; i < 32; ++i) tile[nn * 258 + i * 8 + kq] = f2bf(vals[i]);
        __syncthreads();
#pragma unroll
        for (int i = 0; i < 4; ++i) { const int id = F.tid + 512 * i, r = id >> 5, kc = id & 31; const LAS unsigned* p = (const LAS unsigned*)(tile + r * 258 + kc * 8);
            uint4 o; o.x = p[0]; o.y = p[1]; o.z = p[2]; o.w = p[3];
            *(uint4*)(dst + (size_t)(n0 + r) * K + k0 + kc * 8) = o; }
        __syncthreads();
    }
}
template <class Map>
__device__ __forceinline__ void tr_strip8(const Frame& F, const float* src, int ldsrc, unsigned char* dst, float* scales, int K, int n0, Map map) {
    LAS unsigned char* tile = (LAS unsigned char*)F.lds;
    LAS float* red = (LAS float*)(F.lds + 64 * 272);
    const int nn = F.tid & 63, kq = F.tid >> 6;
    const int sc = map(n0 + nn);
    float m = 0.f;
    for (int i0 = 0; i0 < K / 8; i0 += 64) {
        float vals[64];
#pragma unroll
        for (int i = 0; i < 64; ++i) vals[i] = sc >= 0 ? src[(size_t)((i0 + i) * 8 + kq) * ldsrc + sc] : 0.f;
#pragma unroll
        for (int i = 0; i < 64; ++i) m = fmaxf(m, fabsf(vals[i]));
    }
    __syncthreads();
    red[kq * 64 + nn] = m;
    __syncthreads();
    if (F.tid < 64) { float mm = 0.f;
#pragma unroll
        for (int q = 0; q < 8; ++q) mm = fmaxf(mm, red[q * 64 + F.tid]);
        const float scl = mm > 0.f ? mm * (1.f / 127.f) : 1.f; scales[n0 + F.tid] = scl; red[512 + F.tid] = 1.f / scl; }
    __syncthreads();
    const float inv = red[512 + nn];
    for (int k0 = 0; k0 < K; k0 += 256) {
        float vals[32];
#pragma unroll
        for (int i = 0; i < 32; ++i) vals[i] = sc >= 0 ? src[(size_t)(k0 + i * 8 + kq) * ldsrc + sc] : 0.f;
#pragma unroll
        for (int i = 0; i < 32; ++i) tile[nn * 272 + i * 8 + kq] = (unsigned char)(__float2int_rn(vals[i] * inv) & 255);
        __syncthreads();
#pragma unroll
        for (int i = 0; i < 2; ++i) { const int id = F.tid + 512 * i, r = id >> 4, kc = id & 15; const u32x4 o = *(const LAS u32x4*)(tile + r * 272 + kc * 16);
            *(u32x4*)(dst + (size_t)(n0 + r) * K + k0 + kc * 16) = o; }
        __syncthreads();
    }
}
struct MapId { __device__ __forceinline__ int operator()(int n) const { return n; } };
struct MapInOff { int off; __device__ __forceinline__ int operator()(int n) const { n += off; return n < 9216 ? n : (n < 13312 ? n + 32 : (n < 13344 ? n - 13312 + 9216 : -1)); } };
struct MapIn { __device__ __forceinline__ int operator()(int n) const { return n < 9216 ? n : (n < 13312 ? n + 32 : (n < 13344 ? n - 13312 + 9216 : -1)); } };
__device__ __forceinline__ void conv_tables(const Frame0& F0, int l) {
    PHASE_IDS(F0);
    for (int e = F.bid * 8 + F.wave; e < 16384; e += F.nb * 8) {
        const float* s = F.peer_v + ((size_t)l * 16384 + e) * 2048;
        float4 v[8]; float m = 0.f;
#pragma unroll
        for (int i = 0; i < 8; ++i) { v[i] = *(const float4*)(s + i * 256 + F.lane * 4); m = fmaxf(m, fmaxf(fmaxf(fabsf(v[i].x), fabsf(v[i].y)), fmaxf(fabsf(v[i].z), fabsf(v[i].w)))); }
#pragma unroll
        for (int sh = 32; sh >= 1; sh >>= 1) m = fmaxf(m, __shfl_xor(m, sh));
        const float sc = m > 0.f ? m * (1.f / 127.f) : 1.f, inv = 1.f / sc;
#pragma unroll
        for (int i = 0; i < 8; ++i) *(unsigned*)(F.V8 + (size_t)e * 2048 + i * 256 + F.lane * 4) = pack_i8(v[i].x * inv, v[i].y * inv, v[i].z * inv, v[i].w * inv);
        if (F.lane == 0) F.VS[e] = sc;
    }
    for (int e = F.bid * 8 + F.wave; e < 16384; e += F.nb * 8) {
        const float* s = F.peer_u + ((size_t)l * 16384 + e) * 2048;
        float m = 0.f;
#pragma unroll
        for (int i = 0; i < 8; ++i) { const float4 v = *(const float4*)(s + i * 256 + F.lane * 4); m = fmaxf(m, fmaxf(fmaxf(fabsf(v.x), fabsf(v.y)), fmaxf(fabsf(v.z), fabsf(v.w)))); }
        m = wmax(m);
        if (F.lane == 0) F.VS[16384 + e] = m > 0.f ? m * (1.f / 127.f) : 1.f;
    }
}
__device__ __forceinline__ void phase_prologue(const Frame0& F0) {
    phase_mod(F0);
    {
        PHASE_IDS(F0);
        for (int sidx = F.bid; sidx < 2 * 340; sidx += F.nb) {
            const int l = sidx / 340, r = sidx % 340;
            if (r < 212) tr_strip8(F, F.w_in + (size_t)l * 2048 * 13344, 13344, F.ws + WS_W8IN + (size_t)l * NINP * 2048, (float*)(F.ws + WS_CSIN) + (size_t)l * NINP, 2048, r * 64, MapIn());
            else if (r < 244) tr_strip8(F, F.w_b + (size_t)l * 2048 * 2048, 2048, (unsigned char*)F.WB + (size_t)l * 2048 * 2048, (float*)((unsigned char*)F.WB + (size_t)2 * 2048 * 2048) + l * 2048, 2048, (r - 212) * 64, MapId());
            else if (r < 276) tr_strip8(F, F.w_pq + (size_t)l * 2048 * 2048, 2048, (unsigned char*)F.WPQ + (size_t)l * 2048 * 2048, (float*)((unsigned char*)F.WPQ + (size_t)2 * 2048 * 2048) + l * 2048, 2048, (r - 244) * 64, MapId());
            else if (r >= 308) tr_strip8(F, F.w_o + (size_t)l * 2048 * 2048, 2048, (unsigned char*)F.WO + (size_t)l * 2048 * 2048, (float*)((unsigned char*)F.WO + (size_t)2 * 2048 * 2048) + l * 2048, 2048, (r - 308) * 64, MapId());
            else tr_strip8(F, F.w_a + (size_t)l * 1024 * 2048, 2048, (unsigned char*)F.WA + (size_t)l * 2048 * 1024, (float*)((unsigned char*)F.WA + (size_t)2 * 2048 * 1024) + l * 2048, 1024, (r - 276) * 64, MapId());
        }
    }
    for (int l = 0; l < 2; ++l) {
        Frame P; fill_frame(P, F0);
        tr_convert(F0, P.w_in + (size_t)l * 2048 * 13344, 13344, P.WIN + ((size_t)l * NINP + 4096) * 2048, 2048, 3072, MapInOff{4096});
        tr_convert(F0, P.w_in + (size_t)l * 2048 * 13344, 13344, P.WIN + ((size_t)l * NINP + 13312) * 2048, 2048, 256, MapInOff{13312});
    }
}

__device__ __forceinline__ void phase_lnmod(const Frame0& F0, int l) {
    PHASE_IDS(F0);
    const int stride = F.nb * 8;
    int row = F.bid * 8 + F.wave;
    float4 v[8], shv[8], scv[8]; int cci = -1;
    if (row < T) { const float* xr = xrow_in(F, l, row);
#pragma unroll
        for (int i = 0; i < 8; ++i) v[i] = *(const float4*)(xr + i * 256 + F.lane * 4); }
    for (; row < T; row += stride) {
        float4 vn[8];
        const int nrow = row + stride;
        if (nrow < T) { const float* xn = xrow_in(F, l, nrow);
#pragma unroll
            for (int i = 0; i < 8; ++i) vn[i] = *(const float4*)(xn + i * 256 + F.lane * 4); }
        else {
#pragma unroll
            for (int i = 0; i < 8; ++i) vn[i] = v[i]; }
        const int ci = cond_of(row);
        if (ci != cci) { const float* md = F.MOD + (size_t)(l * 9 + ci) * NADA; cci = ci;
#pragma unroll
            for (int i = 0; i < 8; ++i) { shv[i] = *(const float4*)(md + i * 256 + F.lane * 4); scv[i] = *(const float4*)(md + 2048 + i * 256 + F.lane * 4); } }
        float s = 0.f;
#pragma unroll
        for (int i = 0; i < 8; ++i) s += (v[i].x + v[i].y) + (v[i].z + v[i].w);
        const float mean = wsum(s) * (1.f / 2048.f);
        float q = 0.f;
#pragma unroll
        for (int i = 0; i < 8; ++i) { const float a = v[i].x - mean, b = v[i].y - mean, c = v[i].z - mean, d = v[i].w - mean; q += (a * a + b * b) + (c * c + d * d); }
        const float rstd = rsqrtf(wsum(q) * (1.f / 2048.f) + LN_EPS);
        float am = 0.f;
#pragma unroll
        for (int i = 0; i < 8; ++i) { const int col = i * 256 + F.lane * 4;
            const float4 sh = shv[i], sc = scv[i];
            const float y0 = (v[i].x - mean) * rstd * (1.f + sc.x) + sh.x, y1 = (v[i].y - mean) * rstd * (1.f + sc.y) + sh.y;
            const float y2 = (v[i].z - mean) * rstd * (1.f + sc.z) + sh.z, y3 = (v[i].w - mean) * rstd * (1.f + sc.w) + sh.w;
            if (row < TCTX) { u32x2 o; o.x = cvt_pk_bf16(y0, y1); o.y = cvt_pk_bf16(y2, y3); *(u32x2*)(F.H + (size_t)row * D + col) = o; }
            v[i].x = y0; v[i].y = y1; v[i].z = y2; v[i].w = y3; am = fmaxf(am, fmaxf(fmaxf(fabsf(y0), fabsf(y1)), fmaxf(fabsf(y2), fabsf(y3)))); }
        am = wmax(am);
        const float hs = am > 0.f ? am * (1.f / 127.f) : 1.f, hinv = 1.f / hs;
#pragma unroll
        for (int i = 0; i < 8; ++i) *(unsigned*)(F.ws + WS_H8IN + (size_t)row * D + i * 256 + F.lane * 4) = pack_i8(v[i].x * hinv, v[i].y * hinv, v[i].z * hinv, v[i].w * hinv);
        if (F.lane == 0) ((float*)(F.ws + WS_HSIN))[row] = hs;
#pragma unroll
        for (int i = 0; i < 8; ++i) v[i] = vn[i];
    }
}

__device__ __forceinline__ unsigned dpp_ror8(unsigned x) { return (unsigned)__builtin_amdgcn_update_dpp(0, (int)x, 0x128, 0xf, 0xf, true); }
__device__ __forceinline__ void store_rows128(bf16_t* base, size_t ld, int fr, int fq, const u32x4 w0, const u32x4 w1) {
    const bool lo = fr < 8;
    u32x4 a, b;
#pragma unroll
    for (int j = 0; j < 4; ++j) { const unsigned t0 = dpp_ror8(w0[j]), t1 = dpp_ror8(w1[j]); a[j] = lo ? w0[j] : t1; b[j] = lo ? t0 : w1[j]; }
    bf16_t* p = base + (size_t)(fr & 7) * ld + (lo ? 0 : 32) + 8 * fq;
#if STORE_POLICY == 1
    __builtin_nontemporal_store(a, (u32x4*)p); __builtin_nontemporal_store(b, (u32x4*)(p + 8 * ld));
#elif STORE_POLICY == 2
    asm volatile("global_store_dwordx4 %0, %1, off sc1" :: "v"(p), "v"(a) : "memory"); asm volatile("global_store_dwordx4 %0, %1, off sc1" :: "v"(p + 8 * ld), "v"(b) : "memory");
#elif STORE_POLICY == 3
    asm volatile("global_store_dwordx4 %0, %1, off sc0 sc1" :: "v"(p), "v"(a) : "memory"); asm volatile("global_store_dwordx4 %0, %1, off sc0 sc1" :: "v"(p + 8 * ld), "v"(b) : "memory");
#else
    *(u32x4*)p = a; *(u32x4*)(p + 8 * ld) = b;
#endif
}
__device__ __forceinline__ void store_rows128_f32(float* base, size_t ld, int fr, int fq, const f32x4 v0, const f32x4 v1) {
    const bool lo = fr < 8;
    f32x4 a, b;
#pragma unroll
    for (int j = 0; j < 4; ++j) { const float t0 = __uint_as_float(dpp_ror8(__float_as_uint(v0[j]))), t1 = __uint_as_float(dpp_ror8(__float_as_uint(v1[j]))); a[j] = lo ? v0[j] : t1; b[j] = lo ? t0 : v1[j]; }
    float* p = base + (size_t)(fr & 7) * ld + (lo ? 0 : 16) + 4 * fq;
    *(f32x4*)p = a; *(f32x4*)(p + 8 * ld) = b;
}
__device__ __forceinline__ float4 ld_bf4(const bf16_t* p) { const u32x2 w = *(const u32x2*)p; float4 r; r.x = __uint_as_float(w.x << 16); r.y = __uint_as_float(w.x & 0xffff0000u); r.z = __uint_as_float(w.y << 16); r.w = __uint_as_float(w.y & 0xffff0000u); return r; }
__device__ __forceinline__ u32x4 pack8(const f32x4 v0, const f32x4 v1) { u32x4 w; w.x = cvt_pk_bf16(v0[0], v0[1]); w.y = cvt_pk_bf16(v0[2], v0[3]); w.z = cvt_pk_bf16(v1[0], v1[1]); w.w = cvt_pk_bf16(v1[2], v1[3]); return w; }
struct EpiIn {
    static constexpr bool PERM = true;
    bf16_t *Z1, *ZQ, *ZK, *ZV, *Z3, *GA, *GB; float* Z5;
    __device__ __forceinline__ void operator()(const f32x4 (&acc)[2][2][4][2], const pg8::Unit& u, int wr, int wc, int fr0, int fq0) const {
        int fr = fr0, fq = fq0; asm volatile("" : "+v"(fr), "+v"(fq));
        const int rw = u.pm * 256 + wr * 64;
        if (u.pn < 52) {
            bf16_t* base; int ld, c;
            const int colt = u.pn * 256;
            if (u.pn < 12) { base = Z1; ld = 3072; c = colt; }
            else if (u.pn < 16) { base = ZQ; ld = 1024; c = colt - 3072; }
            else if (u.pn < 20) { base = ZK; ld = 1024; c = colt - 4096; }
            else if (u.pn < 28) { base = ZV; ld = 2048; c = colt - 5120; }
            else if (u.pn < 36) { base = Z3; ld = 2048; c = colt - 7168; }
            else if (u.pn < 44) { base = GA; ld = 2048; c = colt - 9216; }
            else { base = GB; ld = 2048; c = colt - 11264; }
#pragma unroll
            for (int ai = 0; ai < 2; ++ai)
#pragma unroll
                for (int m = 0; m < 4; ++m)
                    store_rows128(base + (size_t)(rw + ai * 128 + m * 16) * ld + c + wc * 64, (size_t)ld, fr, fq, pack8(acc[ai][0][m][0], acc[ai][0][m][1]), pack8(acc[ai][1][m][0], acc[ai][1][m][1]));
        } else if (wc == 0) {
#pragma unroll
            for (int ai = 0; ai < 2; ++ai)
#pragma unroll
                for (int m = 0; m < 4; ++m) { float* rowp = Z5 + (size_t)(rw + fr + ai * 128 + m * 16) * 32 + 8 * fq;
                    *(f32x4*)(rowp) = acc[ai][0][m][0]; *(f32x4*)(rowp + 4) = acc[ai][0][m][1]; }
        }
    }
};
struct SubsetOrder {
    int mode, G, c;
    __device__ __forceinline__ bool next(int i, pg8::Unit& u) const {
        const long L = (long)i * G + c;
        if (mode == 0) { if (L >= 208) return false; const int k = (int)L >> 4; u.pm = (int)L & 15; u.pn = k < 12 ? 16 + k : 52; return true; }
        if (L >= 7424) return false;
        const int w = ((int)L & 7) * 928 + ((int)L >> 3);
        if (w < 6784) { const int r = w % 424; u.pm = 16 + (w / 424) * 8 + (r & 7); u.pn = r >> 3; }
        else { const int v = w - 6784, q = v >> 4; u.pm = v & 15; u.pn = q < 16 ? q : q + 12; }
        return true;
    }
    __device__ __forceinline__ void a_ready(const pg8::Unit&) const {}
    __device__ __forceinline__ void done(const pg8::Unit&) const {}
};
struct EpiInS {
    static constexpr bool PERM = true;
    bf16_t *Z1, *ZQ, *ZK, *ZV, *Z3, *GA, *GB; float* Z5; const float* RS; const float* CS;
    __device__ __forceinline__ void operator()(const i32x4 (&acc)[2][2][4][2], const pg8::Unit& u, int wr, int wc, int fr0, int fq0) const {
        int fr = fr0, fq = fq0; asm volatile("" : "+v"(fr), "+v"(fq));
        const int rw = u.pm * 256 + wr * 64;
        const int colt = u.pn * 256;
        f32x4 cs[2][2];
#pragma unroll
        for (int bj = 0; bj < 2; ++bj)
#pragma unroll
            for (int n = 0; n < 2; ++n) cs[bj][n] = *(const f32x4*)(CS + colt + wc * 64 + bj * 32 + 8 * fq + 4 * n);
        if (u.pn < 52) {
            bf16_t* base; int ld, c;
            if (u.pn < 12) { base = Z1; ld = 3072; c = colt; }
            else if (u.pn < 16) { base = ZQ; ld = 1024; c = colt - 3072; }
            else if (u.pn < 20) { base = ZK; ld = 1024; c = colt - 4096; }
            else if (u.pn < 28) { base = ZV; ld = 2048; c = colt - 5120; }
            else if (u.pn < 36) { base = Z3; ld = 2048; c = colt - 7168; }
            else if (u.pn < 44) { base = GA; ld = 2048; c = colt - 9216; }
            else { base = GB; ld = 2048; c = colt - 11264; }
#pragma unroll
            for (int ai = 0; ai < 2; ++ai)
#pragma unroll
                for (int m = 0; m < 4; ++m) { const float rs = RS[rw + ai * 128 + m * 16 + fr]; f32x4 v[2][2];
#pragma unroll
                    for (int bj = 0; bj < 2; ++bj)
#pragma unroll
                        for (int n = 0; n < 2; ++n)
#pragma unroll
                            for (int j = 0; j < 4; ++j) v[bj][n][j] = (float)acc[ai][bj][m][n][j] * rs * cs[bj][n][j];
                    store_rows128(base + (size_t)(rw + ai * 128 + m * 16) * ld + c + wc * 64, (size_t)ld, fr, fq, pack8(v[0][0], v[0][1]), pack8(v[1][0], v[1][1])); }
        } else if (wc == 0) {
#pragma unroll
            for (int ai = 0; ai < 2; ++ai)
#pragma unroll
                for (int m = 0; m < 4; ++m) { const float rs = RS[rw + ai * 128 + m * 16 + fr]; float* rowp = Z5 + (size_t)(rw + fr + ai * 128 + m * 16) * 32 + 8 * fq; f32x4 v0, v1;
#pragma unroll
                    for (int j = 0; j < 4; ++j) { v0[j] = (float)acc[ai][0][m][0][j] * rs * cs[0][0][j]; v1[j] = (float)acc[ai][0][m][1][j] * rs * cs[0][1][j]; }
                    *(f32x4*)(rowp) = v0; *(f32x4*)(rowp + 4) = v1; }
        }
    }
};
struct EpiA {
    static constexpr bool PERM = true;
    const bf16_t* Z4; bf16_t* Y;
    __device__ __forceinline__ void operator()(const f32x4 (&acc)[2][2][4][2], const pg8::Unit& u, int wr, int wc, int fr0, int fq0) const {
        int fr = fr0, fq = fq0; asm volatile("" : "+v"(fr), "+v"(fq));
        const int rw = u.pm * 256 + wr * 64, cw = u.pn * 256 + wc * 64;
#pragma unroll
        for (int ai = 0; ai < 2; ++ai)
#pragma unroll
            for (int m = 0; m < 4; ++m) { const size_t row = (size_t)(rw + fr + ai * 128 + m * 16);
                u32x4 w[2];
#pragma unroll
                for (int bj = 0; bj < 2; ++bj) { const int col = cw + bj * 32 + 8 * fq;
                    const u32x4 g = *(const u32x4*)(Z4 + row * 2048 + col);
                    const f32x4 v0 = acc[ai][bj][m][0], v1 = acc[ai][bj][m][1];
                    w[bj].x = cvt_pk_bf16(sigmoidf_(bf_lo(g.x)) * v0[0], sigmoidf_(bf_hi(g.x)) * v0[1]);
                    w[bj].y = cvt_pk_bf16(sigmoidf_(bf_lo(g.y)) * v0[2], sigmoidf_(bf_hi(g.y)) * v0[3]);
                    w[bj].z = cvt_pk_bf16(sigmoidf_(bf_lo(g.z)) * v1[0], sigmoidf_(bf_hi(g.z)) * v1[1]);
                    w[bj].w = cvt_pk_bf16(sigmoidf_(bf_lo(g.w)) * v1[2], sigmoidf_(bf_hi(g.w)) * v1[3]); }
                store_rows128(Y + (size_t)(rw + ai * 128 + m * 16) * 2048 + cw, 2048, fr, fq, w[0], w[1]); }
    }
};
struct EpiAS {
    static constexpr bool PERM = true;
    const bf16_t* Z4; bf16_t* Y; const float* RS; const float* CS;
    __device__ __forceinline__ void operator()(const i32x4 (&acc)[2][2][4][2], const pg8::Unit& u, int wr, int wc, int fr0, int fq0) const {
        int fr = fr0, fq = fq0; asm volatile("" : "+v"(fr), "+v"(fq));
        const int rw = u.pm * 256 + wr * 64, cw = u.pn * 256 + wc * 64;
#pragma unroll
        for (int ai = 0; ai < 2; ++ai)
#pragma unroll
            for (int m = 0; m < 4; ++m) { const size_t row = (size_t)(rw + fr + ai * 128 + m * 16); const float rs = RS[row];
                u32x4 w[2];
#pragma unroll
                for (int bj = 0; bj < 2; ++bj) { const int col = cw + bj * 32 + 8 * fq;
                    const u32x4 g = *(const u32x4*)(Z4 + row * 2048 + col);
                    const f32x4 c0 = *(const f32x4*)(CS + col), c1 = *(const f32x4*)(CS + col + 4); f32x4 v0, v1;
#pragma unroll
                    for (int jj = 0; jj < 4; ++jj) { v0[jj] = (float)acc[ai][bj][m][0][jj] * rs * c0[jj]; v1[jj] = (float)acc[ai][bj][m][1][jj] * rs * c1[jj]; }
                    w[bj].x = cvt_pk_bf16(sigmoidf_(bf_lo(g.x)) * v0[0], sigmoidf_(bf_hi(g.x)) * v0[1]);
                    w[bj].y = cvt_pk_bf16(sigmoidf_(bf_lo(g.y)) * v0[2], sigmoidf_(bf_hi(g.y)) * v0[3]);
                    w[bj].z = cvt_pk_bf16(sigmoidf_(bf_lo(g.z)) * v1[0], sigmoidf_(bf_hi(g.z)) * v1[1]);
                    w[bj].w = cvt_pk_bf16(sigmoidf_(bf_lo(g.w)) * v1[2], sigmoidf_(bf_hi(g.w)) * v1[3]); }
                store_rows128(Y + (size_t)(rw + ai * 128 + m * 16) * 2048 + cw, 2048, fr, fq, w[0], w[1]); }
    }
};
struct EpiB {
    static constexpr bool PERM = true;
    const bf16_t* Z4; bf16_t* Y;
    __device__ __forceinline__ void operator()(const f32x4 (&acc)[2][2][4][2], const pg8::Unit& u, int wr, int wc, int fr0, int fq0) const {
        int fr = fr0, fq = fq0; asm volatile("" : "+v"(fr), "+v"(fq));
        const int rw = u.pm * 256 + wr * 64, cw = u.pn * 256 + wc * 64;
#pragma unroll
        for (int ai = 0; ai < 2; ++ai)
#pragma unroll
            for (int m = 0; m < 4; ++m) { const size_t row = (size_t)(rw + fr + ai * 128 + m * 16);
                u32x4 w[2];
#pragma unroll
                for (int bj = 0; bj < 2; ++bj) { const int col = cw + bj * 32 + 8 * fq;
                    const u32x4 g = *(const u32x4*)(Z4 + row * 2048 + col);
                    const u32x4 y = *(const u32x4*)(Y + row * 2048 + col);
                    const f32x4 v0 = acc[ai][bj][m][0], v1 = acc[ai][bj][m][1];
                    w[bj].x = cvt_pk_bf16(bf_lo(y.x) + sigmoidf_(bf_lo(g.x)) * v0[0], bf_hi(y.x) + sigmoidf_(bf_hi(g.x)) * v0[1]);
                    w[bj].y = cvt_pk_bf16(bf_lo(y.y) + sigmoidf_(bf_lo(g.y)) * v0[2], bf_hi(y.y) + sigmoidf_(bf_hi(g.y)) * v0[3]);
                    w[bj].z = cvt_pk_bf16(bf_lo(y.z) + sigmoidf_(bf_lo(g.z)) * v1[0], bf_hi(y.z) + sigmoidf_(bf_hi(g.z)) * v1[1]);
                    w[bj].w = cvt_pk_bf16(bf_lo(y.w) + sigmoidf_(bf_lo(g.w)) * v1[2], bf_hi(y.w) + sigmoidf_(bf_hi(g.w)) * v1[3]); }
                store_rows128(Y + (size_t)(rw + ai * 128 + m * 16) * 2048 + cw, 2048, fr, fq, w[0], w[1]); }
    }
};
struct EpiO {
    static constexpr bool PERM = true;
    const float *xp, *xs, *xo; const float* MODl; bf16_t* T1; int l;
    __device__ __forceinline__ void operator()(const f32x4 (&acc)[2][2][4][2], const pg8::Unit& u, int wr, int wc, int fr0, int fq0) const {
        int fr = fr0, fq = fq0; asm volatile("" : "+v"(fr), "+v"(fq));
        const int cw = u.pn * 256 + wc * 64;
        const int rbase = u.pm * 256;
        const float* g1 = MODl + (size_t)cond_of(rbase) * NADA + 2 * 2048;
        const float* xb = (l == 0) ? (rbase < TCTX ? xp + (size_t)rbase * D : xs + (size_t)(rbase - TCTX) * D) : xo + (size_t)rbase * D;
#pragma unroll
        for (int ai = 0; ai < 2; ++ai)
#pragma unroll
            for (int m = 0; m < 4; ++m) { const int rl0 = wr * 64 + ai * 128 + m * 16, rl = rl0 + fr; u32x4 w[2];
#pragma unroll
                for (int bj = 0; bj < 2; ++bj) { f32x4 r[2]; const int col = cw + bj * 32 + 8 * fq;
#pragma unroll
                    for (int n = 0; n < 2; ++n) {
                        const f32x4 xv = *(const f32x4*)(xb + (size_t)rl * D + col + 4 * n);
                        const f32x4 gvv = *(const f32x4*)(g1 + col + 4 * n);
                        r[n] = xv * ALPHA + gvv * acc[ai][bj][m][n]; }
                    w[bj] = pack8(r[0], r[1]); }
                store_rows128(T1 + (size_t)(rbase + rl0) * D + cw, (size_t)D, fr, fq, w[0], w[1]);
                __builtin_amdgcn_sched_barrier(0); }
    }
};
struct EpiOS {
    static constexpr bool PERM = true;
    const float *xp, *xs, *xo; const float* MODl; bf16_t* T1; int l; const float* RS; const float* CS;
    __device__ __forceinline__ void operator()(const i32x4 (&acc)[2][2][4][2], const pg8::Unit& u, int wr, int wc, int fr0, int fq0) const {
        int fr = fr0, fq = fq0; asm volatile("" : "+v"(fr), "+v"(fq));
        const int cw = u.pn * 256 + wc * 64;
        const int rbase = u.pm * 256;
        const float* g1 = MODl + (size_t)cond_of(rbase) * NADA + 2 * 2048;
        const float* xb = (l == 0) ? (rbase < TCTX ? xp + (size_t)rbase * D : xs + (size_t)(rbase - TCTX) * D) : xo + (size_t)rbase * D;
#pragma unroll
        for (int ai = 0; ai < 2; ++ai)
#pragma unroll
            for (int m = 0; m < 4; ++m) { const int rl0 = wr * 64 + ai * 128 + m * 16, rl = rl0 + fr; u32x4 w[2]; const float rs = RS[rbase + rl];
#pragma unroll
                for (int bj = 0; bj < 2; ++bj) { f32x4 r[2]; const int col = cw + bj * 32 + 8 * fq;
#pragma unroll
                    for (int n = 0; n < 2; ++n) {
                        const f32x4 xv = *(const f32x4*)(xb + (size_t)rl * D + col + 4 * n);
                        const f32x4 gvv = *(const f32x4*)(g1 + col + 4 * n);
                        const f32x4 cs = *(const f32x4*)(CS + col + 4 * n); f32x4 af;
#pragma unroll
                        for (int jj = 0; jj < 4; ++jj) af[jj] = (float)acc[ai][bj][m][n][jj] * rs * cs[jj];
                        r[n] = xv * ALPHA + gvv * af; }
                    w[bj] = pack8(r[0], r[1]); }
                store_rows128(T1 + (size_t)(rbase + rl0) * D + cw, (size_t)D, fr, fq, w[0], w[1]);
                __builtin_amdgcn_sched_barrier(0); }
    }
};
struct EpiPlain {
    static constexpr bool PERM = true;
    bf16_t* O; int ld;
    __device__ __forceinline__ void operator()(const f32x4 (&acc)[2][2][4][2], const pg8::Unit& u, int wr, int wc, int fr0, int fq0) const {
        int fr = fr0, fq = fq0; asm volatile("" : "+v"(fr), "+v"(fq));
        const int rw = u.pm * 256 + wr * 64, cw = u.pn * 256 + wc * 64;
#pragma unroll
        for (int ai = 0; ai < 2; ++ai)
#pragma unroll
            for (int m = 0; m < 4; ++m)
                store_rows128(O + (size_t)(rw + ai * 128 + m * 16) * ld + cw, (size_t)ld, fr, fq, pack8(acc[ai][0][m][0], acc[ai][0][m][1]), pack8(acc[ai][1][m][0], acc[ai][1][m][1]));
    }
};
struct EpiPlainS {
    static constexpr bool PERM = true;
    bf16_t* O; int ld; const float* RS; const float* CS;
    __device__ __forceinline__ void operator()(const i32x4 (&acc)[2][2][4][2], const pg8::Unit& u, int wr, int wc, int fr0, int fq0) const {
        int fr = fr0, fq = fq0; asm volatile("" : "+v"(fr), "+v"(fq));
        const int rw = u.pm * 256 + wr * 64, cw = u.pn * 256 + wc * 64;
        f32x4 cs[2][2];
#pragma unroll
        for (int bj = 0; bj < 2; ++bj)
#pragma unroll
            for (int n = 0; n < 2; ++n) cs[bj][n] = *(const f32x4*)(CS + cw + bj * 32 + 8 * fq + 4 * n);
#pragma unroll
        for (int ai = 0; ai < 2; ++ai)
#pragma unroll
            for (int m = 0; m < 4; ++m) { const float rs = RS[rw + ai * 128 + m * 16 + fr]; f32x4 v[2][2];
#pragma unroll
                for (int bj = 0; bj < 2; ++bj)
#pragma unroll
                    for (int n = 0; n < 2; ++n)
#pragma unroll
                        for (int j = 0; j < 4; ++j) v[bj][n][j] = (float)acc[ai][bj][m][n][j] * rs * cs[bj][n][j];
                store_rows128(O + (size_t)(rw + ai * 128 + m * 16) * ld + cw, (size_t)ld, fr, fq, pack8(v[0][0], v[0][1]), pack8(v[1][0], v[1][1])); }
    }
};
struct EpiBS {
    static constexpr bool PERM = true;
    const bf16_t* Z4; bf16_t* Y; const float* RS; const float* CS;
    __device__ __forceinline__ void operator()(const i32x4 (&acc)[2][2][4][2], const pg8::Unit& u, int wr, int wc, int fr0, int fq0) const {
        int fr = fr0, fq = fq0; asm volatile("" : "+v"(fr), "+v"(fq));
        const int rw = u.pm * 256 + wr * 64, cw = u.pn * 256 + wc * 64;
        f32x4 cs[2][2];
#pragma unroll
        for (int bj = 0; bj < 2; ++bj)
#pragma unroll
            for (int n = 0; n < 2; ++n) cs[bj][n] = *(const f32x4*)(CS + cw + bj * 32 + 8 * fq + 4 * n);
#pragma unroll
        for (int ai = 0; ai < 2; ++ai)
#pragma unroll
            for (int m = 0; m < 4; ++m) { const size_t row = (size_t)(rw + fr + ai * 128 + m * 16); const float rs = RS[row];
                u32x4 w[2];
#pragma unroll
                for (int bj = 0; bj < 2; ++bj) { const int col = cw + bj * 32 + 8 * fq;
                    const u32x4 g = *(const u32x4*)(Z4 + row * 2048 + col);
                    const u32x4 y = *(const u32x4*)(Y + row * 2048 + col);
                    f32x4 v0, v1;
#pragma unroll
                    for (int j = 0; j < 4; ++j) { v0[j] = (float)acc[ai][bj][m][0][j] * rs * cs[bj][0][j]; v1[j] = (float)acc[ai][bj][m][1][j] * rs * cs[bj][1][j]; }
                    w[bj].x = cvt_pk_bf16(bf_lo(y.x) + sigmoidf_(bf_lo(g.x)) * v0[0], bf_hi(y.x) + sigmoidf_(bf_hi(g.x)) * v0[1]);
                    w[bj].y = cvt_pk_bf16(bf_lo(y.y) + sigmoidf_(bf_lo(g.y)) * v0[2], bf_hi(y.y) + sigmoidf_(bf_hi(g.y)) * v0[3]);
                    w[bj].z = cvt_pk_bf16(bf_lo(y.z) + sigmoidf_(bf_lo(g.z)) * v1[0], bf_hi(y.z) + sigmoidf_(bf_hi(g.z)) * v1[1]);
                    w[bj].w = cvt_pk_bf16(bf_lo(y.w) + sigmoidf_(bf_lo(g.w)) * v1[2], bf_hi(y.w) + sigmoidf_(bf_hi(g.w)) * v1[3]); }
                store_rows128(Y + (size_t)(rw + ai * 128 + m * 16) * 2048 + cw, 2048, fr, fq, w[0], w[1]); }
    }
};
template <class Epi, bool I8 = false>
__device__ __forceinline__ void run_gemm(const Frame& F, const bf16_t* A, const bf16_t* Bt, int N, int K, const Epi& E) {
    pg8::Gemm g{A, Bt, T, N, K}; pg8::StaticOrder S; S.init(T, N, F.nb, F.bid);
    pg8::gemm_phase<Epi, pg8::StaticOrder, true, true, I8>(F.lds, g, S, E);
}
#define B_ZQ(F) ((F).Z2)
#define B_ZK(F) ((F).Z2 + (size_t)T * 1024)
#define B_ZV(F) ((F).Z2 + (size_t)T * 2048)
#define B_GA(F) ((F).Z4)
#define B_GB(F) ((F).Z4 + (size_t)T * 2048)
#define B_Y(F)  ((F).Z1 + (size_t)T * 1024)
#define B_QDF(F) ((F).H)
#define B_KDF(F) ((F).H + (size_t)T * 1024)
#define B_QDB(F) ((F).H + (size_t)T * 2048)
#define B_KDB(F) ((F).Z4)
#define B_DEC(F) ((float*)((F).Z4 + (size_t)T * 1024))
#define B_OF(F) ((F).Z2)
#define B_BIN(F) ((F).H)
#define B_QQ(F) ((F).Z2 + (size_t)T * 2048)
#define B_T1(F) ((F).Z4 + (size_t)T * 2048)
__device__ __forceinline__ void phase_gemm_in(const Frame0& F0, int l) {
    {
        PHASE_IDS(F0); EpiIn E{F.Z1, B_ZQ(F), B_ZK(F), B_ZV(F), F.Z3, B_GA(F), B_GB(F), F.Z5};
        pg8::Gemm g{F.H, F.WIN + (size_t)l * NINP * 2048, T, NINP, 2048}; SubsetOrder S{0, F.nb, F.bid};
        pg8::gemm_phase<EpiIn, SubsetOrder, true, true, false>(F.lds, g, S, E); }
    {
        PHASE_IDS(F0); EpiInS E{F.Z1, B_ZQ(F), B_ZK(F), B_ZV(F), F.Z3, B_GA(F), B_GB(F), F.Z5, (const float*)(F.ws + WS_HSIN), (const float*)(F.ws + WS_CSIN) + (size_t)l * NINP};
        pg8::Gemm g{(const bf16_t*)(F.ws + WS_H8IN), (const bf16_t*)(F.ws + WS_W8IN + (size_t)l * NINP * 2048), T, NINP, 2048}; SubsetOrder S{1, F.nb, F.bid};
        pg8::gemm_phase<EpiInS, SubsetOrder, true, true, true>(F.lds, g, S, E); }
}
__device__ __forceinline__ void phase_gemm_a(const Frame0& F0, int l) { PHASE_IDS(F0);
    EpiAS E{B_GA(F), B_Y(F), (const float*)(F.ws + WS_ASIN), (const float*)((const unsigned char*)F.WA + (size_t)2 * 2048 * 1024) + l * 2048};
    run_gemm<EpiAS, true>(F, F.H, (const bf16_t*)((const unsigned char*)F.WA + (size_t)l * 2048 * 1024), 2048, 1024, E); }
__device__ __forceinline__ void phase_gemm_b(const Frame0& F0, int l) { PHASE_IDS(F0);
    EpiBS E{B_GB(F), B_Y(F), F.VS + 110592, (const float*)((const unsigned char*)F.WB + (size_t)2 * 2048 * 2048) + l * 2048};
    run_gemm<EpiBS, true>(F, B_BIN(F), (const bf16_t*)((const unsigned char*)F.WB + (size_t)l * 2048 * 2048), 2048, 2048, E); }
__device__ __forceinline__ void phase_quant_y(const Frame0& F0) {
    PHASE_IDS(F0);
    const bf16_t* Y = B_Y(F); unsigned char* Y8 = (unsigned char*)F.Z1; float* YS = (float*)(F.ws + WS_YS);
    for (int row = F.bid * 8 + F.wave; row < T; row += F.nb * 8) {
        float4 v[8]; float am = 0.f;
#pragma unroll
        for (int i = 0; i < 8; ++i) { v[i] = ld_bf4(Y + (size_t)row * D + i * 256 + F.lane * 4); am = fmaxf(am, fmaxf(fmaxf(fabsf(v[i].x), fabsf(v[i].y)), fmaxf(fabsf(v[i].z), fabsf(v[i].w)))); }
        am = wmax(am);
        const float ys = am > 0.f ? am * (1.f / 127.f) : 1.f, yinv = 1.f / ys;
#pragma unroll
        for (int i = 0; i < 8; ++i) *(unsigned*)(Y8 + (size_t)row * D + i * 256 + F.lane * 4) = pack_i8(v[i].x * yinv, v[i].y * yinv, v[i].z * yinv, v[i].w * yinv);
        if (F.lane == 0) YS[row] = ys;
    }
}
__device__ __forceinline__ void phase_gemm_o(const Frame0& F0, int l) { PHASE_IDS(F0);
    EpiOS E{F.x_prompt, F.x_sample, F.out, F.MOD + (size_t)l * 9 * NADA, B_T1(F), l, (const float*)(F.ws + WS_YS), (const float*)((const unsigned char*)F.WO + (size_t)2 * 2048 * 2048) + l * 2048};
    run_gemm<EpiOS, true>(F, (const bf16_t*)F.Z1, (const bf16_t*)((const unsigned char*)F.WO + (size_t)l * 2048 * 2048), 2048, 2048, E); }
__device__ __forceinline__ void phase_gemm_pq(const Frame0& F0, int l) { PHASE_IDS(F0);
    EpiPlainS E{B_QQ(F), 2048, F.VS + 32768, (const float*)((const unsigned char*)F.WPQ + (size_t)2 * 2048 * 2048) + l * 2048};
    run_gemm<EpiPlainS, true>(F, (const bf16_t*)((const unsigned char*)F.Z3 + ((size_t)64 << 20)), (const bf16_t*)((const unsigned char*)F.WPQ + (size_t)l * 2048 * 2048), 2048, 2048, E); }

__device__ __forceinline__ void phase_conv(const Frame0& F0, int l) {
    PHASE_IDS(F0);
    const bf16_t* Z1 = F.Z1; unsigned char* AIN = (unsigned char*)F.H;
    float* AS = (float*)(F.ws + WS_ASIN);
    LAS float* red = (LAS float*)F.lds;
    const size_t gth = (size_t)F.nb * 512;
    int par = 0;
    for (size_t it = (size_t)F.bid * 512 + F.tid; it < (size_t)T * 128; it += gth, par ^= 8) {
        const int t = (int)(it >> 7), ch = (int)(it & 127) * 8;
        int dlt; bool vm, vp;
        if (t < TCTX) { const int pos = t & 255; dlt = 1; vm = pos > 0; vp = pos < 255; }
        else { const int tau = (t - TCTX) & 4095;
            if (ch < 512) { dlt = 1; vm = (tau & 63) > 0; vp = (tau & 63) < 63; } else { dlt = 64; vm = tau >= 64; vp = tau < 4032; } }
        const bf16_t* zr = Z1 + (size_t)t * 3072;
        const u32x4 zero = {0u, 0u, 0u, 0u};
        const u32x4 cb = *(const u32x4*)(zr + ch), cc0 = *(const u32x4*)(zr + 1024 + ch), cx0 = *(const u32x4*)(zr + 2048 + ch);
        const u32x4 ccm = vm ? *(const u32x4*)(zr - (size_t)dlt * 3072 + 1024 + ch) : zero, cxm = vm ? *(const u32x4*)(zr - (size_t)dlt * 3072 + 2048 + ch) : zero;
        const u32x4 ccp = vp ? *(const u32x4*)(zr + (size_t)dlt * 3072 + 1024 + ch) : zero, cxp = vp ? *(const u32x4*)(zr + (size_t)dlt * 3072 + 2048 + ch) : zero;
        const float* wc = F.w_conv + (size_t)l * 3072 + ch;
        const float4 w0a = *(const float4*)(wc), w0b = *(const float4*)(wc + 4), w1a = *(const float4*)(wc + 1024), w1b = *(const float4*)(wc + 1028), w2a = *(const float4*)(wc + 2048), w2b = *(const float4*)(wc + 2052);
        const float w0[8] = {w0a.x, w0a.y, w0a.z, w0a.w, w0b.x, w0b.y, w0b.z, w0b.w};
        const float w1[8] = {w1a.x, w1a.y, w1a.z, w1a.w, w1b.x, w1b.y, w1b.z, w1b.w};
        const float w2[8] = {w2a.x, w2a.y, w2a.z, w2a.w, w2b.x, w2b.y, w2b.z, w2b.w};
        float o[8]; float am = 0.f;
#pragma unroll
        for (int j = 0; j < 4; ++j) {
            const float um0 = bf_lo(ccm[j]) * bf_lo(cxm[j]), um1 = bf_hi(ccm[j]) * bf_hi(cxm[j]);
            const float u00 = bf_lo(cc0[j]) * bf_lo(cx0[j]), u01 = bf_hi(cc0[j]) * bf_hi(cx0[j]);
            const float up0 = bf_lo(ccp[j]) * bf_lo(cxp[j]), up1 = bf_hi(ccp[j]) * bf_hi(cxp[j]);
            o[2 * j] = bf_lo(cb[j]) * (um0 * w0[2 * j] + u00 * w1[2 * j] + up0 * w2[2 * j]);
            o[2 * j + 1] = bf_hi(cb[j]) * (um1 * w0[2 * j + 1] + u01 * w1[2 * j + 1] + up1 * w2[2 * j + 1]);
            am = fmaxf(am, fmaxf(fabsf(o[2 * j]), fabsf(o[2 * j + 1])));
        }
        am = wmax(am);
        if (F.lane == 0) red[par + F.wave] = am;
        __syncthreads();
        am = fmaxf(red[par + (F.wave & 6)], red[par + (F.wave & 6) + 1]);
        const float as = am > 0.f ? am * (1.f / 127.f) : 1.f, ainv = 1.f / as;
        u32x2 w; w.x = pack_i8(o[0] * ainv, o[1] * ainv, o[2] * ainv, o[3] * ainv); w.y = pack_i8(o[4] * ainv, o[5] * ainv, o[6] * ainv, o[7] * ainv);
        *(u32x2*)(AIN + (size_t)t * 1024 + ch) = w;
        if ((F.tid & 127) == 0) AS[t] = as;
    }
}

__device__ __forceinline__ float logsig_(float x) { return fminf(x, 0.f) - __logf(1.f + __expf(-fabsf(x))); }
__device__ __forceinline__ void phase_gla_prep(const Frame0& F0, int l) {
    PHASE_IDS(F0);
    LAS float* LF = (LAS float*)F.lds;
    LAS float* HT = LF + 2048;
    const int tid = F.tid;
    const int d = tid & 255, half = tid >> 8, p0 = half * 32;
    const bf16_t* ZQ = B_ZQ(F); const bf16_t* ZK = B_ZK(F); const float* Z5 = F.Z5;
    for (int u = F.bid; u < (T / 64) * 4; u += F.nb) {
        const int ch = u >> 2, head = u & 3, tb = ch * 64;
        __syncthreads();
        { const int row = tid >> 3, part = tid & 7; const f32x4 v = *(const f32x4*)(Z5 + (size_t)(tb + row) * 32 + part * 4);
          *(LAS f32x4*)(LF + (part >> 2) * 1024 + row * 16 + (part & 3) * 4) = v; }
        bf16_t qv[32], kv[32];
#pragma unroll
        for (int i = 0; i < 32; ++i) { const size_t ro = (size_t)(tb + p0 + i) * 1024 + head * 256 + d; qv[i] = ZQ[ro]; kv[i] = ZK[ro]; }
        __syncthreads();
#pragma unroll 1
        for (int dir = 0; dir < 2; ++dir) {
            float wg[16];
#pragma unroll
            for (int r = 0; r < 16; ++r) wg[r] = F.w_gk[((size_t)(l * 2 + dir) * 16 + r) * 1024 + head * 256 + d];
            const float gbias = F.b_gk[(size_t)(l * 2 + dir) * 1024 + head * 256 + d];
            float b[32];
#pragma unroll
            for (int i = 0; i < 32; ++i) { float x = gbias; const LAS float* lf = LF + dir * 1024 + (p0 + i) * 16;
#pragma unroll
                for (int r = 0; r < 16; ++r) x += lf[r] * wg[r];
                b[i] = fmaxf(logsig_(x) * 0.0625f, -1.0f); }
            float tot;
            if (!dir) {
#pragma unroll
                for (int i = 1; i < 32; ++i) b[i] += b[i - 1];
                tot = b[31];
            } else {
#pragma unroll
                for (int i = 30; i >= 0; --i) b[i] += b[i + 1];
                tot = b[0];
            }
            HT[half * 256 + d] = tot;
            __syncthreads();
            const float other = HT[(1 - half) * 256 + d];
            const float blast = tot + other;
            const float addv = (dir == 0) ? (half ? other : 0.f) : (half ? 0.f : other);
            bf16_t* QD = dir ? B_QDB(F) : B_QDF(F); bf16_t* KD = dir ? B_KDB(F) : B_KDF(F);
#pragma unroll
            for (int i = 0; i < 32; ++i) {
                const float bb = b[i] + addv; const size_t ro = (size_t)(tb + p0 + i) * 1024 + head * 256 + d;
                QD[ro] = f2bf(bf1(qv[i]) * 0.0625f * __expf(bb - blast));
                KD[ro] = f2bf(bf1(kv[i]) * __expf(blast - bb));
            }
            if (half == 0) B_DEC(F)[((size_t)dir * (T / 64) * 4 + u) * 256 + d] = __expf(blast);
            __syncthreads();
        }
    }
}
__device__ __forceinline__ void phase_gla_scan(const Frame0& F0, int l) {
    PHASE_IDS(F0);
    LAS unsigned char* L = F.lds;
    constexpr int QD_OFF = 0, KD_OFF = 33792, V_OFF = 67584, ST_OFF = 76800, ATT_OFF = 110592, DEC_OFF = 119808;
    const int tid = F.tid, lane = F.lane, wave = F.wave;
    const int fr = lane & 15, fq = lane >> 4;
    const unsigned lbase = (unsigned)(size_t)L;
    const unsigned tr_lane_v = lbase + V_OFF + (unsigned)((8 * fq + (fr >> 2)) * 144 + 8 * (lane & 3));
    const unsigned tr_lane_k = lbase + KD_OFF + (unsigned)((8 * fq + (fr >> 2)) * 528 + 8 * (lane & 3) + wave * 64);
    const bf16_t* ZV = B_ZV(F); bf16_t* OF = B_OF(F);
    const int ti = wave >> 1;
    for (int u0 = F.bid; u0 < 768; u0 += F.nb) {
        const int u = (F.nb == 256) ? (u0 & ~255) + (u0 & 7) * 32 + ((u0 & 255) >> 3) : u0;
        int seq, head, slice, tok0, nch; bool lat;
        if (u < 256) { lat = true; slice = u & 7; head = (u >> 3) & 3; seq = u >> 5; tok0 = TCTX + seq * 4096; nch = 64; }
        else { const int uc = u - 256; lat = false; slice = uc & 7; head = (uc >> 3) & 3; seq = uc >> 5; tok0 = seq * 256; nch = 4; }
#pragma unroll 1
      for (int dir = 0; dir < 2; ++dir) {
        const bf16_t* QD = dir ? B_QDB(F) : B_QDF(F); const bf16_t* KD = dir ? B_KDB(F) : B_KDF(F);
        const float* DEC = B_DEC(F) + (size_t)dir * (T / 64) * 4 * 256;
        const size_t soff = ((((size_t)seq * 2 + l) * 2 + dir) * 4 + head) * 256 * 512;
        f32x4 accS[2][4];
#pragma unroll
        for (int tdi = 0; tdi < 2; ++tdi)
#pragma unroll
            for (int te = 0; te < 4; ++te)
#pragma unroll
                for (int reg = 0; reg < 4; ++reg) {
                    const int dd = (2 * wave + tdi) * 16 + 4 * fq + reg, e = slice * 64 + te * 16 + fr;
                    accS[tdi][te][reg] = lat ? F.state[soff + (size_t)dd * 512 + e] : 0.f;
                }
        u32x4 rq[4], rk[4], rv; f32x4 rdec = {0.f, 0.f, 0.f, 0.f}; bf16_t ro[2][4];
#define GS_LOAD(cc_) do { const int c_ = dir ? nch - 1 - (cc_) : (cc_); const int tb_ = tok0 + c_ * 64; int tl_ = tid; asm volatile("" : "+v"(tl_));   \
            _Pragma("unroll") for (int i_ = 0; i_ < 4; ++i_) { const int id_ = tl_ + 512 * i_, row_ = id_ >> 5, c16_ = id_ & 31; const size_t go_ = (size_t)(tb_ + row_) * 1024 + head * 256 + c16_ * 8; \
                rq[i_] = *(const u32x4*)(QD + go_); rk[i_] = *(const u32x4*)(KD + go_); } \
            rv = *(const u32x4*)(ZV + (size_t)(tb_ + (tl_ >> 3)) * 2048 + head * 512 + slice * 64 + (tl_ & 7) * 8); \
            if (tl_ < 64) rdec = *(const f32x4*)(DEC + ((size_t)(tb_ >> 6) * 4 + head) * 256 + tl_ * 4); \
            if (dir) { const int ln_ = tl_ & 63, wv_ = tl_ >> 6; const bf16_t* ob_ = OF + (size_t)(tb_ + (wv_ >> 1) * 16 + 4 * (ln_ >> 4)) * 2048 + head * 512 + slice * 64 + 2 * (wv_ & 1) * 16 + (ln_ & 15); \
                _Pragma("unroll") for (int t2_ = 0; t2_ < 2; ++t2_) _Pragma("unroll") for (int reg_ = 0; reg_ < 4; ++reg_) ro[t2_][reg_] = ob_[reg_ * 2048 + t2_ * 16]; } } while (0)
        GS_LOAD(0);
#define GS_BAR() do { asm volatile("s_waitcnt lgkmcnt(0)" ::: "memory"); __builtin_amdgcn_s_barrier(); asm volatile("" ::: "memory"); } while (0)
        for (int cc = 0; cc < nch; ++cc) {
            const int c = dir ? nch - 1 - cc : cc; const int tb = tok0 + c * 64;
            GS_BAR();
#pragma unroll
            for (int i = 0; i < 4; ++i) { const int id = tid + 512 * i, row = id >> 5, c16 = id & 31;
                *(LAS u32x4*)(L + QD_OFF + row * 528 + c16 * 16) = rq[i]; *(LAS u32x4*)(L + KD_OFF + row * 528 + c16 * 16) = rk[i]; }
            *(LAS u32x4*)(L + V_OFF + (tid >> 3) * 144 + (tid & 7) * 16) = rv;
            if (tid < 64) *(LAS f32x4*)(L + DEC_OFF + tid * 16) = rdec;
            bf16_t oold[2][4];
#pragma unroll
            for (int t2 = 0; t2 < 2; ++t2)
#pragma unroll
                for (int reg = 0; reg < 4; ++reg) oold[t2][reg] = ro[t2][reg];
            GS_BAR();
            { const int nx = (cc + 1 < nch) ? cc + 1 : cc; GS_LOAD(nx); }
#pragma unroll
            for (int tdi = 0; tdi < 2; ++tdi) {
                const f32x4 dec = *(const LAS f32x4*)(L + DEC_OFF + ((2 * wave + tdi) * 16 + 4 * fq) * 4);
#pragma unroll
                for (int te = 0; te < 4; ++te) { accS[tdi][te] = accS[tdi][te] * dec;
                    u32x2 w; w.x = cvt_pk_bf16(accS[tdi][te][0], accS[tdi][te][1]); w.y = cvt_pk_bf16(accS[tdi][te][2], accS[tdi][te][3]);
                    *(LAS u32x2*)(L + ST_OFF + (te * 16 + fr) * 528 + ((2 * wave + tdi) * 16 + 4 * fq) * 2) = w; }
            }
#pragma unroll
            for (int t2 = 0; t2 < 2; ++t2) {
                const int tj = 2 * (wave & 1) + t2;
                const bool live = dir ? (tj >= ti) : (tj <= ti);
                f32x4 a4 = {0.f, 0.f, 0.f, 0.f};
                if (live) {
#pragma unroll
                    for (int ks = 0; ks < 8; ++ks) {
                        const bf16x8 a = *(const LAS bf16x8*)(L + QD_OFF + (ti * 16 + fr) * 528 + ks * 64 + fq * 16);
                        const bf16x8 bb = *(const LAS bf16x8*)(L + KD_OFF + (tj * 16 + fr) * 528 + ks * 64 + fq * 16);
                        a4 = __builtin_amdgcn_mfma_f32_16x16x32_bf16(a, bb, a4, 0, 0, 0);
                    }
                }
#pragma unroll
                for (int reg = 0; reg < 4; ++reg) { const int i = ti * 16 + 4 * fq + reg, j = tj * 16 + fr; const bool keep = dir ? (j >= i) : (j <= i);
                    *(LAS bf16_t*)(L + ATT_OFF + i * 144 + j * 2) = f2bf(keep ? a4[reg] : 0.f); }
            }
            GS_BAR();
            u32x2 vt[2][4][2], kt[2][2][2];
            asm volatile(
                "ds_read_b64_tr_b16 %0, %16 offset:0\n\tds_read_b64_tr_b16 %1, %16 offset:576\n\tds_read_b64_tr_b16 %2, %16 offset:32\n\tds_read_b64_tr_b16 %3, %16 offset:608\n\t"
                "ds_read_b64_tr_b16 %4, %16 offset:64\n\tds_read_b64_tr_b16 %5, %16 offset:640\n\tds_read_b64_tr_b16 %6, %16 offset:96\n\tds_read_b64_tr_b16 %7, %16 offset:672\n\t"
                "ds_read_b64_tr_b16 %8, %16 offset:4608\n\tds_read_b64_tr_b16 %9, %16 offset:5184\n\tds_read_b64_tr_b16 %10, %16 offset:4640\n\tds_read_b64_tr_b16 %11, %16 offset:5216\n\t"
                "ds_read_b64_tr_b16 %12, %16 offset:4672\n\tds_read_b64_tr_b16 %13, %16 offset:5248\n\tds_read_b64_tr_b16 %14, %16 offset:4704\n\tds_read_b64_tr_b16 %15, %16 offset:5280\n\t"
                "s_waitcnt lgkmcnt(0)"
                : "=&v"(vt[0][0][0]), "=&v"(vt[0][0][1]), "=&v"(vt[0][1][0]), "=&v"(vt[0][1][1]), "=&v"(vt[0][2][0]), "=&v"(vt[0][2][1]), "=&v"(vt[0][3][0]), "=&v"(vt[0][3][1]),
                  "=&v"(vt[1][0][0]), "=&v"(vt[1][0][1]), "=&v"(vt[1][1][0]), "=&v"(vt[1][1][1]), "=&v"(vt[1][2][0]), "=&v"(vt[1][2][1]), "=&v"(vt[1][3][0]), "=&v"(vt[1][3][1])
                : "v"(tr_lane_v) : "memory");
            asm volatile(
                "ds_read_b64_tr_b16 %0, %8 offset:0\n\tds_read_b64_tr_b16 %1, %8 offset:2112\n\tds_read_b64_tr_b16 %2, %8 offset:16896\n\tds_read_b64_tr_b16 %3, %8 offset:19008\n\t"
                "ds_read_b64_tr_b16 %4, %8 offset:32\n\tds_read_b64_tr_b16 %5, %8 offset:2144\n\tds_read_b64_tr_b16 %6, %8 offset:16928\n\tds_read_b64_tr_b16 %7, %8 offset:19040\n\t"
                "s_waitcnt lgkmcnt(0)"
                : "=&v"(kt[0][0][0]), "=&v"(kt[0][0][1]), "=&v"(kt[0][1][0]), "=&v"(kt[0][1][1]), "=&v"(kt[1][0][0]), "=&v"(kt[1][0][1]), "=&v"(kt[1][1][0]), "=&v"(kt[1][1][1])
                : "v"(tr_lane_k) : "memory");
#define GS_FRAG(x_) __builtin_bit_cast(bf16x8, (u32x4){(x_)[0].x, (x_)[0].y, (x_)[1].x, (x_)[1].y})
#pragma unroll
            for (int t2 = 0; t2 < 2; ++t2) {
                const int te = 2 * (wave & 1) + t2;
                f32x4 o4 = {0.f, 0.f, 0.f, 0.f};
#pragma unroll
                for (int ks = 0; ks < 8; ++ks) {
                    const bf16x8 a = *(const LAS bf16x8*)(L + QD_OFF + (ti * 16 + fr) * 528 + ks * 64 + fq * 16);
                    const bf16x8 bb = *(const LAS bf16x8*)(L + ST_OFF + (te * 16 + fr) * 528 + ks * 64 + fq * 16);
                    o4 = __builtin_amdgcn_mfma_f32_16x16x32_bf16(a, bb, o4, 0, 0, 0);
                }
#pragma unroll
                for (int ks = 0; ks < 2; ++ks) {
                    const bf16x8 a = *(const LAS bf16x8*)(L + ATT_OFF + (ti * 16 + fr) * 144 + ks * 64 + fq * 16);
                    const bf16x8 bb = (t2 == 0) ? ((wave & 1) ? GS_FRAG(vt[ks][2]) : GS_FRAG(vt[ks][0])) : ((wave & 1) ? GS_FRAG(vt[ks][3]) : GS_FRAG(vt[ks][1]));
                    o4 = __builtin_amdgcn_mfma_f32_16x16x32_bf16(a, bb, o4, 0, 0, 0);
                }
#pragma unroll
                for (int reg = 0; reg < 4; ++reg) { bf16_t* op = OF + (size_t)(tb + ti * 16 + 4 * fq + reg) * 2048 + head * 512 + slice * 64 + te * 16 + fr;
                    *op = f2bf(dir ? bf1(oold[t2][reg]) + o4[reg] : o4[reg]); }
            }
#pragma unroll
            for (int tdi = 0; tdi < 2; ++tdi)
#pragma unroll
                for (int te = 0; te < 4; ++te) {
                    f32x4 s4 = accS[tdi][te];
                    s4 = __builtin_amdgcn_mfma_f32_16x16x32_bf16(GS_FRAG(kt[tdi][0]), GS_FRAG(vt[0][te]), s4, 0, 0, 0);
                    s4 = __builtin_amdgcn_mfma_f32_16x16x32_bf16(GS_FRAG(kt[tdi][1]), GS_FRAG(vt[1][te]), s4, 0, 0, 0);
                    accS[tdi][te] = s4;
                }
        }
#undef GS_BAR
#undef GS_LOAD
#undef GS_FRAG
        if (!lat) {
            float* so = F.out + (size_t)T * D + soff;
#pragma unroll
            for (int tdi = 0; tdi < 2; ++tdi)
#pragma unroll
                for (int te = 0; te < 4; ++te)
#pragma unroll
                    for (int reg = 0; reg < 4; ++reg) {
                        const int dd = (2 * wave + tdi) * 16 + 4 * fq + reg, e = slice * 64 + te * 16 + fr;
                        so[(size_t)dd * 512 + e] = accS[tdi][te][reg];
                    }
        }
        __syncthreads();
      }
    }
}

__device__ __forceinline__ void phase_postgla(const Frame0& F0, int l) {
    PHASE_IDS(F0);
    const bf16_t* OF = B_OF(F); const bf16_t* R = F.Z3; unsigned char* BIN = (unsigned char*)B_BIN(F);
    float* BS = F.VS + 110592;
    for (int row = F.bid * 8 + F.wave; row < T; row += F.nb * 8) {
        float y[4][8]; float am = 0.f;
#pragma unroll
        for (int hh = 0; hh < 4; ++hh) {
            const int col = hh * 512 + F.lane * 8;
            const u32x4 a = *(const u32x4*)(OF + (size_t)row * D + col), r = *(const u32x4*)(R + (size_t)row * D + col);
            float o[8]; float ss = 0.f;
#pragma unroll
            for (int j = 0; j < 4; ++j) { o[2 * j] = bf_lo(a[j]); o[2 * j + 1] = bf_hi(a[j]); ss += o[2 * j] * o[2 * j] + o[2 * j + 1] * o[2 * j + 1]; }
            const float rn = rsqrtf(wsum(ss) * (1.f / 512.f) + LN_EPS);
            const float4 g0 = *(const float4*)(F.w_gn + (size_t)l * D + col), g1 = *(const float4*)(F.w_gn + (size_t)l * D + col + 4);
            const float gn[8] = {g0.x, g0.y, g0.z, g0.w, g1.x, g1.y, g1.z, g1.w};
#pragma unroll
            for (int j = 0; j < 4; ++j) { y[hh][2 * j] = o[2 * j] * rn * gn[2 * j] * siluf_(bf_lo(r[j])); y[hh][2 * j + 1] = o[2 * j + 1] * rn * gn[2 * j + 1] * siluf_(bf_hi(r[j]));
                am = fmaxf(am, fmaxf(fabsf(y[hh][2 * j]), fabsf(y[hh][2 * j + 1]))); }
        }
        am = wmax(am);
        const float bs = am > 0.f ? am * (1.f / 127.f) : 1.f, binv = 1.f / bs;
#pragma unroll
        for (int hh = 0; hh < 4; ++hh) { u32x2 w; w.x = pack_i8(y[hh][0] * binv, y[hh][1] * binv, y[hh][2] * binv, y[hh][3] * binv); w.y = pack_i8(y[hh][4] * binv, y[hh][5] * binv, y[hh][6] * binv, y[hh][7] * binv);
            *(u32x2*)(BIN + (size_t)row * D + hh * 512 + F.lane * 8) = w; }
        if (F.lane == 0) BS[row] = bs;
    }
}

__device__ __forceinline__ void phase_ln2(const Frame0& F0, int l) {
    PHASE_IDS(F0);
    const float* lg = F.ln_g + (size_t)(l * 2 + 0) * D; const float* lb = F.ln_b + (size_t)(l * 2 + 0) * D;
    const int stride = F.nb * 8;
    int row = F.bid * 8 + F.wave;
    unsigned char* H8 = (unsigned char*)F.Z3 + ((size_t)64 << 20);
    float4 v[8], lgv[8], lbv[8], shv[8], scv[8]; int cci = -1;
#pragma unroll
    for (int i = 0; i < 8; ++i) { lgv[i] = *(const float4*)(lg + i * 256 + F.lane * 4); lbv[i] = *(const float4*)(lb + i * 256 + F.lane * 4); }
    if (row < T) {
#pragma unroll
        for (int i = 0; i < 8; ++i) v[i] = ld_bf4(B_T1(F) + (size_t)row * D + i * 256 + F.lane * 4); }
    for (; row < T; row += stride) {
        float4 vn[8];
        const int nrow = row + stride;
        if (nrow < T) {
#pragma unroll
            for (int i = 0; i < 8; ++i) vn[i] = ld_bf4(B_T1(F) + (size_t)nrow * D + i * 256 + F.lane * 4); }
        else {
#pragma unroll
            for (int i = 0; i < 8; ++i) vn[i] = v[i]; }
        const int ci = cond_of(row);
        if (ci != cci) { const float* md = F.MOD + (size_t)(l * 9 + ci) * NADA; cci = ci;
#pragma unroll
            for (int i = 0; i < 8; ++i) { shv[i] = *(const float4*)(md + 3 * 2048 + i * 256 + F.lane * 4); scv[i] = *(const float4*)(md + 4 * 2048 + i * 256 + F.lane * 4); } }
        float s = 0.f;
#pragma unroll
        for (int i = 0; i < 8; ++i) s += (v[i].x + v[i].y) + (v[i].z + v[i].w);
        float mean = wsum(s) * (1.f / 2048.f); float q = 0.f;
#pragma unroll
        for (int i = 0; i < 8; ++i) { const float a = v[i].x - mean, b = v[i].y - mean, c = v[i].z - mean, d = v[i].w - mean; q += (a * a + b * b) + (c * c + d * d); }
        float rstd = rsqrtf(wsum(q) * (1.f / 2048.f) + LN_EPS);
        s = 0.f;
#pragma unroll
        for (int i = 0; i < 8; ++i) { const float4 g = lgv[i], bb = lbv[i];
            v[i].x = (v[i].x - mean) * rstd * g.x + bb.x; v[i].y = (v[i].y - mean) * rstd * g.y + bb.y; v[i].z = (v[i].z - mean) * rstd * g.z + bb.z; v[i].w = (v[i].w - mean) * rstd * g.w + bb.w;
            s += (v[i].x + v[i].y) + (v[i].z + v[i].w); }
        mean = wsum(s) * (1.f / 2048.f); q = 0.f;
#pragma unroll
        for (int i = 0; i < 8; ++i) { const float a = v[i].x - mean, b = v[i].y - mean, c = v[i].z - mean, d = v[i].w - mean; q += (a * a + b * b) + (c * c + d * d); }
        rstd = rsqrtf(wsum(q) * (1.f / 2048.f) + LN_EPS);
        float am = 0.f;
#pragma unroll
        for (int i = 0; i < 8; ++i) { const int col = i * 256 + F.lane * 4;
            const float4 sh = shv[i], sc = scv[i]; float4 h;
            h.x = (v[i].x - mean) * rstd * (1.f + sc.x) + sh.x; h.y = (v[i].y - mean) * rstd * (1.f + sc.y) + sh.y; h.z = (v[i].z - mean) * rstd * (1.f + sc.z) + sh.z; h.w = (v[i].w - mean) * rstd * (1.f + sc.w) + sh.w;
            u32x2 o; o.x = cvt_pk_bf16(h.x, h.y); o.y = cvt_pk_bf16(h.z, h.w);
            *(u32x2*)(F.H + (size_t)row * D + col) = o;
            v[i] = h; am = fmaxf(am, fmaxf(fmaxf(fabsf(h.x), fabsf(h.y)), fmaxf(fabsf(h.z), fabsf(h.w)))); }
        am = wmax(am);
        const float hs = am > 0.f ? am * (1.f / 127.f) : 1.f, hinv = 1.f / hs;
#pragma unroll
        for (int i = 0; i < 8; ++i) *(unsigned*)(H8 + (size_t)row * D + i * 256 + F.lane * 4) = pack_i8(v[i].x * hinv, v[i].y * hinv, v[i].z * hinv, v[i].w * hinv);
        if (F.lane == 0) F.VS[32768 + row] = hs;
#pragma unroll
        for (int i = 0; i < 8; ++i) v[i] = vn[i];
    }
}

__device__ __forceinline__ unsigned ord_u32(float f) { const unsigned u = __float_as_uint(f); return (u & 0x80000000u) ? ~u : (u | 0x80000000u); }
__device__ __forceinline__ float unord_f32(unsigned u) { return (u & 0x80000000u) ? __uint_as_float(u & 0x7fffffffu) : __uint_as_float(~u); }
__device__ __forceinline__ unsigned umax_(unsigned a, unsigned b) { return a > b ? a : b; }
__device__ __forceinline__ unsigned xmax4(unsigned m) { m = umax_(m, (unsigned)__shfl_xor((int)m, 16)); m = umax_(m, (unsigned)__shfl_xor((int)m, 32)); return m; }
__device__ __forceinline__ void phase_peer_score(const Frame0& F0, int l) {
    PHASE_IDS(F0);
    LAS unsigned char* L = F.lds;
    constexpr int KL_ROW = 272, LW_OFF = 2 * 128 * KL_ROW;
    constexpr int CA[52] = {0, 0, 0, 0, 0, 0, 0, 0, 0, 0, 0, 0, 0, 0, 0, 0, 1, 1, 1, 1, 1, 1, 1, 1, 2, 2, 2, 2, 2, 3, 3, 3, 3, 4, 4, 4, 5, 5, 6, 6, 7, 7, 8, 9, 10, 11, 12, 13, 14, 15, 0, 0};
    constexpr int CB[52] = {0, 1, 2, 3, 4, 5, 6, 7, 8, 9, 10, 11, 12, 13, 14, 15, 0, 1, 2, 3, 4, 5, 6, 7, 0, 1, 2, 3, 4, 0, 1, 2, 3, 0, 1, 2, 0, 1, 0, 1, 0, 1, 0, 0, 0, 0, 0, 0, 0, 0, 0, 0};
    const int tid = F.tid, lane = F.lane, wave = F.wave, fr = lane & 15, fq = lane >> 4;
    const bf16_t* QQ = B_QQ(F);
    int* PIDX = (int*)F.Z3; float* PGATE = (float*)((unsigned char*)F.Z3 + (size_t)T * 128 * 4);
    for (int i = tid; i < 2 * 128 * 128 / 4; i += 512) {
        const int idx = i * 4, side = idx >> 14, n = (idx >> 7) & 127, dd = idx & 127;
        const float4 v = *(const float4*)(F.pkeys + (size_t)l * 2 * 128 * 128 + idx);
        u32x2 w; w.x = cvt_pk_bf16(v.x, v.y); w.y = cvt_pk_bf16(v.z, v.w);
        *(LAS u32x2*)(L + (side * 128 + n) * KL_ROW + dd * 2) = w;
    }
    __syncthreads();
    LAS int* nbuf = (LAS int*)(L + LW_OFF + wave * 4096);
    LAS float* vbuf = (LAS float*)(L + LW_OFF + wave * 4096 + 2048);
    bf16x8 bqn[2][4];
    { const int task0 = F.bid * 8 + wave; if (task0 < (T / 16) * 8) { const int tok0 = (task0 >> 3) * 16 + fr, h0 = task0 & 7;
#pragma unroll
        for (int side = 0; side < 2; ++side)
#pragma unroll
            for (int ks = 0; ks < 4; ++ks) bqn[side][ks] = *(const bf16x8*)(QQ + (size_t)tok0 * D + h0 * 256 + side * 128 + ks * 32 + fq * 8); } }
    for (int task = F.bid * 8 + wave; task < (T / 16) * 8; task += F.nb * 8) {
        const int tg = task >> 3, h = task & 7, tok = tg * 16 + fr;
        unsigned key0[32], key1[32];
#pragma unroll
        for (int side = 0; side < 2; ++side)
#pragma unroll
            for (int tile = 0; tile < 8; ++tile) {
                f32x4 s4 = {0.f, 0.f, 0.f, 0.f};
#pragma unroll
                for (int ks = 0; ks < 4; ++ks) {
                    const bf16x8 a = *(const LAS bf16x8*)(L + (side * 128 + tile * 16 + fr) * KL_ROW + ks * 64 + fq * 16);
                    s4 = __builtin_amdgcn_mfma_f32_16x16x32_bf16(a, bqn[side][ks], s4, 0, 0, 0);
                }
#pragma unroll
                for (int reg = 0; reg < 4; ++reg) { const unsigned kv = (ord_u32(s4[reg]) & ~127u) | (unsigned)(127 - (tile * 16 + 4 * fq + reg)); if (side == 0) key0[tile * 4 + reg] = kv; else key1[tile * 4 + reg] = kv; }
                if (tile & 1) __builtin_amdgcn_sched_barrier(0);
            }
        { const int ntask = task + F.nb * 8; if (ntask < (T / 16) * 8) { const int tokn = (ntask >> 3) * 16 + fr, hn = ntask & 7;
#pragma unroll
            for (int side = 0; side < 2; ++side)
#pragma unroll
                for (int ks = 0; ks < 4; ++ks) bqn[side][ks] = *(const bf16x8*)(QQ + (size_t)tokn * D + hn * 256 + side * 128 + ks * 32 + fq * 8); } }
        float v1[16], v2[16];
#pragma unroll
        for (int side = 0; side < 2; ++side) {
#pragma unroll
            for (int r = 0; r < 16; ++r) {
                unsigned m = side == 0 ? key0[0] : key1[0];
#pragma unroll
                for (int i = 1; i < 32; ++i) m = umax_(m, side == 0 ? key0[i] : key1[i]);
                m = xmax4(m);
#pragma unroll
                for (int i = 0; i < 32; ++i) { if (side == 0) key0[i] = (key0[i] == m) ? 0u : key0[i]; else key1[i] = (key1[i] == m) ? 0u : key1[i]; }
                const float val = unord_f32(m & ~127u);
                if (side == 0) v1[r] = val; else v2[r] = val;
                if (fq == 0) { nbuf[fr * 32 + side * 16 + r] = 127 - (int)(m & 127u); vbuf[fr * 32 + side * 16 + r] = val; }
            }
        }
        unsigned ck[13];
#pragma unroll
        for (int s = 0; s < 13; ++s) {
            const float x0 = v1[CA[4 * s]] + v2[CB[4 * s]], x1 = v1[CA[4 * s + 1]] + v2[CB[4 * s + 1]], x2 = v1[CA[4 * s + 2]] + v2[CB[4 * s + 2]], x3 = v1[CA[4 * s + 3]] + v2[CB[4 * s + 3]];
            const int c0 = CA[4 * s] * 16 + CB[4 * s], c1 = CA[4 * s + 1] * 16 + CB[4 * s + 1], c2 = CA[4 * s + 2] * 16 + CB[4 * s + 2], c3 = CA[4 * s + 3] * 16 + CB[4 * s + 3];
            const float xv = fq == 0 ? x0 : (fq == 1 ? x1 : (fq == 2 ? x2 : x3));
            const int cv = fq == 0 ? c0 : (fq == 1 ? c1 : (fq == 2 ? c2 : c3));
            const bool valid = (4 * s + fq) < 50;
            ck[s] = valid ? ((ord_u32(xv) & ~255u) | (unsigned)(255 - cv)) : 0u;
        }
        unsigned cw[16];
#pragma unroll
        for (int r = 0; r < 16; ++r) {
            unsigned m = ck[0];
#pragma unroll
            for (int i = 1; i < 13; ++i) m = umax_(m, ck[i]);
            m = xmax4(m);
#pragma unroll
            for (int i = 0; i < 13; ++i) ck[i] = (ck[i] == m) ? 0u : ck[i];
            cw[r] = m;
        }
        asm volatile("s_waitcnt lgkmcnt(0)" ::: "memory");
        __builtin_amdgcn_wave_barrier();
        float sv[4]; int ix[4];
#pragma unroll
        for (int i = 0; i < 4; ++i) {
            const unsigned m = fq == 0 ? cw[4 * i] : (fq == 1 ? cw[4 * i + 1] : (fq == 2 ? cw[4 * i + 2] : cw[4 * i + 3]));
            const int code = 255 - (int)(m & 255u), a = code >> 4, b = code & 15;
            ix[i] = nbuf[fr * 32 + a] * 128 + nbuf[fr * 32 + 16 + b];
            sv[i] = vbuf[fr * 32 + a] + vbuf[fr * 32 + 16 + b];
        }
        float mx = fmaxf(fmaxf(sv[0], sv[1]), fmaxf(sv[2], sv[3]));
        mx = fmaxf(mx, __shfl_xor(mx, 16)); mx = fmaxf(mx, __shfl_xor(mx, 32));
        float ev[4], es = 0.f;
#pragma unroll
        for (int i = 0; i < 4; ++i) { ev[i] = __expf(sv[i] - mx); es += ev[i]; }
        es += __shfl_xor(es, 16); es += __shfl_xor(es, 32);
        const float inv = 1.f / es;
#pragma unroll
        for (int i = 0; i < 4; ++i) { const size_t o = ((size_t)tok * 8 + h) * 16 + 4 * i + fq; PIDX[o] = ix[i]; PGATE[o] = ev[i] * inv; }
        asm volatile("s_waitcnt lgkmcnt(0)" ::: "memory");
        __builtin_amdgcn_wave_barrier();
    }
}

constexpr int PE_NG = 32, PE_NJ = 8, PE_NTB = T / 128, PE_BI = 16384;
constexpr size_t NPAIR = (size_t)T * 128;
constexpr size_t PE_ITEMS_OFF = 0, PE_VLIST_OFF = (size_t)32 << 20, PE_BLKOFF_OFF = (size_t)64 << 20, PE_GATES_OFF = (size_t)72 << 20;
__device__ __forceinline__ unsigned lds_add(LAS unsigned* p, unsigned v) { return __hip_atomic_fetch_add(p, v, __ATOMIC_RELAXED, __HIP_MEMORY_SCOPE_WORKGROUP); }
__device__ __forceinline__ void phase_peer_bucket(const Frame0& F0) {
    PHASE_IDS(F0);
    LAS unsigned* cnt = (LAS unsigned*)F.lds;
    LAS unsigned* base = cnt + 256;
    LAS unsigned* gstart = base + 256;
    const int* PIDX = (const int*)F.Z3;
    unsigned* ITEMS = (unsigned*)((unsigned char*)F.Z1 + PE_ITEMS_OFF); int* BLKOFF = (int*)((unsigned char*)F.Z1 + PE_BLKOFF_OFF);
    float* GATES = (float*)((unsigned char*)F.Z1 + PE_GATES_OFF); const float* PGATE = (const float*)((const unsigned char*)F.Z3 + (size_t)T * 128 * 4);
    const int tid = F.tid, lane = F.lane, wave = F.wave;
    for (int tb = F.bid; tb < PE_NTB; tb += F.nb) {
        if (tid < 256) cnt[tid] = 0u;
        __syncthreads();
        unsigned myidx[32];
#pragma unroll
        for (int k = 0; k < 32; ++k) { myidx[k] = (unsigned)PIDX[(size_t)tb * PE_BI + tid + 512 * k]; (void)lds_add(&cnt[wave * 32 + (myidx[k] >> 9)], 1u); }
        __syncthreads();
        if (tid < 64) {
            unsigned s = 0u;
            if (tid < 32) {
#pragma unroll
                for (int w = 0; w < 8; ++w) { const unsigned c = cnt[w * 32 + tid]; base[w * 32 + tid] = s; s += c; }
            }
            unsigned incl = s;
#pragma unroll
            for (int off = 1; off < 32; off <<= 1) { const unsigned v = (unsigned)__shfl_up((int)incl, off); if (lane >= off) incl += v; }
            if (tid < 32) {
                const unsigned excl = incl - s; gstart[tid] = excl; if (tid == 31) gstart[32] = incl;
#pragma unroll
                for (int w = 0; w < 8; ++w) base[w * 32 + tid] += excl;
            }
        }
        __syncthreads();
        if (tid < 33) BLKOFF[tb * 33 + tid] = (int)gstart[tid];
        if (tid < 256) cnt[tid] = 0u;
        __syncthreads();
#pragma unroll
        for (int k = 0; k < 32; ++k) { const int i = tid + 512 * k; const unsigned g = myidx[k] >> 9; const unsigned p = lds_add(&cnt[wave * 32 + g], 1u); const unsigned pos = base[wave * 32 + g] + p;
            ITEMS[(size_t)tb * PE_BI + pos] = ((unsigned)(i >> 7) << 21) | ((unsigned)(i & 127) << 14) | myidx[k]; }
        __syncthreads();
    }
}
__device__ __forceinline__ void phase_peer_u(const Frame0& F0, int l) {
    PHASE_IDS(F0);
    const float* PU = F.peer_u + (size_t)l * 16384 * D;
    LAS unsigned char* L = F.lds;
    constexpr int WROW = 272, P_OFF = 512 * WROW;
    LAS int* P = (LAS int*)(L + P_OFF);
    LAS int* B0 = P + 292;
    LAS int* WT = B0 + 288;
    const unsigned char* H2 = (const unsigned char*)F.Z3 + ((size_t)64 << 20);
    const unsigned* ITEMS = (const unsigned*)((unsigned char*)F.Z1 + PE_ITEMS_OFF); const int* BLKOFF = (const int*)((unsigned char*)F.Z1 + PE_BLKOFF_OFF);
    bf16_t* PART = (bf16_t*)F.Z2;
    const int tid = F.tid, lane = F.lane, wave = F.wave;
    for (int u = F.bid; u < PE_NG * PE_NJ; u += F.nb) {
        const int j = u & 7, g = u >> 3;
        __syncthreads();
        for (int i = tid; i < 512 * 16; i += 512) { const int row = i >> 4, c = i & 15;
            const float* sp = PU + (size_t)(g * 512 + row) * D + j * 256 + c * 16; const float4 a = ((const float4*)sp)[0], b = ((const float4*)sp)[1], cq = ((const float4*)sp)[2], dq = ((const float4*)sp)[3];
            const float ui = 1.f / F.VS[16384 + g * 512 + row];
            u32x4 v; v.x = pack_i8(a.x * ui, a.y * ui, a.z * ui, a.w * ui); v.y = pack_i8(b.x * ui, b.y * ui, b.z * ui, b.w * ui); v.z = pack_i8(cq.x * ui, cq.y * ui, cq.z * ui, cq.w * ui); v.w = pack_i8(dq.x * ui, dq.y * ui, dq.z * ui, dq.w * ui);
            *(LAS u32x4*)(L + row * WROW + c * 16) = v; }
        int c = 0;
        if (tid < PE_NTB) { const int b0 = BLKOFF[tid * 33 + g]; c = BLKOFF[tid * 33 + g + 1] - b0; B0[tid] = b0; }
        int incl = c;
#pragma unroll
        for (int off = 1; off < 64; off <<= 1) { const int v = __shfl_up(incl, off); if (lane >= off) incl += v; }
        if (lane == 63) WT[wave] = incl;
        __syncthreads();
        int woff = 0;
#pragma unroll
        for (int w = 0; w < 8; ++w) woff += (w < wave) ? WT[w] : 0;
        if (tid < PE_NTB) P[tid + 1] = incl + woff;
        if (tid == 0) P[0] = 0;
        __syncthreads();
        const int total = P[PE_NTB];
        const int sub = lane & 3;
        int tbw = 0;
        const unsigned char* hbase = H2 + j * 256 + sub * 16;
        const LAS unsigned char* wbase = L + sub * 16;
        bf16_t* partj = PART + (size_t)j * NPAIR;
#define PU_ISSUE(qb_, S) do { const int q_ = (qb_) + lane; S##ok = q_ < total; S##pp = 0; S##tb = 0; S##raw = 0u; \
            if (S##ok) { while (q_ >= P[tbw + 1]) ++tbw; S##pp = tbw * PE_BI + B0[tbw] + (q_ - P[tbw]); S##tb = tbw * 128; S##raw = ITEMS[S##pp]; } } while (0)
#define PU_BCAST(x_, r_) __builtin_amdgcn_update_dpp(0, (x_), (r_) * 0x55, 0xf, 0xf, true)
#define PU_LH1(TE_, H0_, H1_, r_) { const int bc_ = PU_BCAST(TE_, r_); TE_##e[r_] = bc_ & 511; const unsigned char* hp_ = hbase + (size_t)(bc_ >> 9) * D; H0_[2 * (r_)] = *(const u32x4*)(hp_); H0_[2 * (r_) + 1] = *(const u32x4*)(hp_ + 64); H1_[2 * (r_)] = *(const u32x4*)(hp_ + 128); H1_[2 * (r_) + 1] = *(const u32x4*)(hp_ + 192); }
#define PU_LOADH(S, TE_, H0_, H1_) do { TE_ = (int)(((unsigned)(S##tb + (int)(S##raw >> 21)) << 9) | (S##raw & 511u)); \
            PU_LH1(TE_, H0_, H1_, 0) PU_LH1(TE_, H0_, H1_, 1) PU_LH1(TE_, H0_, H1_, 2) PU_LH1(TE_, H0_, H1_, 3) } while (0)
#define PU_DPP_ADD(x_, ctrl_) ((x_) + __builtin_amdgcn_update_dpp(0, (x_), (ctrl_), 0xf, 0xf, true))
#define PU_D4(h_, w_) s0_ = __builtin_amdgcn_sdot4((int)(h_).x, (int)(w_).x, s0_, false); s1_ = __builtin_amdgcn_sdot4((int)(h_).y, (int)(w_).y, s1_, false); \
                s0_ = __builtin_amdgcn_sdot4((int)(h_).z, (int)(w_).z, s0_, false); s1_ = __builtin_amdgcn_sdot4((int)(h_).w, (int)(w_).w, s1_, false);
#define PU_C1(TE_, H0_, H1_, r_) { const LAS unsigned char* wp_ = wbase + TE_##e[r_] * WROW; \
                const u32x4 w0_ = *(const LAS u32x4*)(wp_), w1_ = *(const LAS u32x4*)(wp_ + 64), w2_ = *(const LAS u32x4*)(wp_ + 128), w3_ = *(const LAS u32x4*)(wp_ + 192); int s0_ = 0, s1_ = 0; \
                PU_D4(H0_[2 * (r_)], w0_) PU_D4(H0_[2 * (r_) + 1], w1_) PU_D4(H1_[2 * (r_)], w2_) PU_D4(H1_[2 * (r_) + 1], w3_) \
                int sm_ = s0_ + s1_; sm_ = PU_DPP_ADD(sm_, 0x4e); sm_ = PU_DPP_ADD(sm_, 0xb1);   \
                keep_ = (sub == r_) ? sm_ : keep_; }
#define PU_COMPUTE(S, TE_, H0_, H1_) do { int keep_ = 0; \
            PU_C1(TE_, H0_, H1_, 0) PU_C1(TE_, H0_, H1_, 1) PU_C1(TE_, H0_, H1_, 2) PU_C1(TE_, H0_, H1_, 3) \
            if (S##ok) partj[S##pp] = f2bf((float)keep_); } while (0)
        u32x4 hA0[8], hA1[8], hB0[8], hB1[8]; int teA, teB, teAe[8], teBe[8];
        bool s0ok, s1ok, s2ok, s3ok; int s0pp, s1pp, s2pp, s3pp, s0tb, s1tb, s2tb, s3tb; unsigned s0raw, s1raw, s2raw, s3raw;
        int qb = wave * 64;
        PU_ISSUE(qb, s0); PU_ISSUE(qb + 512, s1); PU_ISSUE(qb + 1024, s2);
        PU_LOADH(s0, teA, hA0, hA1);
        for (; qb < total; qb += 2048) {
            PU_ISSUE(qb + 1536, s3); PU_LOADH(s1, teB, hB0, hB1); PU_COMPUTE(s0, teA, hA0, hA1);
            PU_ISSUE(qb + 2048, s0); PU_LOADH(s2, teA, hA0, hA1); PU_COMPUTE(s1, teB, hB0, hB1);
            PU_ISSUE(qb + 2560, s1); PU_LOADH(s3, teB, hB0, hB1); PU_COMPUTE(s2, teA, hA0, hA1);
            PU_ISSUE(qb + 3072, s2); PU_LOADH(s0, teA, hA0, hA1); PU_COMPUTE(s3, teB, hB0, hB1);
        }
#undef PU_ISSUE
#undef PU_BCAST
#undef PU_LOADH
#undef PU_LH1
#undef PU_C1
#undef PU_D4
#undef PU_DPP_ADD
#undef PU_COMPUTE
    }
}
__device__ __forceinline__ void phase_peer_coef(const Frame0& F0) {
    PHASE_IDS(F0);
    const unsigned* ITEMS = (const unsigned*)((unsigned char*)F.Z1 + PE_ITEMS_OFF); unsigned* VLIST = (unsigned*)((unsigned char*)F.Z1 + PE_VLIST_OFF);
    const bf16_t* PART = (const bf16_t*)F.Z2; const float* PGATE = (const float*)((const unsigned char*)F.Z3 + (size_t)T * 128 * 4);
    for (int Lu = F.bid; Lu < PE_NTB * 8; Lu += F.nb) {
        int tb, su;
        if (F.nb == 256) { const int k = Lu >> 8, b = Lu & 255; tb = k * 32 + (b & 7) * 4 + (b >> 6); su = (b >> 3) & 7; } else { tb = Lu >> 3; su = Lu & 7; }
        const size_t p0 = (size_t)tb * PE_BI + su * 2048 + F.tid;
        unsigned item[4]; float s[4], gt[4], vs[4], qs[4];
#pragma unroll
        for (int r = 0; r < 4; ++r) { item[r] = ITEMS[p0 + r * 512]; s[r] = 0.f; }
#pragma unroll
        for (int r = 0; r < 4; ++r) { const size_t p = p0 + r * 512;
#pragma unroll
            for (int j = 0; j < PE_NJ; ++j) s[r] += bf1(PART[(size_t)j * NPAIR + p]); }
#pragma unroll
        for (int r = 0; r < 4; ++r) { const int t = tb * 128 + (int)(item[r] >> 21), slot = (int)((item[r] >> 14) & 127u);
            gt[r] = PGATE[(size_t)t * 128 + slot]; vs[r] = F.VS[item[r] & 16383u]; qs[r] = F.VS[16384 + (item[r] & 16383u)] * F.VS[32768 + t]; }
#pragma unroll
        for (int r = 0; r < 4; ++r) { const int t = tb * 128 + (int)(item[r] >> 21), slot = (int)((item[r] >> 14) & 127u); const unsigned idx = item[r] & 16383u;
            const float coef = gt[r] * gelu_tanh(s[r] * qs[r]) * vs[r];
            VLIST[((size_t)(t >> 6) * 128 + slot) * 64 + (t & 63)] = (idx << 16) | (unsigned)f2bf(coef); }
    }
}
constexpr size_t PE_PK_OFF = (size_t)80 << 20;
__device__ __forceinline__ void phase_peer_pack(const Frame0& F0) {
    PHASE_IDS(F0);
    const unsigned* VLIST = (const unsigned*)((unsigned char*)F.Z1 + PE_VLIST_OFF); unsigned* PK = (unsigned*)((unsigned char*)F.Z1 + PE_PK_OFF);
    float* CT = F.VS + 73728;
    for (int tw = F.bid + F.wave * F.nb; tw < T / 64; tw += 8 * F.nb) {
        const int t = tw * 64 + F.lane;
        const unsigned* vl = VLIST + (size_t)(t >> 6) * 8192 + (t & 63);
        float cm = 0.f;
#pragma unroll 1
        for (int kh = 0; kh < 2; ++kh) {
            unsigned it[64];
#pragma unroll
            for (int k = 0; k < 64; ++k) it[k] = vl[(kh * 64 + k) * 64];
#pragma unroll
            for (int k = 0; k < 64; ++k) cm = fmaxf(cm, fabsf(__uint_as_float(it[k] << 16)));
        }
        const float ct = cm > 0.f ? cm * (1.f / 127.f) : 1.f, cinv = 1.f / ct;
        unsigned* pk = PK + (size_t)(t >> 6) * (32 * 3 * 64) + (t & 63);
#pragma unroll 1
        for (int kh = 0; kh < 2; ++kh) {
            unsigned it[64];
#pragma unroll
            for (int k = 0; k < 64; ++k) it[k] = vl[(kh * 64 + k) * 64];
#pragma unroll
            for (int q = 0; q < 16; ++q) { const unsigned w0 = it[4 * q], w1 = it[4 * q + 1], w2 = it[4 * q + 2], w3 = it[4 * q + 3];
                unsigned* o = pk + (size_t)((kh * 16 + q) * 3) * 64;
                o[0] = (w0 >> 16) | (w1 & 0xffff0000u); o[64] = (w2 >> 16) | (w3 & 0xffff0000u);
                o[128] = pack_i8(__uint_as_float(w0 << 16) * cinv, __uint_as_float(w1 << 16) * cinv, __uint_as_float(w2 << 16) * cinv, __uint_as_float(w3 << 16) * cinv); }
        }
        CT[t] = ct;
    }
}
__device__ __forceinline__ void phase_peer_v(const Frame0& F0) {
    PHASE_IDS(F0);
    LAS unsigned char* L = F.lds;
    const unsigned char* V8 = F.V8; const unsigned* PK = (const unsigned*)((unsigned char*)F.Z1 + PE_PK_OFF);
    const float* CT = F.VS + 73728;
    float* FBUF = (float*)F.Z2;
    const int tid = F.tid;
    for (int u0 = F.bid; u0 < 256; u0 += F.nb) {
        const int u = (F.nb == 256) ? (u0 & 7) * 32 + (u0 >> 3) : u0;
        __syncthreads();
        for (int e = tid; e < 16384; e += 512) { const u32x2 v = *(const u32x2*)(V8 + (size_t)e * 2048 + u * 8); *(LAS u32x2*)(L + e * 8) = v; }
        __syncthreads();
        unsigned la[48], lb[48];
#define PV_LOAD(dst, t_, kb_) do { const unsigned* pk_ = PK + (size_t)((t_) >> 6) * (32 * 3 * 64) + ((t_) & 63) + (size_t)(kb_) * 48 * 64; \
            _Pragma("unroll") for (int i_ = 0; i_ < 48; ++i_) dst[i_] = pk_[i_ * 64]; } while (0)
#define PV_QUAD(src, q_) do { const unsigned d0_ = src[3 * (q_)], d1_ = src[3 * (q_) + 1], cq_ = src[3 * (q_) + 2]; \
            const u32x2 x0_ = *(const LAS u32x2*)(L + (d0_ & 0xffffu) * 8), x1_ = *(const LAS u32x2*)(L + (d0_ >> 16) * 8), x2_ = *(const LAS u32x2*)(L + (d1_ & 0xffffu) * 8), x3_ = *(const LAS u32x2*)(L + (d1_ >> 16) * 8); \
            { const unsigned tl01 = __builtin_amdgcn_perm(x1_.x, x0_.x, 0x05010400u), th01 = __builtin_amdgcn_perm(x1_.x, x0_.x, 0x07030602u), tl23 = __builtin_amdgcn_perm(x3_.x, x2_.x, 0x05010400u), th23 = __builtin_amdgcn_perm(x3_.x, x2_.x, 0x07030602u); \
              a0 = __builtin_amdgcn_sdot4((int)__builtin_amdgcn_perm(tl23, tl01, 0x05040100u), (int)cq_, a0, false); a1 = __builtin_amdgcn_sdot4((int)__builtin_amdgcn_perm(tl23, tl01, 0x07060302u), (int)cq_, a1, false); \
              a2 = __builtin_amdgcn_sdot4((int)__builtin_amdgcn_perm(th23, th01, 0x05040100u), (int)cq_, a2, false); a3 = __builtin_amdgcn_sdot4((int)__builtin_amdgcn_perm(th23, th01, 0x07060302u), (int)cq_, a3, false); } \
            { const unsigned tl01 = __builtin_amdgcn_perm(x1_.y, x0_.y, 0x05010400u), th01 = __builtin_amdgcn_perm(x1_.y, x0_.y, 0x07030602u), tl23 = __builtin_amdgcn_perm(x3_.y, x2_.y, 0x05010400u), th23 = __builtin_amdgcn_perm(x3_.y, x2_.y, 0x07030602u); \
              a4 = __builtin_amdgcn_sdot4((int)__builtin_amdgcn_perm(tl23, tl01, 0x05040100u), (int)cq_, a4, false); a5 = __builtin_amdgcn_sdot4((int)__builtin_amdgcn_perm(tl23, tl01, 0x07060302u), (int)cq_, a5, false); \
              a6 = __builtin_amdgcn_sdot4((int)__builtin_amdgcn_perm(th23, th01, 0x05040100u), (int)cq_, a6, false); a7 = __builtin_amdgcn_sdot4((int)__builtin_amdgcn_perm(th23, th01, 0x07060302u), (int)cq_, a7, false); } } while (0)
#define PV_BATCH(src) do { _Pragma("unroll") for (int q_ = 0; q_ < 16; ++q_) { PV_QUAD(src, q_); if ((q_ & 3) == 3) __builtin_amdgcn_sched_barrier(0); } } while (0)
        PV_LOAD(la, tid, 0);
        for (int t = tid; t < T; t += 512) {
            int a0 = 0, a1 = 0, a2 = 0, a3 = 0, a4 = 0, a5 = 0, a6 = 0, a7 = 0;
            const float ct = CT[t];
            const int tn = (t + 512 < T) ? t + 512 : t;
            PV_LOAD(lb, t, 1); PV_BATCH(la);
            PV_LOAD(la, tn, 0); PV_BATCH(lb);
            f32x4 o0 = {(float)a0 * ct, (float)a1 * ct, (float)a2 * ct, (float)a3 * ct}, o1 = {(float)a4 * ct, (float)a5 * ct, (float)a6 * ct, (float)a7 * ct};
            *(f32x4*)(FBUF + (size_t)t * D + u * 8) = o0; *(f32x4*)(FBUF + (size_t)t * D + u * 8 + 4) = o1;
        }
#undef PV_LOAD
#undef PV_QUAD
#undef PV_BATCH
    }
}
__device__ __forceinline__ void phase_peer_final(const Frame0& F0, int l) {
    PHASE_IDS(F0);
    const float* FBUF = (const float*)F.Z2;
    const float* lg = F.ln_g + (size_t)(l * 2 + 1) * D; const float* lb = F.ln_b + (size_t)(l * 2 + 1) * D;
    const float* lg0 = F.ln_g + (size_t)(l * 2 + 0) * D; const float* lb0 = F.ln_b + (size_t)(l * 2 + 0) * D;
    LAS float* PL = (LAS float*)F.lds;
    for (int i = F.tid; i < 2048; i += 512) { PL[i] = lg0[i]; PL[2048 + i] = lb0[i]; PL[4096 + i] = lg[i]; PL[6144 + i] = lb[i]; }
    __syncthreads();
    const int stride = F.nb * 8;
    int row = F.bid * 8 + F.wave;
    float4 xv[8], g2v[8]; int cci = -1;
    if (row < T) {
#pragma unroll
        for (int i = 0; i < 8; ++i) xv[i] = ld_bf4(B_T1(F) + (size_t)row * D + i * 256 + F.lane * 4); }
    for (; row < T; row += stride) {
        float4 xn[8], fv[8];
#pragma unroll
        for (int i = 0; i < 8; ++i) fv[i] = *(const float4*)(FBUF + (size_t)row * D + i * 256 + F.lane * 4);
        const int nrow = row + stride;
        if (nrow < T) {
#pragma unroll
            for (int i = 0; i < 8; ++i) xn[i] = ld_bf4(B_T1(F) + (size_t)nrow * D + i * 256 + F.lane * 4); }
        else {
#pragma unroll
            for (int i = 0; i < 8; ++i) xn[i] = xv[i]; }
        int lo4 = F.lane * 4; asm volatile("" : "+v"(lo4));
        {
            float s0 = 0.f;
#pragma unroll
            for (int i = 0; i < 8; ++i) s0 += (xv[i].x + xv[i].y) + (xv[i].z + xv[i].w);
            const float mean0 = wsum(s0) * (1.f / 2048.f); float q0 = 0.f;
#pragma unroll
            for (int i = 0; i < 8; ++i) { const float a = xv[i].x - mean0, b = xv[i].y - mean0, c = xv[i].z - mean0, d = xv[i].w - mean0; q0 += (a * a + b * b) + (c * c + d * d); }
            const float rstd0 = rsqrtf(wsum(q0) * (1.f / 2048.f) + LN_EPS);
#pragma unroll
            for (int i = 0; i < 8; ++i) { const f32x4 g = *(const LAS f32x4*)(PL + i * 256 + lo4), bb = *(const LAS f32x4*)(PL + 2048 + i * 256 + lo4);
                xv[i].x = (xv[i].x - mean0) * rstd0 * g.x + bb.x; xv[i].y = (xv[i].y - mean0) * rstd0 * g.y + bb.y; xv[i].z = (xv[i].z - mean0) * rstd0 * g.z + bb.z; xv[i].w = (xv[i].w - mean0) * rstd0 * g.w + bb.w; }
        }
        float* xr = F.XA + (size_t)row * D;
        const int ci = cond_of(row);
        if (ci != cci) { const float* g2 = F.MOD + (size_t)(l * 9 + ci) * NADA + 5 * 2048; cci = ci;
#pragma unroll
            for (int i = 0; i < 8; ++i) g2v[i] = *(const float4*)(g2 + i * 256 + F.lane * 4); }
        float4 v[8]; float s = 0.f;
#pragma unroll
        for (int i = 0; i < 8; ++i) { const float4 x = xv[i], g = g2v[i], f = fv[i];
            v[i].x = ALPHA * x.x + g.x * f.x; v[i].y = ALPHA * x.y + g.y * f.y; v[i].z = ALPHA * x.z + g.z * f.z; v[i].w = ALPHA * x.w + g.w * f.w; s += (v[i].x + v[i].y) + (v[i].z + v[i].w); }
        float mean = wsum(s) * (1.f / 2048.f); float q = 0.f;
#pragma unroll
        for (int i = 0; i < 8; ++i) { const float a = v[i].x - mean, b = v[i].y - mean, c = v[i].z - mean, d = v[i].w - mean; q += (a * a + b * b) + (c * c + d * d); }
        float rstd = rsqrtf(wsum(q) * (1.f / 2048.f) + LN_EPS);
        s = 0.f;
#pragma unroll
        for (int i = 0; i < 8; ++i) { const int col = i * 256 + F.lane * 4; const f32x4 g = *(const LAS f32x4*)(PL + 4096 + i * 256 + lo4), bb = *(const LAS f32x4*)(PL + 6144 + i * 256 + lo4);
            v[i].x = (v[i].x - mean) * rstd * g.x + bb.x; v[i].y = (v[i].y - mean) * rstd * g.y + bb.y; v[i].z = (v[i].z - mean) * rstd * g.z + bb.z; v[i].w = (v[i].w - mean) * rstd * g.w + bb.w;
            *(float4*)(xr + col) = v[i]; s += (v[i].x + v[i].y) + (v[i].z + v[i].w); }
        if (l == 0) {
            const float* md = F.MOD + (size_t)(9 + ci) * NADA;
            float4 shn[8], scn[8];
#pragma unroll
            for (int i = 0; i < 8; ++i) { shn[i] = *(const float4*)(md + i * 256 + F.lane * 4); scn[i] = *(const float4*)(md + 2048 + i * 256 + F.lane * 4); }
            mean = wsum(s) * (1.f / 2048.f); q = 0.f;
#pragma unroll
            for (int i = 0; i < 8; ++i) { const float a = v[i].x - mean, b = v[i].y - mean, c = v[i].z - mean, d = v[i].w - mean; q += (a * a + b * b) + (c * c + d * d); }
            rstd = rsqrtf(wsum(q) * (1.f / 2048.f) + LN_EPS);
            float am = 0.f;
#pragma unroll
            for (int i = 0; i < 8; ++i) { const int col = i * 256 + F.lane * 4;
                const float4 sh = shn[i], sc = scn[i];
                float4 h; h.x = (v[i].x - mean) * rstd * (1.f + sc.x) + sh.x; h.y = (v[i].y - mean) * rstd * (1.f + sc.y) + sh.y; h.z = (v[i].z - mean) * rstd * (1.f + sc.z) + sh.z; h.w = (v[i].w - mean) * rstd * (1.f + sc.w) + sh.w;
                if (row < TCTX) { u32x2 o; o.x = cvt_pk_bf16(h.x, h.y); o.y = cvt_pk_bf16(h.z, h.w); *(u32x2*)(F.H + (size_t)row * D + col) = o; }
                v[i] = h; am = fmaxf(am, fmaxf(fmaxf(fabsf(h.x), fabsf(h.y)), fmaxf(fabsf(h.z), fabsf(h.w)))); }
            am = wmax(am);
            const float hs = am > 0.f ? am * (1.f / 127.f) : 1.f, hinv = 1.f / hs;
#pragma unroll
            for (int i = 0; i < 8; ++i) *(unsigned*)(F.ws + WS_H8IN + (size_t)row * D + i * 256 + F.lane * 4) = pack_i8(v[i].x * hinv, v[i].y * hinv, v[i].z * hinv, v[i].w * hinv);
            if (F.lane == 0) ((float*)(F.ws + WS_HSIN))[row] = hs;
        }
#pragma unroll
        for (int i = 0; i < 8; ++i) xv[i] = xn[i];
    }
}

constexpr int N_PHASES = 25;
__global__ void __launch_bounds__(512, 2) hybrid_fwd(Args args) {
    extern __shared__ __attribute__((aligned(16))) unsigned char lds_raw[];
    Frame0 F; F.lds = (LAS unsigned char*)lds_raw;
    const int lo = args.ph_lo, hi = args.ph_hi;
#if MK_ONE_LAUNCH
    volatile LAS unsigned* misc = (volatile LAS unsigned*)(F.lds + MISC_OFF);
    if (threadIdx.x < 16) misc[threadIdx.x] = 0u;
    __syncthreads();
    XcdBarrier bar = xcd_barrier_post((unsigned*)(args.ws + WS_BAR), misc);
#define SEAM(k) do { xcd_barrier(bar); } while (0)
#else
#define SEAM(k) do { } while (0)
#endif
#define NREP(k) ((args.rep == (k)) ? 2 : 1)
#ifndef PH_ONLY
#define PH_ONLY -1
#endif
#define IN(k) (lo <= (k) && (k) < hi && (PH_ONLY < 0 || ((k) == 0 ? 0 : ((k) - 1) % 12 + 1) == PH_ONLY))
    if (IN(0)) { for (int r = NREP(13); r > 0; --r) { phase_prologue(F); SEAM(0); } }
    for (int l = 0; l < 2; ++l) {
        const int pb = 1 + 12 * l;
        if (IN(pb + 0) && l == 0) { for (int r = NREP(1); r > 0; --r) { phase_lnmod(F, l); SEAM(pb + 0); } }
        if (IN(pb + 1)) { for (int r = NREP(2); r > 0; --r) { phase_gemm_in(F, l); SEAM(pb + 1); } }
        if (IN(pb + 2)) { for (int r = NREP(3); r > 0; --r) { phase_conv(F, l); SEAM(pb + 2); } }
        if (IN(pb + 3)) { phase_gemm_a(F, l); SEAM(pb + 3); }
        if (IN(pb + 4)) {
#ifndef NO_PREP
            for (int r = NREP(4); r > 0; --r) { phase_gla_prep(F, l); SEAM(pb + 4); }
#endif
#ifndef NO_SCAN
            for (int r = NREP(5); r > 0; --r) { phase_gla_scan(F, l); SEAM(pb + 4); }
#endif
        }
        if (IN(pb + 5)) { for (int r = NREP(6); r > 0; --r) { phase_postgla(F, l); SEAM(pb + 5); } }
        if (IN(pb + 6)) { phase_gemm_b(F, l); SEAM(pb + 6); }
        if (IN(pb + 7)) { phase_quant_y(F); SEAM(pb + 7); phase_gemm_o(F, l); SEAM(pb + 7); }
        if (IN(pb + 8)) { phase_ln2(F, l); conv_tables(F, l); SEAM(pb + 8); }
        if (IN(pb + 9)) { for (int r = NREP(10); r > 0; --r) { phase_gemm_pq(F, l); SEAM(pb + 9); } }
        if (IN(pb + 10)) { for (int r = NREP(11); r > 0; --r) { phase_peer_score(F, l); SEAM(pb + 10); } }
        if (IN(pb + 11)) {
            for (int r = NREP(20); r > 0; --r) { phase_peer_bucket(F); SEAM(pb + 11); }
            for (int r = NREP(21); r > 0; --r) { phase_peer_u(F, l); SEAM(pb + 11); }
            for (int r = NREP(22); r > 0; --r) { phase_peer_coef(F); SEAM(pb + 11); }
            phase_peer_pack(F); SEAM(pb + 11);
            for (int r = NREP(23); r > 0; --r) { phase_peer_v(F); SEAM(pb + 11); }
            phase_peer_final(F, l); SEAM(pb + 11); }
    }
#undef IN
#undef SEAM
}

extern "C" void kernel_launch(void* const* d_in, const int* in_sizes, int n_in, void* d_out, int out_size, void* d_ws, size_t ws_size, hipStream_t stream) {
    static int grid = 0;
    if (grid == 0) {
        if (n_in != 21 || ws_size < WS_END) { fprintf(stderr, "kernel_launch: unexpected inputs (n_in %d) or workspace %zu < %zu\n", n_in, ws_size, (size_t)WS_END); grid = -1; return; }
        int dev = 0, cus = 0, per_cu = 0;
        if (hipGetDevice(&dev) != hipSuccess || hipDeviceGetAttribute(&cus, hipDeviceAttributeMultiprocessorCount, dev) != hipSuccess) { grid = -1; return; }
        if (hipFuncSetAttribute((const void*)hybrid_fwd, hipFuncAttributeMaxDynamicSharedMemorySize, LDS_TOTAL) != hipSuccess) { fprintf(stderr, "kernel_launch: hipFuncSetAttribute failed\n"); grid = -1; return; }
        if (hipOccupancyMaxActiveBlocksPerMultiprocessor(&per_cu, (const void*)hybrid_fwd, 512, LDS_TOTAL) != hipSuccess || per_cu < 1) { fprintf(stderr, "kernel_launch: occupancy query says %d\n", per_cu); }
        (void)hipGetLastError();
        grid = cus;
    }
    if (grid < 0) return;
    (void)hipMemsetAsync((char*)d_ws + WS_BAR, 0, 16384, stream);
    Args a{};
    for (int i = 0; i < 21; ++i) a.in[i] = (const float*)d_in[i];
    a.out = (float*)d_out; a.ws = (unsigned char*)d_ws;
#ifndef PROBE_REP
#define PROBE_REP 0
#endif
    a.rep = PROBE_REP; a.pad = 0;
#if MK_ONE_LAUNCH
    a.ph_lo = 0; a.ph_hi = N_PHASES;
    hipLaunchKernelGGL(hybrid_fwd, dim3(grid), dim3(512), LDS_TOTAL, stream, a);
#else
    for (int p = 0; p < N_PHASES; ++p) { a.ph_lo = p; a.ph_hi = p + 1; hipLaunchKernelGGL(hybrid_fwd, dim3(grid), dim3(512), LDS_TOTAL, stream, a); }
#endif
}
```

```cpp
#include <hip/hip_runtime.h>
#include <cstdio>
#include <cstdint>

#ifndef STORE_POLICY
#define STORE_POLICY 1
#endif
#ifndef MK_ONE_LAUNCH
#define MK_ONE_LAUNCH 1
#endif

#define LAS __attribute__((address_space(3)))
typedef unsigned short bf16_t;
typedef short bf16x8 __attribute__((ext_vector_type(8)));
typedef float f32x4 __attribute__((ext_vector_type(4)));
typedef unsigned u32x4 __attribute__((ext_vector_type(4)));
typedef int i32x4 __attribute__((ext_vector_type(4)));
typedef unsigned u32x2 __attribute__((ext_vector_type(2)));
typedef __bf16 bf16x2_t __attribute__((ext_vector_type(2)));

constexpr int D = 2048, TCTX = 4096, TLAT = 32768, T = TCTX + TLAT;
constexpr int NINP = 13568;
constexpr int NADA = 12288;
constexpr float ALPHA = 1.41421356237f;
constexpr float LN_EPS = 1e-5f;
constexpr int LDS_TOTAL = 155648;
constexpr int MISC_OFF = LDS_TOTAL - 64;

constexpr size_t al256(size_t x) { return (x + 255) & ~(size_t)255; }
constexpr size_t WS_BAR = 0;
constexpr size_t WS_MOD = 16384;
constexpr size_t WS_WIN = WS_MOD + 1048576;
constexpr size_t WS_WA = WS_WIN + (size_t)2 * NINP * 2048 * 2;
constexpr size_t WS_WB = WS_WA + (size_t)2 * 2048 * 1024 * 2;
constexpr size_t WS_WO = WS_WB + (size_t)2 * 2048 * 2048 * 2;
constexpr size_t WS_WPQ = WS_WO + (size_t)2 * 2048 * 2048 * 2;
constexpr size_t WS_H = WS_WPQ + (size_t)2 * 2048 * 2048 * 2;
constexpr size_t WS_Z1 = WS_H + (size_t)T * 2048 * 2;
constexpr size_t WS_Z2 = WS_Z1 + (size_t)T * 3072 * 2;
constexpr size_t WS_Z3 = WS_Z2 + (size_t)T * 4096 * 2;
constexpr size_t WS_Z4 = WS_Z3 + (size_t)T * 2048 * 2;
constexpr size_t WS_U16 = WS_Z4;
constexpr size_t WS_V8 = WS_U16 + (size_t)16384 * 2048 * 2;
constexpr size_t WS_VS = WS_V8 + (size_t)16384 * 2048;
constexpr size_t WS_Z5 = WS_Z4 + (size_t)T * 4096 * 2;
constexpr size_t WS_END0 = WS_Z5 + (size_t)T * 32 * 4;
constexpr size_t WS_H8IN = al256(WS_END0);
constexpr size_t WS_W8IN = WS_H8IN + (size_t)T * 2048;
constexpr size_t WS_CSIN = WS_W8IN + (size_t)2 * NINP * 2048;
constexpr size_t WS_HSIN = WS_CSIN + (size_t)2 * NINP * 4;
constexpr size_t WS_ASIN = WS_HSIN + (size_t)T * 4;
constexpr size_t WS_YS = WS_ASIN + (size_t)T * 4;
constexpr size_t WS_END = WS_YS + (size_t)T * 4;

__device__ __forceinline__ unsigned cvt_pk_bf16(float lo, float hi) { unsigned r; asm("v_cvt_pk_bf16_f32 %0, %1, %2" : "=v"(r) : "v"(lo), "v"(hi)); return r; }
__device__ __forceinline__ bf16_t f2bf(float x) { return (bf16_t)(cvt_pk_bf16(x, 0.f) & 0xffffu); }
__device__ __forceinline__ float bf_lo(unsigned w) { return __uint_as_float(w << 16); }
__device__ __forceinline__ float bf_hi(unsigned w) { return __uint_as_float(w & 0xffff0000u); }
__device__ __forceinline__ float bf1(bf16_t u) { return __uint_as_float((unsigned)u << 16); }
__device__ __forceinline__ float wmax(float v) {
#pragma unroll
    for (int sh = 32; sh >= 1; sh >>= 1) v = fmaxf(v, __shfl_xor(v, sh));
    return v; }
__device__ __forceinline__ unsigned pack_i8(float a, float b, float c, float d) { const int q0 = __float2int_rn(a), q1 = __float2int_rn(b), q2 = __float2int_rn(c), q3 = __float2int_rn(d);
    return ((unsigned)q0 & 255u) | (((unsigned)q1 & 255u) << 8) | (((unsigned)q2 & 255u) << 16) | ((unsigned)q3 << 24); }
__device__ __forceinline__ float wsum(float v) {
#pragma unroll
    for (int m = 32; m >= 1; m >>= 1) v += __shfl_xor(v, m);
    return v;
}
__device__ __forceinline__ float sigmoidf_(float x) { return __builtin_amdgcn_rcpf(1.f + __expf(-x)); }
__device__ __forceinline__ float siluf_(float x) { return x * sigmoidf_(x); }
__device__ __forceinline__ float gelu_tanh(float x) {
    const float y = 0.7978845608028654f * (x + 0.044715f * x * x * x);
    const float e = __expf(2.f * y);
    const float th = 1.f - 2.f * __builtin_amdgcn_rcpf(e + 1.f);
    return 0.5f * x * (1.f + th);
}
__device__ __forceinline__ float dot2bf(unsigned a, unsigned b, float acc) { return __builtin_amdgcn_fdot2_f32_bf16(__builtin_bit_cast(bf16x2_t, a), __builtin_bit_cast(bf16x2_t, b), acc, false); }

#define XB_TMO      128
#define XB_XCNT(j)  (256  + 64 * (j))
#define XB_XSUB(j)  (1280 + 64 * (j))
#define XB_XGEN(j)  (2304 + 64 * (j))
#define XB_TOP      3328
#define XB_TOPGEN   3392
#define XCD_BAR_WORDS 3456
#define XB_SPIN_CAP (1u << 18)
__device__ __forceinline__ unsigned xb_ld(unsigned* p)              { return __hip_atomic_load(p, __ATOMIC_RELAXED, __HIP_MEMORY_SCOPE_AGENT); }
__device__ __forceinline__ unsigned xb_add(unsigned* p, unsigned v) { return __hip_atomic_fetch_add(p, v, __ATOMIC_RELAXED, __HIP_MEMORY_SCOPE_AGENT); }
__device__ __forceinline__ unsigned xb_xcc_id() { return (unsigned)__builtin_amdgcn_s_getreg((3 << 11) | 20) & 0xFu; }
#define XB_SPIN(cond, bar) do { unsigned _sp = 0; while (cond) { __builtin_amdgcn_s_sleep(1); \
    if ((++_sp & 255u) == 0u) { if (xb_ld(&(bar)[XB_TMO])) break; if (_sp > XB_SPIN_CAP) { atomicAdd(&(bar)[XB_TMO], 1u); break; } } } } while (0)
struct XcdBarrier { unsigned* bar; unsigned x; volatile LAS unsigned* st; };
__device__ __forceinline__ XcdBarrier xcd_barrier_post(unsigned* bar, volatile LAS unsigned* st) {
    XcdBarrier b; b.bar = bar; b.x = xb_xcc_id(); b.st = st;
    if (threadIdx.x == 0) (void)xb_add(&bar[XB_XCNT(b.x)], 1u);
    return b;
}
__device__ __forceinline__ void xcd_barrier_complete(unsigned* bar, unsigned x, unsigned& nloc, unsigned& nx) {
    const unsigned G = gridDim.x * gridDim.y * gridDim.z;
    unsigned sum, cnt, mine, sp = 0u;
    for (;;) {
        sum = 0u; cnt = 0u; mine = 0u;
#pragma unroll
        for (unsigned j = 0; j < 16; ++j) { const unsigned c = xb_ld(&bar[XB_XCNT(j)]); sum += c; cnt += (c > 0u) ? 1u : 0u; mine = (j == x) ? c : mine; }
        if (sum == G) break;
        __builtin_amdgcn_s_sleep(1);
        if ((++sp & 255u) == 0u) { if (xb_ld(&bar[XB_TMO])) break; if (sp > XB_SPIN_CAP) { atomicAdd(&bar[XB_TMO], 1u); break; } }
    }
    nloc = mine > 0u ? mine : 1u; nx = cnt > 0u ? cnt : 1u;
}
__device__ __forceinline__ void xcd_barrier(const XcdBarrier& b) {
    asm volatile("s_waitcnt vmcnt(0)" ::: "memory");
    __syncthreads();
    if (threadIdx.x == 0) {
        unsigned* bar = b.bar;
        __builtin_amdgcn_s_waitcnt(0);
        unsigned nloc = b.st[0], nx = b.st[1];
        if (nloc == 0u) { xcd_barrier_complete(bar, b.x, nloc, nx); b.st[0] = nloc; b.st[1] = nx; }
        const unsigned old = xb_add(&bar[XB_XSUB(b.x)], 1u);
        const unsigned gen = old / nloc;
        if (old + 1u == (gen + 1u) * nloc) {
            __builtin_amdgcn_fence(__ATOMIC_RELEASE, "agent");
            asm volatile("s_waitcnt vmcnt(0)" ::: "memory");
            const unsigned og = xb_add(&bar[XB_TOP], 1u);
            const unsigned tg = og / nx;
            if (og + 1u == (tg + 1u) * nx) xb_add(&bar[XB_TOPGEN], 1u);
            else XB_SPIN(xb_ld(&bar[XB_TOPGEN]) == tg, bar);
            __builtin_amdgcn_fence(__ATOMIC_ACQUIRE, "agent");
            xb_add(&bar[XB_XGEN(b.x)], 1u);
            asm volatile("s_waitcnt vmcnt(0)" ::: "memory");
        } else {
            XB_SPIN(xb_ld(&bar[XB_XGEN(b.x)]) == gen, bar);
            __builtin_amdgcn_fence(__ATOMIC_ACQUIRE, "agent");
            asm volatile("s_waitcnt vmcnt(0)" ::: "memory");
        }
    }
    __syncthreads();
}

namespace pg8 {
#define PG8_LAS __attribute__((address_space(3)))
constexpr int BM = 256, BK = 64, HALF = 128, HTB = HALF * BK * 2, STAGE_BYTES = 8 * HTB, NXCD = 8, WGM = 8;
__host__ __device__ __forceinline__ int lds_byte(int r, int c) { const int st = (r >> 4) * 2 + (c >> 5), rr = r & 15, cc = c & 31, ob = rr * 64 + cc * 2; return st * 1024 + (ob ^ (((ob >> 9) & 1) << 5)); }
__host__ __device__ __forceinline__ void stage_rc(int b, int& R, int& C) { const int st = b / 1024, sb = b % 1024, swz = sb ^ (((sb >> 9) & 1) << 5); R = (st >> 1) * 16 + swz / 64; C = (st & 1) * 32 + (swz % 64) / 2; }
__host__ __device__ __forceinline__ int perm32(int rho) { const int n = rho >> 4, i = rho & 15; return 8 * (i >> 2) + 4 * n + (i & 3); }
struct Unit { int pm, pn; };
struct Gemm { const bf16_t* A; const bf16_t* Bt; int M, N, K; };
struct StaticOrder {
    int nM, nN, nwg, G, c;
    __host__ __device__ void init(int M, int N, int G_, int c_) { nM = M / BM; nN = N / BM; nwg = nM * nN; G = G_; c = c_; }
    __host__ __device__ bool next(int i, Unit& u) const {
        const long L = (long)i * G + c; if (L >= nwg) return false;
        int wgid = (int)L; { const int q = nwg / NXCD, r = nwg % NXCD, xcd = wgid % NXCD, off = wgid / NXCD; wgid = (xcd < r ? xcd * (q + 1) : r * (q + 1) + (xcd - r) * q) + off; }
        const int nig = WGM * nN, gid = wgid / nig, fm = gid * WGM, gsz = (nM - fm) < WGM ? (nM - fm) : WGM;
        u.pm = fm + ((wgid % nig) % gsz); u.pn = (wgid % nig) / gsz; return true;
    }
    __device__ __forceinline__ void a_ready(const Unit&) const {}
    __device__ __forceinline__ void done(const Unit&) const {}
};

template <bool I8> struct AccT { typedef f32x4 type; };
template <> struct AccT<true> { typedef i32x4 type; };
template <class Epi, class Sched, bool ALIGN_EPI = false, bool SP2 = false, bool I8 = false>
__device__ __forceinline__ void gemm_phase(PG8_LAS unsigned char* lds, const Gemm g, const Sched& S, const Epi& E) {
    int tid_ = threadIdx.x; asm volatile("" : "+v"(tid_));
    const int tid = tid_, wid = __builtin_amdgcn_readfirstlane(tid >> 6), lane = tid & 63, wr = wid >> 2, wc = wid & 3, fr = lane & 15, fq = lane >> 4;
    const int K = g.K, nt = I8 ? K / (2 * BK) : K / BK; const unsigned KB = I8 ? (unsigned)K : 2u * (unsigned)K;
    typedef typename AccT<I8>::type acc_t;
    unsigned voffA[2], voffB[2];
#pragma unroll
    for (int i = 0; i < 2; ++i) { int R, C; stage_rc(tid * 16 + i * 8192, R, C); const int Rb = 64 * (R >> 5) + (Epi::PERM ? perm32(R & 31) : (R & 31));
        voffA[i] = (unsigned)R * KB + (unsigned)C * 2u; voffB[i] = (unsigned)Rb * KB + (unsigned)C * 2u; }
    const size_t kstep = (size_t)(BK * 2);
    const size_t hstep = (size_t)HALF * KB;
    const size_t hstepB = (size_t)32 * KB;
    const size_t tstep = 2 * hstep;
    const unsigned ldsw = (unsigned)wid * 1024u;
    const int aoff = lds_byte(wr * 64 + fr, fq * 8), boff = lds_byte(wc * 32 + fr, fq * 8);
#define PG8_SA(b, h) (((b) * 2 + (h)) * HTB)
#define PG8_SB(b, h) ((4 + (b) * 2 + (h)) * HTB)
#define PG8_STAGE(bufoff, gbase, voff) do { _Pragma("unroll") for (int _i = 0; _i < 2; ++_i) \
        __builtin_amdgcn_global_load_lds((const unsigned*)((const char*)(gbase) + (voff)[_i]), (PG8_LAS unsigned*)(lds + (bufoff) + ldsw + _i * 8192), 16, 0, 0); } while (0)
#define PG8_LDA(dst, b, h) do { _Pragma("unroll") for (int m = 0; m < 4; ++m) _Pragma("unroll") for (int k = 0; k < 2; ++k) dst[m][k] = *(const PG8_LAS bf16x8*)(lds + PG8_SA(b, h) + aoff + m * 2048 + k * 1024); } while (0)
#define PG8_LDB(dst, b, h) do { _Pragma("unroll") for (int n = 0; n < 2; ++n) _Pragma("unroll") for (int k = 0; k < 2; ++k) dst[n][k] = *(const PG8_LAS bf16x8*)(lds + PG8_SB(b, h) + boff + n * 2048 + k * 1024); } while (0)
#define PG8_MMA(ai, bj, At, Bt) do { __builtin_amdgcn_s_setprio(1); _Pragma("unroll") for (int m = 0; m < 4; ++m) _Pragma("unroll") for (int n = 0; n < 2; ++n) _Pragma("unroll") for (int k = 0; k < 2; ++k) \
        { if constexpr (I8) acc[ai][bj][m][n] = __builtin_amdgcn_mfma_i32_16x16x64_i8(__builtin_bit_cast(i32x4, Bt[n][k]), __builtin_bit_cast(i32x4, At[m][k]), acc[ai][bj][m][n], 0, 0, 0); \
          else acc[ai][bj][m][n] = __builtin_amdgcn_mfma_f32_16x16x32_bf16(Bt[n][k], At[m][k], acc[ai][bj][m][n], 0, 0, 0); } __builtin_amdgcn_s_setprio(0); } while (0)
#define PG8_WAIT_V(n) asm volatile("s_waitcnt vmcnt(" #n ")" ::: "memory")
#define PG8_WAIT_L(n) asm volatile("s_waitcnt lgkmcnt(" #n ")" ::: "memory")
#define PG8_BAR __builtin_amdgcn_s_barrier()
#define PG8_SCHED __builtin_amdgcn_sched_barrier(0)
    Unit cur, nxt; int ui = 0;
    if (!S.next(0, cur)) return;
    acc_t acc[2][2][4][2];
#pragma unroll
    for (int a = 0; a < 2; ++a)
#pragma unroll
        for (int b = 0; b < 2; ++b)
#pragma unroll
            for (int m = 0; m < 4; ++m)
#pragma unroll
                for (int n = 0; n < 2; ++n) acc[a][b][m][n] = (acc_t){0, 0, 0, 0};
    bf16x8 At[4][2], B0[2][2], B1[2][2];
    const char* cA = (const char*)g.A + (size_t)cur.pm * tstep; const char* cB = (const char*)g.Bt + (size_t)cur.pn * tstep;
    S.a_ready(cur);
    if constexpr (SP2) {
        PG8_STAGE(PG8_SB(0, 0), cB, voffB); PG8_STAGE(PG8_SB(0, 1), cB + hstepB, voffB); PG8_STAGE(PG8_SA(0, 0), cA, voffA); PG8_STAGE(PG8_SA(0, 1), cA + hstep, voffA);
        if (wr == 1) PG8_BAR;
        PG8_WAIT_V(2); PG8_BAR;
        PG8_STAGE(PG8_SB(1, 0), cB + kstep, voffB); PG8_STAGE(PG8_SA(1, 0), cA + kstep, voffA); PG8_STAGE(PG8_SB(1, 1), cB + hstepB + kstep, voffB);
        PG8_WAIT_V(6); PG8_BAR;
    } else {
        PG8_STAGE(PG8_SB(0, 0), cB, voffB); PG8_STAGE(PG8_SA(0, 0), cA, voffA); PG8_STAGE(PG8_SB(0, 1), cB + hstepB, voffB); PG8_STAGE(PG8_SA(0, 1), cA + hstep, voffA);
        if (wr == 1) PG8_BAR;
        PG8_WAIT_V(4); PG8_BAR;
        PG8_STAGE(PG8_SB(1, 0), cB + kstep, voffB); PG8_STAGE(PG8_SA(1, 0), cA + kstep, voffA); PG8_STAGE(PG8_SB(1, 1), cB + hstepB + kstep, voffB);
        PG8_WAIT_V(6); PG8_BAR;
    }
    for (;;) {
        const bool has_next = S.next(ui + 1, nxt);
        const char* nA = has_next ? (const char*)g.A + (size_t)nxt.pm * tstep : cA; const char* nB = has_next ? (const char*)g.Bt + (size_t)nxt.pn * tstep : cB;
        for (int t = 0; t < nt; t += 2) {
            const bool last = (t == nt - 2);
            const char* a1 = cA + (size_t)(t + 1) * kstep;
            const char* a2 = last ? nA : cA + (size_t)(t + 2) * kstep; const char* b2 = last ? nB : cB + (size_t)(t + 2) * kstep;
            const char* a3 = a2 + kstep; const char* b3 = b2 + kstep;
            if (last && has_next) S.a_ready(nxt);
            if constexpr (SP2) {
            PG8_LDB(B0, 0, 0); PG8_LDB(B1, 0, 1); PG8_SCHED; PG8_LDA(At, 0, 0); PG8_STAGE(PG8_SA(1, 1), a1 + hstep, voffA);
            PG8_WAIT_V(8); PG8_WAIT_L(0); PG8_BAR; PG8_MMA(0, 0, At, B0); PG8_MMA(0, 1, At, B1); PG8_BAR; PG8_SCHED;
            PG8_LDA(At, 0, 1); PG8_STAGE(PG8_SB(0, 0), b2, voffB); PG8_STAGE(PG8_SB(0, 1), b2 + hstepB, voffB); PG8_STAGE(PG8_SA(0, 0), a2, voffA);
            PG8_WAIT_V(8); PG8_WAIT_L(0); PG8_BAR; PG8_MMA(1, 0, At, B0); PG8_MMA(1, 1, At, B1); PG8_BAR; PG8_SCHED;
            PG8_LDB(B0, 1, 0); PG8_LDB(B1, 1, 1); PG8_SCHED; PG8_LDA(At, 1, 0); PG8_STAGE(PG8_SA(0, 1), a2 + hstep, voffA);
            PG8_WAIT_V(8); PG8_WAIT_L(0); PG8_BAR; PG8_MMA(0, 0, At, B0); PG8_MMA(0, 1, At, B1); PG8_BAR; PG8_SCHED;
            PG8_LDA(At, 1, 1); PG8_STAGE(PG8_SB(1, 0), b3, voffB); PG8_STAGE(PG8_SB(1, 1), b3 + hstepB, voffB); PG8_STAGE(PG8_SA(1, 0), a3, voffA);
            PG8_WAIT_V(8); PG8_WAIT_L(0); PG8_BAR; PG8_MMA(1, 0, At, B0); PG8_MMA(1, 1, At, B1); PG8_BAR; PG8_SCHED;
            } else {
            PG8_LDB(B0, 0, 0); PG8_SCHED; PG8_LDA(At, 0, 0); PG8_STAGE(PG8_SA(1, 1), a1 + hstep, voffA);
            PG8_WAIT_L(8); PG8_BAR; PG8_WAIT_L(0); PG8_MMA(0, 0, At, B0); PG8_BAR; PG8_SCHED;
            PG8_LDB(B1, 0, 1); PG8_STAGE(PG8_SB(0, 0), b2, voffB);
            PG8_BAR; PG8_WAIT_L(0); PG8_MMA(0, 1, At, B1); PG8_BAR;
            PG8_LDA(At, 0, 1); PG8_STAGE(PG8_SA(0, 0), a2, voffA);
            PG8_BAR; PG8_WAIT_L(0); PG8_MMA(1, 0, At, B0); PG8_BAR; PG8_SCHED;
            PG8_STAGE(PG8_SB(0, 1), b2 + hstepB, voffB);
            PG8_WAIT_V(6); PG8_BAR; PG8_MMA(1, 1, At, B1); PG8_BAR;
            PG8_LDB(B0, 1, 0); PG8_SCHED; PG8_LDA(At, 1, 0); PG8_STAGE(PG8_SA(0, 1), a2 + hstep, voffA);
            PG8_WAIT_L(8); PG8_BAR; PG8_WAIT_L(0); PG8_MMA(0, 0, At, B0); PG8_BAR; PG8_SCHED;
            PG8_LDB(B1, 1, 1); PG8_STAGE(PG8_SB(1, 0), b3, voffB);
            PG8_BAR; PG8_WAIT_L(0); PG8_MMA(0, 1, At, B1); PG8_BAR;
            PG8_LDA(At, 1, 1); PG8_STAGE(PG8_SA(1, 0), a3, voffA);
            PG8_BAR; PG8_WAIT_L(0); PG8_MMA(1, 0, At, B0); PG8_BAR; PG8_SCHED;
            PG8_STAGE(PG8_SB(1, 1), b3 + hstepB, voffB);
            PG8_WAIT_V(6); PG8_BAR; PG8_MMA(1, 1, At, B1); PG8_BAR;
            }
        }
        if constexpr (ALIGN_EPI) { if (wr == 0) PG8_BAR; }
        E(acc, cur, wr, wc, fr, fq); S.done(cur);
        if (!has_next) break;
#pragma unroll
        for (int a = 0; a < 2; ++a)
#pragma unroll
            for (int b = 0; b < 2; ++b)
#pragma unroll
                for (int m = 0; m < 4; ++m)
#pragma unroll
                    for (int n = 0; n < 2; ++n) acc[a][b][m][n] = (acc_t){0, 0, 0, 0};
        cur = nxt; cA = nA; cB = nB; ++ui;
        if constexpr (ALIGN_EPI) { if (wr == 1) PG8_BAR; }
    }
    PG8_WAIT_V(0);
    if constexpr (!ALIGN_EPI) { if (wr == 0) PG8_BAR; }
    PG8_BAR;
#undef PG8_SA
#undef PG8_SB
#undef PG8_STAGE
#undef PG8_LDA
#undef PG8_LDB
#undef PG8_MMA
#undef PG8_WAIT_V
#undef PG8_WAIT_L
#undef PG8_BAR
#undef PG8_SCHED
}
}

struct Args { const float* in[21]; float* out; unsigned char* ws; int ph_lo, ph_hi, rep, pad; };
struct Frame0 { LAS unsigned char* lds; };
struct Frame {
    LAS unsigned char* lds; int tid, lane, wave, bid, nb;
    const float *x_prompt, *x_sample, *state, *cvec, *cctx, *w_in, *w_conv, *w_a, *w_gk, *b_gk, *w_gn, *w_b, *w_o, *w_ada, *b_ada, *ln_g, *ln_b, *w_pq, *pkeys, *peer_u, *peer_v;
    float* out; unsigned char* ws;
    float* MOD; bf16_t *WIN, *WA, *WB, *WO, *WPQ, *U16; unsigned char* V8; float* VS; float* XA; bf16_t *H, *Z1, *Z2, *Z3, *Z4; float* Z5;
};
typedef const __attribute__((address_space(4))) Args* KArgs;
__device__ __forceinline__ void fill_frame(Frame& F, const Frame0& F0) {
    auto kp = __builtin_amdgcn_kernarg_segment_ptr();
    asm volatile("" : "+s"(kp));
    KArgs A = (KArgs)kp;
    int t_ = threadIdx.x; asm volatile("" : "+v"(t_));
    F.lds = F0.lds; F.tid = t_; F.lane = t_ & 63; F.wave = __builtin_amdgcn_readfirstlane(t_ >> 6); F.bid = blockIdx.x; F.nb = gridDim.x;
    F.x_prompt = A->in[0]; F.x_sample = A->in[1]; F.state = A->in[2]; F.cvec = A->in[3]; F.cctx = A->in[4]; F.w_in = A->in[5]; F.w_conv = A->in[6]; F.w_a = A->in[7];
    F.w_gk = A->in[8]; F.b_gk = A->in[9]; F.w_gn = A->in[10]; F.w_b = A->in[11]; F.w_o = A->in[12]; F.w_ada = A->in[13]; F.b_ada = A->in[14]; F.ln_g = A->in[15]; F.ln_b = A->in[16];
    F.w_pq = A->in[17]; F.pkeys = A->in[18]; F.peer_u = A->in[19]; F.peer_v = A->in[20];
    F.out = A->out; unsigned char* ws = A->ws; F.ws = ws;
    F.MOD = (float*)(ws + WS_MOD); F.WIN = (bf16_t*)(ws + WS_WIN); F.WA = (bf16_t*)(ws + WS_WA); F.WB = (bf16_t*)(ws + WS_WB); F.WO = (bf16_t*)(ws + WS_WO); F.WPQ = (bf16_t*)(ws + WS_WPQ);
    F.U16 = (bf16_t*)(ws + WS_U16); F.V8 = ws + WS_V8; F.VS = (float*)(ws + WS_VS); F.XA = A->out; F.H = (bf16_t*)(ws + WS_H);
    F.Z1 = (bf16_t*)(ws + WS_Z1); F.Z2 = (bf16_t*)(ws + WS_Z2); F.Z3 = (bf16_t*)(ws + WS_Z3); F.Z4 = (bf16_t*)(ws + WS_Z4); F.Z5 = (float*)(ws + WS_Z5);
}
#define PHASE_IDS(F0_) Frame F; fill_frame(F, F0_)
__device__ __forceinline__ const float* xrow_in(const Frame& F, int l, int row) {
    if (l == 0) return row < TCTX ? F.x_prompt + (size_t)row * D : F.x_sample + (size_t)(row - TCTX) * D;
    return F.out + (size_t)row * D;
}
__device__ __forceinline__ int cond_of(int row) { return row < TCTX ? 8 : ((row - TCTX) >> 12); }

__device__ __forceinline__ void phase_mod(const Frame0& F0) {
    PHASE_IDS(F0);
    LAS float* sl = (LAS float*)F.lds;
    LAS float* red = (LAS float*)(F.lds + 73728);
    for (int i = F.tid; i < 9 * 2048; i += 512) { const int ci = i >> 11, dd = i & 2047; const float c = ci < 8 ? F.cvec[ci * 2048 + dd] : F.cctx[dd]; sl[i] = siluf_(c); }
    __syncthreads();
    const int cg = F.tid & 15, ks = F.tid >> 4;
    for (int u = F.bid; u < 2 * 192; u += F.nb) {
        const int l = u / 192, c0 = (u % 192) * 64;
        float acc[9][4];
#pragma unroll
        for (int ci = 0; ci < 9; ++ci)
#pragma unroll
            for (int j = 0; j < 4; ++j) acc[ci][j] = 0.f;
        const float* wp = F.w_ada + ((size_t)l * 2048 + ks * 64) * NADA + c0 + cg * 4;
#pragma unroll 4
        for (int r = 0; r < 64; ++r) {
            const float4 w = *(const float4*)(wp + (size_t)r * NADA);
#pragma unroll
            for (int ci = 0; ci < 9; ++ci) { const float s = sl[ci * 2048 + ks * 64 + r]; acc[ci][0] += s * w.x; acc[ci][1] += s * w.y; acc[ci][2] += s * w.z; acc[ci][3] += s * w.w; }
        }
#pragma unroll
        for (int ci = 0; ci < 9; ++ci)
#pragma unroll
            for (int j = 0; j < 4; ++j) { float v = acc[ci][j]; v += __shfl_xor(v, 16); v += __shfl_xor(v, 32); acc[ci][j] = v; }
        if (F.lane < 16) {
#pragma unroll
            for (int ci = 0; ci < 9; ++ci)
#pragma unroll
                for (int j = 0; j < 4; ++j) red[(F.wave * 9 + ci) * 64 + cg * 4 + j] = acc[ci][j];
        }
        __syncthreads();
        for (int i = F.tid; i < 576; i += 512) { const int ci = i >> 6, c = i & 63; float s = 0.f;
#pragma unroll
            for (int w = 0; w < 8; ++w) s += red[(w * 9 + ci) * 64 + c];
            F.MOD[(size_t)(l * 9 + ci) * NADA + c0 + c] = s + F.b_ada[l * NADA + c0 + c]; }
        __syncthreads();
    }
}
template <class Map>
__device__ __forceinline__ void tr_convert(const Frame0& F0, const float* src, int ldsrc, bf16_t* dst, int K, int N, Map map) {
    PHASE_IDS(F0);
    LAS bf16_t* tile = (LAS bf16_t*)F.lds;
    const int ntn = N / 64, ntk = K / 256;
    for (int u = F.bid; u < ntn * ntk; u += F.nb) {
        const int n0 = (u / ntk) * 64, k0 = (u % ntk) * 256;
        const int nn = F.tid & 63, kq = F.tid >> 6;
        const int sc = map(n0 + nn);
        float vals[32];
#pragma unroll
        for (int i = 0; i < 32; ++i) { const int kk = i * 8 + kq; vals[i] = sc >= 0 ? src[(size_t)(k0 + kk) * ldsrc + sc] : 0.f; }
#pragma unroll
        for (int i = 0; i < 32; ++i) tile[nn * 258 + i * 8 + kq] = f2bf(vals[i]);
        __syncthreads();
#pragma unroll
        for (int i = 0; i < 4; ++i) { const int id = F.tid + 512 * i, r = id >> 5, kc = id & 31; const LAS unsigned* p = (const LAS unsigned*)(tile + r * 258 + kc * 8);
            uint4 o; o.x = p[0]; o.y = p[1]; o.z = p[2]; o.w = p[3];
            *(uint4*)(dst + (size_t)(n0 + r) * K + k0 + kc * 8) = o; }
        __syncthreads();
    }
}
template <class Map>
__device__ __forceinline__ void tr_strip8(const Frame& F, const float* src, int ldsrc, unsigned char* dst, float* scales, int K, int n0, Map map) {
    LAS unsigned char* tile = (LAS unsigned char*)F.lds;
    LAS float* red = (LAS float*)(F.lds + 64 * 272);
    const int nn = F.tid & 63, kq = F.tid >> 6;
    const int sc = map(n0 + nn);
    float m = 0.f;
    for (int i0 = 0; i0 < K / 8; i0 += 64) {
        float vals[64];
#pragma unroll
        for (int i = 0; i < 64; ++i) vals[i] = sc >= 0 ? src[(size_t)((i0 + i) * 8 + kq) * ldsrc + sc] : 0.f;
#pragma unroll
        for (int i = 0; i < 64; ++i) m = fmaxf(m, fabsf(vals[i]));
    }
    __syncthreads();
    red[kq * 64 + nn] = m;
    __syncthreads();
    if (F.tid < 64) { float mm = 0.f;
#pragma unroll
        for (int q = 0; q < 8; ++q) mm = fmaxf(mm, red[q * 64 + F.tid]);
        const float scl = mm > 0.f ? mm * (1.f / 127.f) : 1.f; scales[n0 + F.tid] = scl; red[512 + F.tid] = 1.f / scl; }
    __syncthreads();
    const float inv = red[512 + nn];
    for (int k0 = 0; k0 < K; k0 += 256) {
        float vals[32];
#pragma unroll
        for (int i = 0; i < 32; ++i) vals[i] = sc >= 0 ? src[(size_t)(k0 + i * 8 + kq) * ldsrc + sc] : 0.f;
#pragma unroll
        for (int i = 0; i < 32; ++i) tile[nn * 272 + i * 8 + kq] = (unsigned char)(__float2int_rn(vals[i] * inv) & 255);
        __syncthreads();
#pragma unroll
        for (int i = 0; i < 2; ++i) { const int id = F.tid + 512 * i, r = id >> 4, kc = id & 15; const u32x4 o = *(const LAS u32x4*)(tile + r * 272 + kc * 16);
            *(u32x4*)(dst + (size_t)(n0 + r) * K + k0 + kc * 16) = o; }
        __syncthreads();
    }
}
struct MapId { __device__ __forceinline__ int operator()(int n) const { return n; } };
struct MapInOff { int off; __device__ __forceinline__ int operator()(int n) const { n += off; return n < 9216 ? n : (n < 13312 ? n + 32 : (n < 13344 ? n - 13312 + 9216 : -1)); } };
struct MapIn { __device__ __forceinline__ int operator()(int n) const { return n < 9216 ? n : (n < 13312 ? n + 32 : (n < 13344 ? n - 13312 + 9216 : -1)); } };
__device__ __forceinline__ void conv_tables(const Frame0& F0, int l) {
    PHASE_IDS(F0);
    for (int e = F.bid * 8 + F.wave; e < 16384; e += F.nb * 8) {
        const float* s = F.peer_v + ((size_t)l * 16384 + e) * 2048;
        float4 v[8]; float m = 0.f;
#pragma unroll
        for (int i = 0; i < 8; ++i) { v[i] = *(const float4*)(s + i * 256 + F.lane * 4); m = fmaxf(m, fmaxf(fmaxf(fabsf(v[i].x), fabsf(v[i].y)), fmaxf(fabsf(v[i].z), fabsf(v[i].w)))); }
#pragma unroll
        for (int sh = 32; sh >= 1; sh >>= 1) m = fmaxf(m, __shfl_xor(m, sh));
        const float sc = m > 0.f ? m * (1.f / 127.f) : 1.f, inv = 1.f / sc;
#pragma unroll
        for (int i = 0; i < 8; ++i) *(unsigned*)(F.V8 + (size_t)e * 2048 + i * 256 + F.lane * 4) = pack_i8(v[i].x * inv, v[i].y * inv, v[i].z * inv, v[i].w * inv);
        if (F.lane == 0) F.VS[e] = sc;
    }
    for (int e = F.bid * 8 + F.wave; e < 16384; e += F.nb * 8) {
        const float* s = F.peer_u + ((size_t)l * 16384 + e) * 2048;
        float m = 0.f;
#pragma unroll
        for (int i = 0; i < 8; ++i) { const float4 v = *(const float4*)(s + i * 256 + F.lane * 4); m = fmaxf(m, fmaxf(fmaxf(fabsf(v.x), fabsf(v.y)), fmaxf(fabsf(v.z), fabsf(v.w)))); }
        m = wmax(m);
        if (F.lane == 0) F.VS[16384 + e] = m > 0.f ? m * (1.f / 127.f) : 1.f;
    }
}
__device__ __forceinline__ void phase_prologue(const Frame0& F0) {
    phase_mod(F0);
    {
        PHASE_IDS(F0);
        for (int sidx = F.bid; sidx < 2 * 340; sidx += F.nb) {
            const int l = sidx / 340, r = sidx % 340;
            if (r < 212) tr_strip8(F, F.w_in + (size_t)l * 2048 * 13344, 13344, F.ws + WS_W8IN + (size_t)l * NINP * 2048, (float*)(F.ws + WS_CSIN) + (size_t)l * NINP, 2048, r * 64, MapIn());
            else if (r < 244) tr_strip8(F, F.w_b + (size_t)l * 2048 * 2048, 2048, (unsigned char*)F.WB + (size_t)l * 2048 * 2048, (float*)((unsigned char*)F.WB + (size_t)2 * 2048 * 2048) + l * 2048, 2048, (r - 212) * 64, MapId());
            else if (r < 276) tr_strip8(F, F.w_pq + (size_t)l * 2048 * 2048, 2048, (unsigned char*)F.WPQ + (size_t)l * 2048 * 2048, (float*)((unsigned char*)F.WPQ + (size_t)2 * 2048 * 2048) + l * 2048, 2048, (r - 244) * 64, MapId());
            else if (r >= 308) tr_strip8(F, F.w_o + (size_t)l * 2048 * 2048, 2048, (unsigned char*)F.WO + (size_t)l * 2048 * 2048, (float*)((unsigned char*)F.WO + (size_t)2 * 2048 * 2048) + l * 2048, 2048, (r - 308) * 64, MapId());
            else tr_strip8(F, F.w_a + (size_t)l * 1024 * 2048, 2048, (unsigned char*)F.WA + (size_t)l * 2048 * 1024, (float*)((unsigned char*)F.WA + (size_t)2 * 2048 * 1024) + l * 2048, 1024, (r - 276) * 64, MapId());
        }
    }
    for (int l = 0; l < 2; ++l) {
        Frame P; fill_frame(P, F0);
        tr_convert(F0, P.w_in + (size_t)l * 2048 * 13344, 13344, P.WIN + ((size_t)l * NINP + 4096) * 2048, 2048, 3072, MapInOff{4096});
        tr_convert(F0, P.w_in + (size_t)l * 2048 * 13344, 13344, P.WIN + ((size_t)l * NINP + 13312) * 2048, 2048, 256, MapInOff{13312});
    }
}

__device__ __forceinline__ void phase_lnmod(const Frame0& F0, int l) {
    PHASE_IDS(F0);
    const int stride = F.nb * 8;
    int row = F.bid * 8 + F.wave;
    float4 v[8], shv[8], scv[8]; int cci = -1;
    if (row < T) { const float* xr = xrow_in(F, l, row);
#pragma unroll
        for (int i = 0; i < 8; ++i) v[i] = *(const float4*)(xr + i * 256 + F.lane * 4); }
    for (; row < T; row += stride) {
        float4 vn[8];
        const int nrow = row + stride;
        if (nrow < T) { const float* xn = xrow_in(F, l, nrow);
#pragma unroll
            for (int i = 0; i < 8; ++i) vn[i] = *(const float4*)(xn + i * 256 + F.lane * 4); }
        else {
#pragma unroll
            for (int i = 0; i < 8; ++i) vn[i] = v[i]; }
        const int ci = cond_of(row);
        if (ci != cci) { const float* md = F.MOD + (size_t)(l * 9 + ci) * NADA; cci = ci;
#pragma unroll
            for (int i = 0; i < 8; ++i) { shv[i] = *(const float4*)(md + i * 256 + F.lane * 4); scv[i] = *(const float4*)(md + 2048 + i * 256 + F.lane * 4); } }
        float s = 0.f;
#pragma unroll
        for (int i = 0; i < 8; ++i) s += (v[i].x + v[i].y) + (v[i].z + v[i].w);
        const float mean = wsum(s) * (1.f / 2048.f);
        float q = 0.f;
#pragma unroll
        for (int i = 0; i < 8; ++i) { const float a = v[i].x - mean, b = v[i].y - mean, c = v[i].z - mean, d = v[i].w - mean; q += (a * a + b * b) + (c * c + d * d); }
        const float rstd = rsqrtf(wsum(q) * (1.f / 2048.f) + LN_EPS);
        float am = 0.f;
#pragma unroll
        for (int i = 0; i < 8; ++i) { const int col = i * 256 + F.lane * 4;
            const float4 sh = shv[i], sc = scv[i];
            const float y0 = (v[i].x - mean) * rstd * (1.f + sc.x) + sh.x, y1 = (v[i].y - mean) * rstd * (1.f + sc.y) + sh.y;
            const float y2 = (v[i].z - mean) * rstd * (1.f + sc.z) + sh.z, y3 = (v[i].w - mean) * rstd * (1.f + sc.w) + sh.w;
            if (row < TCTX) { u32x2 o; o.x = cvt_pk_bf16(y0, y1); o.y = cvt_pk_bf16(y2, y3); *(u32x2*)(F.H + (size_t)row * D + col) = o; }
            v[i].x = y0; v[i].y = y1; v[i].z = y2; v[i].w = y3; am = fmaxf(am, fmaxf(fmaxf(fabsf(y0), fabsf(y1)), fmaxf(fabsf(y2), fabsf(y3)))); }
        am = wmax(am);
        const float hs = am > 0.f ? am * (1.f / 127.f) : 1.f, hinv = 1.f / hs;
#pragma unroll
        for (int i = 0; i < 8; ++i) *(unsigned*)(F.ws + WS_H8IN + (size_t)row * D + i * 256 + F.lane * 4) = pack_i8(v[i].x * hinv, v[i].y * hinv, v[i].z * hinv, v[i].w * hinv);
        if (F.lane == 0) ((float*)(F.ws + WS_HSIN))[row] = hs;
#pragma unroll
        for (int i = 0; i < 8; ++i) v[i] = vn[i];
    }
}

__device__ __forceinline__ unsigned dpp_ror8(unsigned x) { return (unsigned)__builtin_amdgcn_update_dpp(0, (int)x, 0x128, 0xf, 0xf, true); }
__device__ __forceinline__ void store_rows128(bf16_t* base, size_t ld, int fr, int fq, const u32x4 w0, const u32x4 w1) {
    const bool lo = fr < 8;
    u32x4 a, b;
#pragma unroll
    for (int j = 0; j < 4; ++j) { const unsigned t0 = dpp_ror8(w0[j]), t1 = dpp_ror8(w1[j]); a[j] = lo ? w0[j] : t1; b[j] = lo ? t0 : w1[j]; }
    bf16_t* p = base + (size_t)(fr & 7) * ld + (lo ? 0 : 32) + 8 * fq;
#if STORE_POLICY == 1
    __builtin_nontemporal_store(a, (u32x4*)p); __builtin_nontemporal_store(b, (u32x4*)(p + 8 * ld));
#elif STORE_POLICY == 2
    asm volatile("global_store_dwordx4 %0, %1, off sc1" :: "v"(p), "v"(a) : "memory"); asm volatile("global_store_dwordx4 %0, %1, off sc1" :: "v"(p + 8 * ld), "v"(b) : "memory");
#elif STORE_POLICY == 3
    asm volatile("global_store_dwordx4 %0, %1, off sc0 sc1" :: "v"(p), "v"(a) : "memory"); asm volatile("global_store_dwordx4 %0, %1, off sc0 sc1" :: "v"(p + 8 * ld), "v"(b) : "memory");
#else
    *(u32x4*)p = a; *(u32x4*)(p + 8 * ld) = b;
#endif
}
__device__ __forceinline__ void store_rows128_f32(float* base, size_t ld, int fr, int fq, const f32x4 v0, const f32x4 v1) {
    const bool lo = fr < 8;
    f32x4 a, b;
#pragma unroll
    for (int j = 0; j < 4; ++j) { const float t0 = __uint_as_float(dpp_ror8(__float_as_uint(v0[j]))), t1 = __uint_as_float(dpp_ror8(__float_as_uint(v1[j]))); a[j] = lo ? v0[j] : t1; b[j] = lo ? t0 : v1[j]; }
    float* p = base + (size_t)(fr & 7) * ld + (lo ? 0 : 16) + 4 * fq;
    *(f32x4*)p = a; *(f32x4*)(p + 8 * ld) = b;
}
__device__ __forceinline__ float4 ld_bf4(const bf16_t* p) { const u32x2 w = *(const u32x2*)p; float4 r; r.x = __uint_as_float(w.x << 16); r.y = __uint_as_float(w.x & 0xffff0000u); r.z = __uint_as_float(w.y << 16); r.w = __uint_as_float(w.y & 0xffff0000u); return r; }
__device__ __forceinline__ u32x4 pack8(const f32x4 v0, const f32x4 v1) { u32x4 w; w.x = cvt_pk_bf16(v0[0], v0[1]); w.y = cvt_pk_bf16(v0[2], v0[3]); w.z = cvt_pk_bf16(v1[0], v1[1]); w.w = cvt_pk_bf16(v1[2], v1[3]); return w; }
struct EpiIn {
    static constexpr bool PERM = true;
    bf16_t *Z1, *ZQ, *ZK, *ZV, *Z3, *GA, *GB; float* Z5;
    __device__ __forceinline__ void operator()(const f32x4 (&acc)[2][2][4][2], const pg8::Unit& u, int wr, int wc, int fr0, int fq0) const {
        int fr = fr0, fq = fq0; asm volatile("" : "+v"(fr), "+v"(fq));
        const int rw = u.pm * 256 + wr * 64;
        if (u.pn < 52) {
            bf16_t* base; int ld, c;
            const int colt = u.pn * 256;
            if (u.pn < 12) { base = Z1; ld = 3072; c = colt; }
            else if (u.pn < 16) { base = ZQ; ld = 1024; c = colt - 3072; }
            else if (u.pn < 20) { base = ZK; ld = 1024; c = colt - 4096; }
            else if (u.pn < 28) { base = ZV; ld = 2048; c = colt - 5120; }
            else if (u.pn < 36) { base = Z3; ld = 2048; c = colt - 7168; }
            else if (u.pn < 44) { base = GA; ld = 2048; c = colt - 9216; }
            else { base = GB; ld = 2048; c = colt - 11264; }
#pragma unroll
            for (int ai = 0; ai < 2; ++ai)
#pragma unroll
                for (int m = 0; m < 4; ++m)
                    store_rows128(base + (size_t)(rw + ai * 128 + m * 16) * ld + c + wc * 64, (size_t)ld, fr, fq, pack8(acc[ai][0][m][0], acc[ai][0][m][1]), pack8(acc[ai][1][m][0], acc[ai][1][m][1]));
        } else if (wc == 0) {
#pragma unroll
            for (int ai = 0; ai < 2; ++ai)
#pragma unroll
                for (int m = 0; m < 4; ++m) { float* rowp = Z5 + (size_t)(rw + fr + ai * 128 + m * 16) * 32 + 8 * fq;
                    *(f32x4*)(rowp) = acc[ai][0][m][0]; *(f32x4*)(rowp + 4) = acc[ai][0][m][1]; }
        }
    }
};
struct SubsetOrder {
    int mode, G, c;
    __device__ __forceinline__ bool next(int i, pg8::Unit& u) const {
        const long L = (long)i * G + c;
        if (mode == 0) { if (L >= 208) return false; const int k = (int)L >> 4; u.pm = (int)L & 15; u.pn = k < 12 ? 16 + k : 52; return true; }
        if (L >= 7424) return false;
        const int w = ((int)L & 7) * 928 + ((int)L >> 3);
        if (w < 6784) { const int r = w % 424; u.pm = 16 + (w / 424) * 8 + (r & 7); u.pn = r >> 3; }
        else { const int v = w - 6784, q = v >> 4; u.pm = v & 15; u.pn = q < 16 ? q : q + 12; }
        return true;
    }
    __device__ __forceinline__ void a_ready(const pg8::Unit&) const {}
    __device__ __forceinline__ void done(const pg8::Unit&) const {}
};
struct EpiInS {
    static constexpr bool PERM = true;
    bf16_t *Z1, *ZQ, *ZK, *ZV, *Z3, *GA, *GB; float* Z5; const float* RS; const float* CS;
    __device__ __forceinline__ void operator()(const i32x4 (&acc)[2][2][4][2], const pg8::Unit& u, int wr, int wc, int fr0, int fq0) const {
        int fr = fr0, fq = fq0; asm volatile("" : "+v"(fr), "+v"(fq));
        const int rw = u.pm * 256 + wr * 64;
        const int colt = u.pn * 256;
        f32x4 cs[2][2];
#pragma unroll
        for (int bj = 0; bj < 2; ++bj)
#pragma unroll
            for (int n = 0; n < 2; ++n) cs[bj][n] = *(const f32x4*)(CS + colt + wc * 64 + bj * 32 + 8 * fq + 4 * n);
        if (u.pn < 52) {
            bf16_t* base; int ld, c;
            if (u.pn < 12) { base = Z1; ld = 3072; c = colt; }
            else if (u.pn < 16) { base = ZQ; ld = 1024; c = colt - 3072; }
            else if (u.pn < 20) { base = ZK; ld = 1024; c = colt - 4096; }
            else if (u.pn < 28) { base = ZV; ld = 2048; c = colt - 5120; }
            else if (u.pn < 36) { base = Z3; ld = 2048; c = colt - 7168; }
            else if (u.pn < 44) { base = GA; ld = 2048; c = colt - 9216; }
            else { base = GB; ld = 2048; c = colt - 11264; }
#pragma unroll
            for (int ai = 0; ai < 2; ++ai)
#pragma unroll
                for (int m = 0; m < 4; ++m) { const float rs = RS[rw + ai * 128 + m * 16 + fr]; f32x4 v[2][2];
#pragma unroll
                    for (int bj = 0; bj < 2; ++bj)
#pragma unroll
                        for (int n = 0; n < 2; ++n)
#pragma unroll
                            for (int j = 0; j < 4; ++j) v[bj][n][j] = (float)acc[ai][bj][m][n][j] * rs * cs[bj][n][j];
                    store_rows128(base + (size_t)(rw + ai * 128 + m * 16) * ld + c + wc * 64, (size_t)ld, fr, fq, pack8(v[0][0], v[0][1]), pack8(v[1][0], v[1][1])); }
        } else if (wc == 0) {
#pragma unroll
            for (int ai = 0; ai < 2; ++ai)
#pragma unroll
                for (int m = 0; m < 4; ++m) { const float rs = RS[rw + ai * 128 + m * 16 + fr]; float* rowp = Z5 + (size_t)(rw + fr + ai * 128 + m * 16) * 32 + 8 * fq; f32x4 v0, v1;
#pragma unroll
                    for (int j = 0; j < 4; ++j) { v0[j] = (float)acc[ai][0][m][0][j] * rs * cs[0][0][j]; v1[j] = (float)acc[ai][0][m][1][j] * rs * cs[0][1][j]; }
                    *(f32x4*)(rowp) = v0; *(f32x4*)(rowp + 4) = v1; }
        }
    }
};
struct EpiA {
    static constexpr bool PERM = true;
    const bf16_t* Z4; bf16_t* Y;
    __device__ __forceinline__ void operator()(const f32x4 (&acc)[2][2][4][2], const pg8::Unit& u, int wr, int wc, int fr0, int fq0) const {
        int fr = fr0, fq = fq0; asm volatile("" : "+v"(fr), "+v"(fq));
        const int rw = u.pm * 256 + wr * 64, cw = u.pn * 256 + wc * 64;
#pragma unroll
        for (int ai = 0; ai < 2; ++ai)
#pragma unroll
            for (int m = 0; m < 4; ++m) { const size_t row = (size_t)(rw + fr + ai * 128 + m * 16);
                u32x4 w[2];
#pragma unroll
                for (int bj = 0; bj < 2; ++bj) { const int col = cw + bj * 32 + 8 * fq;
                    const u32x4 g = *(const u32x4*)(Z4 + row * 2048 + col);
                    const f32x4 v0 = acc[ai][bj][m][0], v1 = acc[ai][bj][m][1];
                    w[bj].x = cvt_pk_bf16(sigmoidf_(bf_lo(g.x)) * v0[0], sigmoidf_(bf_hi(g.x)) * v0[1]);
                    w[bj].y = cvt_pk_bf16(sigmoidf_(bf_lo(g.y)) * v0[2], sigmoidf_(bf_hi(g.y)) * v0[3]);
                    w[bj].z = cvt_pk_bf16(sigmoidf_(bf_lo(g.z)) * v1[0], sigmoidf_(bf_hi(g.z)) * v1[1]);
                    w[bj].w = cvt_pk_bf16(sigmoidf_(bf_lo(g.w)) * v1[2], sigmoidf_(bf_hi(g.w)) * v1[3]); }
                store_rows128(Y + (size_t)(rw + ai * 128 + m * 16) * 2048 + cw, 2048, fr, fq, w[0], w[1]); }
    }
};
struct EpiAS {
    static constexpr bool PERM = true;
    const bf16_t* Z4; bf16_t* Y; const float* RS; const float* CS;
    __device__ __forceinline__ void operator()(const i32x4 (&acc)[2][2][4][2], const pg8::Unit& u, int wr, int wc, int fr0, int fq0) const {
        int fr = fr0, fq = fq0; asm volatile("" : "+v"(fr), "+v"(fq));
        const int rw = u.pm * 256 + wr * 64, cw = u.pn * 256 + wc * 64;
#pragma unroll
        for (int ai = 0; ai < 2; ++ai)
#pragma unroll
            for (int m = 0; m < 4; ++m) { const size_t row = (size_t)(rw + fr + ai * 128 + m * 16); const float rs = RS[row];
                u32x4 w[2];
#pragma unroll
                for (int bj = 0; bj < 2; ++bj) { const int col = cw + bj * 32 + 8 * fq;
                    const u32x4 g = *(const u32x4*)(Z4 + row * 2048 + col);
                    const f32x4 c0 = *(const f32x4*)(CS + col), c1 = *(const f32x4*)(CS + col + 4); f32x4 v0, v1;
#pragma unroll
                    for (int jj = 0; jj < 4; ++jj) { v0[jj] = (float)acc[ai][bj][m][0][jj] * rs * c0[jj]; v1[jj] = (float)acc[ai][bj][m][1][jj] * rs * c1[jj]; }
                    w[bj].x = cvt_pk_bf16(sigmoidf_(bf_lo(g.x)) * v0[0], sigmoidf_(bf_hi(g.x)) * v0[1]);
                    w[bj].y = cvt_pk_bf16(sigmoidf_(bf_lo(g.y)) * v0[2], sigmoidf_(bf_hi(g.y)) * v0[3]);
                    w[bj].z = cvt_pk_bf16(sigmoidf_(bf_lo(g.z)) * v1[0], sigmoidf_(bf_hi(g.z)) * v1[1]);
                    w[bj].w = cvt_pk_bf16(sigmoidf_(bf_lo(g.w)) * v1[2], sigmoidf_(bf_hi(g.w)) * v1[3]); }
                store_rows128(Y + (size_t)(rw + ai * 128 + m * 16) * 2048 + cw, 2048, fr, fq, w[0], w[1]); }
    }
};
struct EpiB {
    static constexpr bool PERM = true;
    const bf16_t* Z4; bf16_t* Y;
    __device__ __forceinline__ void operator()(const f32x4 (&acc)[2][2][4][2], const pg8::Unit& u, int wr, int wc, int fr0, int fq0) const {
        int fr = fr0, fq = fq0; asm volatile("" : "+v"(fr), "+v"(fq));
        const int rw = u.pm * 256 + wr * 64, cw = u.pn * 256 + wc * 64;
#pragma unroll
        for (int ai = 0; ai < 2; ++ai)
#pragma unroll
            for (int m = 0; m < 4; ++m) { const size_t row = (size_t)(rw + fr + ai * 128 + m * 16);
                u32x4 w[2];
#pragma unroll
                for (int bj = 0; bj < 2; ++bj) { const int col = cw + bj * 32 + 8 * fq;
                    const u32x4 g = *(const u32x4*)(Z4 + row * 2048 + col);
                    const u32x4 y = *(const u32x4*)(Y + row * 2048 + col);
                    const f32x4 v0 = acc[ai][bj][m][0], v1 = acc[ai][bj][m][1];
                    w[bj].x = cvt_pk_bf16(bf_lo(y.x) + sigmoidf_(bf_lo(g.x)) * v0[0], bf_hi(y.x) + sigmoidf_(bf_hi(g.x)) * v0[1]);
                    w[bj].y = cvt_pk_bf16(bf_lo(y.y) + sigmoidf_(bf_lo(g.y)) * v0[2], bf_hi(y.y) + sigmoidf_(bf_hi(g.y)) * v0[3]);
                    w[bj].z = cvt_pk_bf16(bf_lo(y.z) + sigmoidf_(bf_lo(g.z)) * v1[0], bf_hi(y.z) + sigmoidf_(bf_hi(g.z)) * v1[1]);
                    w[bj].w = cvt_pk_bf16(bf_lo(y.w) + sigmoidf_(bf_lo(g.w)) * v1[2], bf_hi(y.w) + sigmoidf_(bf_hi(g.w)) * v1[3]); }
                store_rows128(Y + (size_t)(rw + ai * 128 + m * 16) * 2048 + cw, 2048, fr, fq, w[0], w[1]); }
    }
};
struct EpiO {
    static constexpr bool PERM = true;
    const float *xp, *xs, *xo; const float* MODl; bf16_t* T1; int l;
    __device__ __forceinline__ void operator()(const f32x4 (&acc)[2][2][4][2], const pg8::Unit& u, int wr, int wc, int fr0, int fq0) const {
        int fr = fr0, fq = fq0; asm volatile("" : "+v"(fr), "+v"(fq));
        const int cw = u.pn * 256 + wc * 64;
        const int rbase = u.pm * 256;
        const float* g1 = MODl + (size_t)cond_of(rbase) * NADA + 2 * 2048;
        const float* xb = (l == 0) ? (rbase < TCTX ? xp + (size_t)rbase * D : xs + (size_t)(rbase - TCTX) * D) : xo + (size_t)rbase * D;
#pragma unroll
        for (int ai = 0; ai < 2; ++ai)
#pragma unroll
            for (int m = 0; m < 4; ++m) { const int rl0 = wr * 64 + ai * 128 + m * 16, rl = rl0 + fr; u32x4 w[2];
#pragma unroll
                for (int bj = 0; bj < 2; ++bj) { f32x4 r[2]; const int col = cw + bj * 32 + 8 * fq;
#pragma unroll
                    for (int n = 0; n < 2; ++n) {
                        const f32x4 xv = *(const f32x4*)(xb + (size_t)rl * D + col + 4 * n);
                        const f32x4 gvv = *(const f32x4*)(g1 + col + 4 * n);
                        r[n] = xv * ALPHA + gvv * acc[ai][bj][m][n]; }
                    w[bj] = pack8(r[0], r[1]); }
                store_rows128(T1 + (size_t)(rbase + rl0) * D + cw, (size_t)D, fr, fq, w[0], w[1]);
                __builtin_amdgcn_sched_barrier(0); }
    }
};
struct EpiOS {
    static constexpr bool PERM = true;
    const float *xp, *xs, *xo; const float* MODl; bf16_t* T1; int l; const float* RS; const float* CS;
    __device__ __forceinline__ void operator()(const i32x4 (&acc)[2][2][4][2], const pg8::Unit& u, int wr, int wc, int fr0, int fq0) const {
        int fr = fr0, fq = fq0; asm volatile("" : "+v"(fr), "+v"(fq));
        const int cw = u.pn * 256 + wc * 64;
        const int rbase = u.pm * 256;
        const float* g1 = MODl + (size_t)cond_of(rbase) * NADA + 2 * 2048;
        const float* xb = (l == 0) ? (rbase < TCTX ? xp + (size_t)rbase * D : xs + (size_t)(rbase - TCTX) * D) : xo + (size_t)rbase * D;
#pragma unroll
        for (int ai = 0; ai < 2; ++ai)
#pragma unroll
            for (int m = 0; m < 4; ++m) { const int rl0 = wr * 64 + ai * 128 + m * 16, rl = rl0 + fr; u32x4 w[2]; const float rs = RS[rbase + rl];
#pragma unroll
                for (int bj = 0; bj < 2; ++bj) { f32x4 r[2]; const int col = cw + bj * 32 + 8 * fq;
#pragma unroll
                    for (int n = 0; n < 2; ++n) {
                        const f32x4 xv = *(const f32x4*)(xb + (size_t)rl * D + col + 4 * n);
                        const f32x4 gvv = *(const f32x4*)(g1 + col + 4 * n);
                        const f32x4 cs = *(const f32x4*)(CS + col + 4 * n); f32x4 af;
#pragma unroll
                        for (int jj = 0; jj < 4; ++jj) af[jj] = (float)acc[ai][bj][m][n][jj] * rs * cs[jj];
                        r[n] = xv * ALPHA + gvv * af; }
                    w[bj] = pack8(r[0], r[1]); }
                store_rows128(T1 + (size_t)(rbase + rl0) * D + cw, (size_t)D, fr, fq, w[0], w[1]);
                __builtin_amdgcn_sched_barrier(0); }
    }
};
struct EpiPlain {
    static constexpr bool PERM = true;
    bf16_t* O; int ld;
    __device__ __forceinline__ void operator()(const f32x4 (&acc)[2][2][4][2], const pg8::Unit& u, int wr, int wc, int fr0, int fq0) const {
        int fr = fr0, fq = fq0; asm volatile("" : "+v"(fr), "+v"(fq));
        const int rw = u.pm * 256 + wr * 64, cw = u.pn * 256 + wc * 64;
#pragma unroll
        for (int ai = 0; ai < 2; ++ai)
#pragma unroll
            for (int m = 0; m < 4; ++m)
                store_rows128(O + (size_t)(rw + ai * 128 + m * 16) * ld + cw, (size_t)ld, fr, fq, pack8(acc[ai][0][m][0], acc[ai][0][m][1]), pack8(acc[ai][1][m][0], acc[ai][1][m][1]));
    }
};
struct EpiPlainS {
    static constexpr bool PERM = true;
    bf16_t* O; int ld; const float* RS; const float* CS;
    __device__ __forceinline__ void operator()(const i32x4 (&acc)[2][2][4][2], const pg8::Unit& u, int wr, int wc, int fr0, int fq0) const {
        int fr = fr0, fq = fq0; asm volatile("" : "+v"(fr), "+v"(fq));
        const int rw = u.pm * 256 + wr * 64, cw = u.pn * 256 + wc * 64;
        f32x4 cs[2][2];
#pragma unroll
        for (int bj = 0; bj < 2; ++bj)
#pragma unroll
            for (int n = 0; n < 2; ++n) cs[bj][n] = *(const f32x4*)(CS + cw + bj * 32 + 8 * fq + 4 * n);
#pragma unroll
        for (int ai = 0; ai < 2; ++ai)
#pragma unroll
            for (int m = 0; m < 4; ++m) { const float rs = RS[rw + ai * 128 + m * 16 + fr]; f32x4 v[2][2];
#pragma unroll
                for (int bj = 0; bj < 2; ++bj)
#pragma unroll
                    for (int n = 0; n < 2; ++n)
#pragma unroll
                        for (int j = 0; j < 4; ++j) v[bj][n][j] = (float)acc[ai][bj][m][n][j] * rs * cs[bj][n][j];
                store_rows128(O + (size_t)(rw + ai * 128 + m * 16) * ld + cw, (size_t)ld, fr, fq, pack8(v[0][0], v[0][1]), pack8(v[1][0], v[1][1])); }
    }
};
struct EpiBS {
    static constexpr bool PERM = true;
    const bf16_t* Z4; bf16_t* Y; const float* RS; const float* CS;
    __device__ __forceinline__ void operator()(const i32x4 (&acc)[2][2][4][2], const pg8::Unit& u, int wr, int wc, int fr0, int fq0) const {
        int fr = fr0, fq = fq0; asm volatile("" : "+v"(fr), "+v"(fq));
        const int rw = u.pm * 256 + wr * 64, cw = u.pn * 256 + wc * 64;
        f32x4 cs[2][2];
#pragma unroll
        for (int bj = 0; bj < 2; ++bj)
#pragma unroll
            for (int n = 0; n < 2; ++n) cs[bj][n] = *(const f32x4*)(CS + cw + bj * 32 + 8 * fq + 4 * n);
#pragma unroll
        for (int ai = 0; ai < 2; ++ai)
#pragma unroll
            for (int m = 0; m < 4; ++m) { const size_t row = (size_t)(rw + fr + ai * 128 + m * 16); const float rs = RS[row];
                u32x4 w[2];
#pragma unroll
                for (int bj = 0; bj < 2; ++bj) { const int col = cw + bj * 32 + 8 * fq;
                    const u32x4 g = *(const u32x4*)(Z4 + row * 2048 + col);
                    const u32x4 y = *(const u32x4*)(Y + row * 2048 + col);
                    f32x4 v0, v1;
#pragma unroll
                    for (int j = 0; j < 4; ++j) { v0[j] = (float)acc[ai][bj][m][0][j] * rs * cs[bj][0][j]; v1[j] = (float)acc[ai][bj][m][1][j] * rs * cs[bj][1][j]; }
                    w[bj].x = cvt_pk_bf16(bf_lo(y.x) + sigmoidf_(bf_lo(g.x)) * v0[0], bf_hi(y.x) + sigmoidf_(bf_hi(g.x)) * v0[1]);
                    w[bj].y = cvt_pk_bf16(bf_lo(y.y) + sigmoidf_(bf_lo(g.y)) * v0[2], bf_hi(y.y) + sigmoidf_(bf_hi(g.y)) * v0[3]);
                    w[bj].z = cvt_pk_bf16(bf_lo(y.z) + sigmoidf_(bf_lo(g.z)) * v1[0], bf_hi(y.z) + sigmoidf_(bf_hi(g.z)) * v1[1]);
                    w[bj].w = cvt_pk_bf16(bf_lo(y.w) + sigmoidf_(bf_lo(g.w)) * v1[2], bf_hi(y.w) + sigmoidf_(bf_hi(g.w)) * v1[3]); }
                store_rows128(Y + (size_t)(rw + ai * 128 + m * 16) * 2048 + cw, 2048, fr, fq, w[0], w[1]); }
    }
};
template <class Epi, bool I8 = false>
__device__ __forceinline__ void run_gemm(const Frame& F, const bf16_t* A, const bf16_t* Bt, int N, int K, const Epi& E) {
    pg8::Gemm g{A, Bt, T, N, K}; pg8::StaticOrder S; S.init(T, N, F.nb, F.bid);
    pg8::gemm_phase<Epi, pg8::StaticOrder, true, true, I8>(F.lds, g, S, E);
}
#define B_ZQ(F) ((F).Z2)
#define B_ZK(F) ((F).Z2 + (size_t)T * 1024)
#define B_ZV(F) ((F).Z2 + (size_t)T * 2048)
#define B_GA(F) ((F).Z4)
#define B_GB(F) ((F).Z4 + (size_t)T * 2048)
#define B_Y(F)  ((F).Z1 + (size_t)T * 1024)
#define B_QDF(F) ((F).H)
#define B_KDF(F) ((F).H + (size_t)T * 1024)
#define B_QDB(F) ((F).H + (size_t)T * 2048)
#define B_KDB(F) ((F).Z4)
#define B_DEC(F) ((float*)((F).Z4 + (size_t)T * 1024))
#define B_OF(F) ((F).Z2)
#define B_BIN(F) ((F).H)
#define B_QQ(F) ((F).Z2 + (size_t)T * 2048)
#define B_T1(F) ((F).Z4 + (size_t)T * 2048)
__device__ __forceinline__ void phase_gemm_in(const Frame0& F0, int l) {
    {
        PHASE_IDS(F0); EpiIn E{F.Z1, B_ZQ(F), B_ZK(F), B_ZV(F), F.Z3, B_GA(F), B_GB(F), F.Z5};
        pg8::Gemm g{F.H, F.WIN + (size_t)l * NINP * 2048, T, NINP, 2048}; SubsetOrder S{0, F.nb, F.bid};
        pg8::gemm_phase<EpiIn, SubsetOrder, true, true, false>(F.lds, g, S, E); }
    {
        PHASE_IDS(F0); EpiInS E{F.Z1, B_ZQ(F), B_ZK(F), B_ZV(F), F.Z3, B_GA(F), B_GB(F), F.Z5, (const float*)(F.ws + WS_HSIN), (const float*)(F.ws + WS_CSIN) + (size_t)l * NINP};
        pg8::Gemm g{(const bf16_t*)(F.ws + WS_H8IN), (const bf16_t*)(F.ws + WS_W8IN + (size_t)l * NINP * 2048), T, NINP, 2048}; SubsetOrder S{1, F.nb, F.bid};
        pg8::gemm_phase<EpiInS, SubsetOrder, true, true, true>(F.lds, g, S, E); }
}
__device__ __forceinline__ void phase_gemm_a(const Frame0& F0, int l) { PHASE_IDS(F0);
    EpiAS E{B_GA(F), B_Y(F), (const float*)(F.ws + WS_ASIN), (const float*)((const unsigned char*)F.WA + (size_t)2 * 2048 * 1024) + l * 2048};
    run_gemm<EpiAS, true>(F, F.H, (const bf16_t*)((const unsigned char*)F.WA + (size_t)l * 2048 * 1024), 2048, 1024, E); }
__device__ __forceinline__ void phase_gemm_b(const Frame0& F0, int l) { PHASE_IDS(F0);
    EpiBS E{B_GB(F), B_Y(F), F.VS + 110592, (const float*)((const unsigned char*)F.WB + (size_t)2 * 2048 * 2048) + l * 2048};
    run_gemm<EpiBS, true>(F, B_BIN(F), (const bf16_t*)((const unsigned char*)F.WB + (size_t)l * 2048 * 2048), 2048, 2048, E); }
__device__ __forceinline__ void phase_quant_y(const Frame0& F0) {
    PHASE_IDS(F0);
    const bf16_t* Y = B_Y(F); unsigned char* Y8 = (unsigned char*)F.Z1; float* YS = (float*)(F.ws + WS_YS);
    const int stride = F.nb * 8;
    int row = F.bid * 8 + F.wave;
    u32x2 raw[8];
    if (row < T) {
#pragma unroll
        for (int i = 0; i < 8; ++i) raw[i] = *(const u32x2*)(Y + (size_t)row * D + i * 256 + F.lane * 4); }
    for (; row < T; row += stride) {
        float4 v[8]; float am = 0.f;
#pragma unroll
        for (int i = 0; i < 8; ++i) { v[i].x = bf_lo(raw[i].x); v[i].y = bf_hi(raw[i].x); v[i].z = bf_lo(raw[i].y); v[i].w = bf_hi(raw[i].y); am = fmaxf(am, fmaxf(fmaxf(fabsf(v[i].x), fabsf(v[i].y)), fmaxf(fabsf(v[i].z), fabsf(v[i].w)))); }
        { const int nrow = row + stride < T ? row + stride : row;
#pragma unroll
          for (int i = 0; i < 8; ++i) raw[i] = *(const u32x2*)(Y + (size_t)nrow * D + i * 256 + F.lane * 4); }
        am = wmax(am);
        const float ys = am > 0.f ? am * (1.f / 127.f) : 1.f, yinv = 1.f / ys;
#pragma unroll
        for (int i = 0; i < 8; ++i) *(unsigned*)(Y8 + (size_t)row * D + i * 256 + F.lane * 4) = pack_i8(v[i].x * yinv, v[i].y * yinv, v[i].z * yinv, v[i].w * yinv);
        if (F.lane == 0) YS[row] = ys;
    }
}
__device__ __forceinline__ void phase_gemm_o(const Frame0& F0, int l) { PHASE_IDS(F0);
    EpiOS E{F.x_prompt, F.x_sample, F.out, F.MOD + (size_t)l * 9 * NADA, B_T1(F), l, (const float*)(F.ws + WS_YS), (const float*)((const unsigned char*)F.WO + (size_t)2 * 2048 * 2048) + l * 2048};
    run_gemm<EpiOS, true>(F, (const bf16_t*)F.Z1, (const bf16_t*)((const unsigned char*)F.WO + (size_t)l * 2048 * 2048), 2048, 2048, E); }
__device__ __forceinline__ void phase_gemm_pq(const Frame0& F0, int l) { PHASE_IDS(F0);
    EpiPlainS E{B_QQ(F), 2048, F.VS + 32768, (const float*)((const unsigned char*)F.WPQ + (size_t)2 * 2048 * 2048) + l * 2048};
    run_gemm<EpiPlainS, true>(F, (const bf16_t*)((const unsigned char*)F.Z3 + ((size_t)64 << 20)), (const bf16_t*)((const unsigned char*)F.WPQ + (size_t)l * 2048 * 2048), 2048, 2048, E); }

__device__ __forceinline__ void phase_conv(const Frame0& F0, int l) {
    PHASE_IDS(F0);
    const bf16_t* Z1 = F.Z1; unsigned char* AIN = (unsigned char*)F.H;
    float* AS = (float*)(F.ws + WS_ASIN);
    LAS float* red = (LAS float*)F.lds;
    const size_t gth = (size_t)F.nb * 512;
    int par = 0;
    for (size_t it = (size_t)F.bid * 512 + F.tid; it < (size_t)T * 128; it += gth, par ^= 8) {
        const int t = (int)(it >> 7), ch = (int)(it & 127) * 8;
        int dlt; bool vm, vp;
        if (t < TCTX) { const int pos = t & 255; dlt = 1; vm = pos > 0; vp = pos < 255; }
        else { const int tau = (t - TCTX) & 4095;
            if (ch < 512) { dlt = 1; vm = (tau & 63) > 0; vp = (tau & 63) < 63; } else { dlt = 64; vm = tau >= 64; vp = tau < 4032; } }
        const bf16_t* zr = Z1 + (size_t)t * 3072;
        const u32x4 zero = {0u, 0u, 0u, 0u};
        const u32x4 cb = *(const u32x4*)(zr + ch), cc0 = *(const u32x4*)(zr + 1024 + ch), cx0 = *(const u32x4*)(zr + 2048 + ch);
        const u32x4 ccm = vm ? *(const u32x4*)(zr - (size_t)dlt * 3072 + 1024 + ch) : zero, cxm = vm ? *(const u32x4*)(zr - (size_t)dlt * 3072 + 2048 + ch) : zero;
        const u32x4 ccp = vp ? *(const u32x4*)(zr + (size_t)dlt * 3072 + 1024 + ch) : zero, cxp = vp ? *(const u32x4*)(zr + (size_t)dlt * 3072 + 2048 + ch) : zero;
        const float* wc = F.w_conv + (size_t)l * 3072 + ch;
        const float4 w0a = *(const float4*)(wc), w0b = *(const float4*)(wc + 4), w1a = *(const float4*)(wc + 1024), w1b = *(const float4*)(wc + 1028), w2a = *(const float4*)(wc + 2048), w2b = *(const float4*)(wc + 2052);
        const float w0[8] = {w0a.x, w0a.y, w0a.z, w0a.w, w0b.x, w0b.y, w0b.z, w0b.w};
        const float w1[8] = {w1a.x, w1a.y, w1a.z, w1a.w, w1b.x, w1b.y, w1b.z, w1b.w};
        const float w2[8] = {w2a.x, w2a.y, w2a.z, w2a.w, w2b.x, w2b.y, w2b.z, w2b.w};
        float o[8]; float am = 0.f;
#pragma unroll
        for (int j = 0; j < 4; ++j) {
            const float um0 = bf_lo(ccm[j]) * bf_lo(cxm[j]), um1 = bf_hi(ccm[j]) * bf_hi(cxm[j]);
            const float u00 = bf_lo(cc0[j]) * bf_lo(cx0[j]), u01 = bf_hi(cc0[j]) * bf_hi(cx0[j]);
            const float up0 = bf_lo(ccp[j]) * bf_lo(cxp[j]), up1 = bf_hi(ccp[j]) * bf_hi(cxp[j]);
            o[2 * j] = bf_lo(cb[j]) * (um0 * w0[2 * j] + u00 * w1[2 * j] + up0 * w2[2 * j]);
            o[2 * j + 1] = bf_hi(cb[j]) * (um1 * w0[2 * j + 1] + u01 * w1[2 * j + 1] + up1 * w2[2 * j + 1]);
            am = fmaxf(am, fmaxf(fabsf(o[2 * j]), fabsf(o[2 * j + 1])));
        }
        am = wmax(am);
        if (F.lane == 0) red[par + F.wave] = am;
        __syncthreads();
        am = fmaxf(red[par + (F.wave & 6)], red[par + (F.wave & 6) + 1]);
        const float as = am > 0.f ? am * (1.f / 127.f) : 1.f, ainv = 1.f / as;
        u32x2 w; w.x = pack_i8(o[0] * ainv, o[1] * ainv, o[2] * ainv, o[3] * ainv); w.y = pack_i8(o[4] * ainv, o[5] * ainv, o[6] * ainv, o[7] * ainv);
        *(u32x2*)(AIN + (size_t)t * 1024 + ch) = w;
        if ((F.tid & 127) == 0) AS[t] = as;
    }
}

__device__ __forceinline__ float logsig_(float x) { return fminf(x, 0.f) - __logf(1.f + __expf(-fabsf(x))); }
__device__ __forceinline__ void phase_gla_prep(const Frame0& F0, int l) {
    PHASE_IDS(F0);
    LAS float* LF = (LAS float*)F.lds;
    LAS float* HT = LF + 2048;
    const int tid = F.tid;
    const int d = tid & 255, half = tid >> 8, p0 = half * 32;
    const bf16_t* ZQ = B_ZQ(F); const bf16_t* ZK = B_ZK(F); const float* Z5 = F.Z5;
    for (int u = F.bid; u < (T / 64) * 4; u += F.nb) {
        const int ch = u >> 2, head = u & 3, tb = ch * 64;
        __syncthreads();
        { const int row = tid >> 3, part = tid & 7; const f32x4 v = *(const f32x4*)(Z5 + (size_t)(tb + row) * 32 + part * 4);
          *(LAS f32x4*)(LF + (part >> 2) * 1024 + row * 16 + (part & 3) * 4) = v; }
        bf16_t qv[32], kv[32];
#pragma unroll
        for (int i = 0; i < 32; ++i) { const size_t ro = (size_t)(tb + p0 + i) * 1024 + head * 256 + d; qv[i] = ZQ[ro]; kv[i] = ZK[ro]; }
        __syncthreads();
#pragma unroll 1
        for (int dir = 0; dir < 2; ++dir) {
            float wg[16];
#pragma unroll
            for (int r = 0; r < 16; ++r) wg[r] = F.w_gk[((size_t)(l * 2 + dir) * 16 + r) * 1024 + head * 256 + d];
            const float gbias = F.b_gk[(size_t)(l * 2 + dir) * 1024 + head * 256 + d];
            float b[32];
#pragma unroll
            for (int i = 0; i < 32; ++i) { float x = gbias; const LAS float* lf = LF + dir * 1024 + (p0 + i) * 16;
#pragma unroll
                for (int r = 0; r < 16; ++r) x += lf[r] * wg[r];
                b[i] = fmaxf(logsig_(x) * 0.0625f, -1.0f); }
            float tot;
            if (!dir) {
#pragma unroll
                for (int i = 1; i < 32; ++i) b[i] += b[i - 1];
                tot = b[31];
            } else {
#pragma unroll
                for (int i = 30; i >= 0; --i) b[i] += b[i + 1];
                tot = b[0];
            }
            HT[half * 256 + d] = tot;
            __syncthreads();
            const float other = HT[(1 - half) * 256 + d];
            const float blast = tot + other;
            const float addv = (dir == 0) ? (half ? other : 0.f) : (half ? 0.f : other);
            bf16_t* QD = dir ? B_QDB(F) : B_QDF(F); bf16_t* KD = dir ? B_KDB(F) : B_KDF(F);
#pragma unroll
            for (int i = 0; i < 32; ++i) {
                const float bb = b[i] + addv; const size_t ro = (size_t)(tb + p0 + i) * 1024 + head * 256 + d;
                QD[ro] = f2bf(bf1(qv[i]) * 0.0625f * __expf(bb - blast));
                KD[ro] = f2bf(bf1(kv[i]) * __expf(blast - bb));
            }
            if (half == 0) B_DEC(F)[((size_t)dir * (T / 64) * 4 + u) * 256 + d] = __expf(blast);
            __syncthreads();
        }
    }
}
__device__ __forceinline__ void phase_gla_scan(const Frame0& F0, int l) {
    PHASE_IDS(F0);
    LAS unsigned char* L = F.lds;
    constexpr int QD_OFF = 0, KD_OFF = 33792, V_OFF = 67584, ST_OFF = 76800, ATT_OFF = 110592, DEC_OFF = 119808;
    const int tid = F.tid, lane = F.lane, wave = F.wave;
    const int fr = lane & 15, fq = lane >> 4;
    const unsigned lbase = (unsigned)(size_t)L;
    const unsigned tr_lane_v = lbase + V_OFF + (unsigned)((8 * fq + (fr >> 2)) * 144 + 8 * (lane & 3));
    const unsigned tr_lane_k = lbase + KD_OFF + (unsigned)((8 * fq + (fr >> 2)) * 528 + 8 * (lane & 3) + wave * 64);
    const bf16_t* ZV = B_ZV(F); bf16_t* OF = B_OF(F);
    const int ti = wave >> 1;
    for (int u0 = F.bid; u0 < 768; u0 += F.nb) {
        const int u = (F.nb == 256) ? (u0 & ~255) + (u0 & 7) * 32 + ((u0 & 255) >> 3) : u0;
        int seq, head, slice, tok0, nch; bool lat;
        if (u < 256) { lat = true; slice = u & 7; head = (u >> 3) & 3; seq = u >> 5; tok0 = TCTX + seq * 4096; nch = 64; }
        else { const int uc = u - 256; lat = false; slice = uc & 7; head = (uc >> 3) & 3; seq = uc >> 5; tok0 = seq * 256; nch = 4; }
#pragma unroll 1
      for (int dir = 0; dir < 2; ++dir) {
        const bf16_t* QD = dir ? B_QDB(F) : B_QDF(F); const bf16_t* KD = dir ? B_KDB(F) : B_KDF(F);
        const float* DEC = B_DEC(F) + (size_t)dir * (T / 64) * 4 * 256;
        const size_t soff = ((((size_t)seq * 2 + l) * 2 + dir) * 4 + head) * 256 * 512;
        f32x4 accS[2][4];
#pragma unroll
        for (int tdi = 0; tdi < 2; ++tdi)
#pragma unroll
            for (int te = 0; te < 4; ++te)
#pragma unroll
                for (int reg = 0; reg < 4; ++reg) {
                    const int dd = (2 * wave + tdi) * 16 + 4 * fq + reg, e = slice * 64 + te * 16 + fr;
                    accS[tdi][te][reg] = lat ? F.state[soff + (size_t)dd * 512 + e] : 0.f;
                }
        u32x4 rq[4], rk[4], rv; f32x4 rdec = {0.f, 0.f, 0.f, 0.f}; bf16_t ro[2][4];
#define GS_LOAD(cc_) do { const int c_ = dir ? nch - 1 - (cc_) : (cc_); const int tb_ = tok0 + c_ * 64; int tl_ = tid; asm volatile("" : "+v"(tl_));   \
            _Pragma("unroll") for (int i_ = 0; i_ < 4; ++i_) { const int id_ = tl_ + 512 * i_, row_ = id_ >> 5, c16_ = id_ & 31; const size_t go_ = (size_t)(tb_ + row_) * 1024 + head * 256 + c16_ * 8; \
                rq[i_] = *(const u32x4*)(QD + go_); rk[i_] = *(const u32x4*)(KD + go_); } \
            rv = *(const u32x4*)(ZV + (size_t)(tb_ + (tl_ >> 3)) * 2048 + head * 512 + slice * 64 + (tl_ & 7) * 8); \
            if (tl_ < 64) rdec = *(const f32x4*)(DEC + ((size_t)(tb_ >> 6) * 4 + head) * 256 + tl_ * 4); \
            if (dir) { const int ln_ = tl_ & 63, wv_ = tl_ >> 6; const bf16_t* ob_ = OF + (size_t)(tb_ + (wv_ >> 1) * 16 + 4 * (ln_ >> 4)) * 2048 + head * 512 + slice * 64 + 2 * (wv_ & 1) * 16 + (ln_ & 15); \
                _Pragma("unroll") for (int t2_ = 0; t2_ < 2; ++t2_) _Pragma("unroll") for (int reg_ = 0; reg_ < 4; ++reg_) ro[t2_][reg_] = ob_[reg_ * 2048 + t2_ * 16]; } } while (0)
        GS_LOAD(0);
#define GS_BAR() do { asm volatile("s_waitcnt lgkmcnt(0)" ::: "memory"); __builtin_amdgcn_s_barrier(); asm volatile("" ::: "memory"); } while (0)
        for (int cc = 0; cc < nch; ++cc) {
            const int c = dir ? nch - 1 - cc : cc; const int tb = tok0 + c * 64;
            GS_BAR();
#pragma unroll
            for (int i = 0; i < 4; ++i) { const int id = tid + 512 * i, row = id >> 5, c16 = id & 31;
                *(LAS u32x4*)(L + QD_OFF + row * 528 + c16 * 16) = rq[i]; *(LAS u32x4*)(L + KD_OFF + row * 528 + c16 * 16) = rk[i]; }
            *(LAS u32x4*)(L + V_OFF + (tid >> 3) * 144 + (tid & 7) * 16) = rv;
            if (tid < 64) *(LAS f32x4*)(L + DEC_OFF + tid * 16) = rdec;
            bf16_t oold[2][4];
#pragma unroll
            for (int t2 = 0; t2 < 2; ++t2)
#pragma unroll
                for (int reg = 0; reg < 4; ++reg) oold[t2][reg] = ro[t2][reg];
            GS_BAR();
            { const int nx = (cc + 1 < nch) ? cc + 1 : cc; GS_LOAD(nx); }
#pragma unroll
            for (int tdi = 0; tdi < 2; ++tdi) {
                const f32x4 dec = *(const LAS f32x4*)(L + DEC_OFF + ((2 * wave + tdi) * 16 + 4 * fq) * 4);
#pragma unroll
                for (int te = 0; te < 4; ++te) { accS[tdi][te] = accS[tdi][te] * dec;
                    u32x2 w; w.x = cvt_pk_bf16(accS[tdi][te][0], accS[tdi][te][1]); w.y = cvt_pk_bf16(accS[tdi][te][2], accS[tdi][te][3]);
                    *(LAS u32x2*)(L + ST_OFF + (te * 16 + fr) * 528 + ((2 * wave + tdi) * 16 + 4 * fq) * 2) = w; }
            }
#pragma unroll
            for (int t2 = 0; t2 < 2; ++t2) {
                const int tj = 2 * (wave & 1) + t2;
                const bool live = dir ? (tj >= ti) : (tj <= ti);
                f32x4 a4 = {0.f, 0.f, 0.f, 0.f};
                if (live) {
#pragma unroll
                    for (int ks = 0; ks < 8; ++ks) {
                        const bf16x8 a = *(const LAS bf16x8*)(L + QD_OFF + (ti * 16 + fr) * 528 + ks * 64 + fq * 16);
                        const bf16x8 bb = *(const LAS bf16x8*)(L + KD_OFF + (tj * 16 + fr) * 528 + ks * 64 + fq * 16);
                        a4 = __builtin_amdgcn_mfma_f32_16x16x32_bf16(a, bb, a4, 0, 0, 0);
                    }
                }
#pragma unroll
                for (int reg = 0; reg < 4; ++reg) { const int i = ti * 16 + 4 * fq + reg, j = tj * 16 + fr; const bool keep = dir ? (j >= i) : (j <= i);
                    *(LAS bf16_t*)(L + ATT_OFF + i * 144 + j * 2) = f2bf(keep ? a4[reg] : 0.f); }
            }
            GS_BAR();
            u32x2 vt[2][4][2], kt[2][2][2];
            asm volatile(
                "ds_read_b64_tr_b16 %0, %16 offset:0\n\tds_read_b64_tr_b16 %1, %16 offset:576\n\tds_read_b64_tr_b16 %2, %16 offset:32\n\tds_read_b64_tr_b16 %3, %16 offset:608\n\t"
                "ds_read_b64_tr_b16 %4, %16 offset:64\n\tds_read_b64_tr_b16 %5, %16 offset:640\n\tds_read_b64_tr_b16 %6, %16 offset:96\n\tds_read_b64_tr_b16 %7, %16 offset:672\n\t"
                "ds_read_b64_tr_b16 %8, %16 offset:4608\n\tds_read_b64_tr_b16 %9, %16 offset:5184\n\tds_read_b64_tr_b16 %10, %16 offset:4640\n\tds_read_b64_tr_b16 %11, %16 offset:5216\n\t"
                "ds_read_b64_tr_b16 %12, %16 offset:4672\n\tds_read_b64_tr_b16 %13, %16 offset:5248\n\tds_read_b64_tr_b16 %14, %16 offset:4704\n\tds_read_b64_tr_b16 %15, %16 offset:5280\n\t"
                "s_waitcnt lgkmcnt(0)"
                : "=&v"(vt[0][0][0]), "=&v"(vt[0][0][1]), "=&v"(vt[0][1][0]), "=&v"(vt[0][1][1]), "=&v"(vt[0][2][0]), "=&v"(vt[0][2][1]), "=&v"(vt[0][3][0]), "=&v"(vt[0][3][1]),
                  "=&v"(vt[1][0][0]), "=&v"(vt[1][0][1]), "=&v"(vt[1][1][0]), "=&v"(vt[1][1][1]), "=&v"(vt[1][2][0]), "=&v"(vt[1][2][1]), "=&v"(vt[1][3][0]), "=&v"(vt[1][3][1])
                : "v"(tr_lane_v) : "memory");
            asm volatile(
                "ds_read_b64_tr_b16 %0, %8 offset:0\n\tds_read_b64_tr_b16 %1, %8 offset:2112\n\tds_read_b64_tr_b16 %2, %8 offset:16896\n\tds_read_b64_tr_b16 %3, %8 offset:19008\n\t"
                "ds_read_b64_tr_b16 %4, %8 offset:32\n\tds_read_b64_tr_b16 %5, %8 offset:2144\n\tds_read_b64_tr_b16 %6, %8 offset:16928\n\tds_read_b64_tr_b16 %7, %8 offset:19040\n\t"
                "s_waitcnt lgkmcnt(0)"
                : "=&v"(kt[0][0][0]), "=&v"(kt[0][0][1]), "=&v"(kt[0][1][0]), "=&v"(kt[0][1][1]), "=&v"(kt[1][0][0]), "=&v"(kt[1][0][1]), "=&v"(kt[1][1][0]), "=&v"(kt[1][1][1])
                : "v"(tr_lane_k) : "memory");
#define GS_FRAG(x_) __builtin_bit_cast(bf16x8, (u32x4){(x_)[0].x, (x_)[0].y, (x_)[1].x, (x_)[1].y})
#pragma unroll
            for (int t2 = 0; t2 < 2; ++t2) {
                const int te = 2 * (wave & 1) + t2;
                f32x4 o4 = {0.f, 0.f, 0.f, 0.f};
#pragma unroll
                for (int ks = 0; ks < 8; ++ks) {
                    const bf16x8 a = *(const LAS bf16x8*)(L + QD_OFF + (ti * 16 + fr) * 528 + ks * 64 + fq * 16);
                    const bf16x8 bb = *(const LAS bf16x8*)(L + ST_OFF + (te * 16 + fr) * 528 + ks * 64 + fq * 16);
                    o4 = __builtin_amdgcn_mfma_f32_16x16x32_bf16(a, bb, o4, 0, 0, 0);
                }
#pragma unroll
                for (int ks = 0; ks < 2; ++ks) {
                    const bf16x8 a = *(const LAS bf16x8*)(L + ATT_OFF + (ti * 16 + fr) * 144 + ks * 64 + fq * 16);
                    const bf16x8 bb = (t2 == 0) ? ((wave & 1) ? GS_FRAG(vt[ks][2]) : GS_FRAG(vt[ks][0])) : ((wave & 1) ? GS_FRAG(vt[ks][3]) : GS_FRAG(vt[ks][1]));
                    o4 = __builtin_amdgcn_mfma_f32_16x16x32_bf16(a, bb, o4, 0, 0, 0);
                }
#pragma unroll
                for (int reg = 0; reg < 4; ++reg) { bf16_t* op = OF + (size_t)(tb + ti * 16 + 4 * fq + reg) * 2048 + head * 512 + slice * 64 + te * 16 + fr;
                    *op = f2bf(dir ? bf1(oold[t2][reg]) + o4[reg] : o4[reg]); }
            }
#pragma unroll
            for (int tdi = 0; tdi < 2; ++tdi)
#pragma unroll
                for (int te = 0; te < 4; ++te) {
                    f32x4 s4 = accS[tdi][te];
                    s4 = __builtin_amdgcn_mfma_f32_16x16x32_bf16(GS_FRAG(kt[tdi][0]), GS_FRAG(vt[0][te]), s4, 0, 0, 0);
                    s4 = __builtin_amdgcn_mfma_f32_16x16x32_bf16(GS_FRAG(kt[tdi][1]), GS_FRAG(vt[1][te]), s4, 0, 0, 0);
                    accS[tdi][te] = s4;
                }
        }
#undef GS_BAR
#undef GS_LOAD
#undef GS_FRAG
        if (!lat) {
            float* so = F.out + (size_t)T * D + soff;
#pragma unroll
            for (int tdi = 0; tdi < 2; ++tdi)
#pragma unroll
                for (int te = 0; te < 4; ++te)
#pragma unroll
                    for (int reg = 0; reg < 4; ++reg) {
                        const int dd = (2 * wave + tdi) * 16 + 4 * fq + reg, e = slice * 64 + te * 16 + fr;
                        so[(size_t)dd * 512 + e] = accS[tdi][te][reg];
                    }
        }
        __syncthreads();
      }
    }
}

__device__ __forceinline__ void phase_postgla(const Frame0& F0, int l) {
    PHASE_IDS(F0);
    const bf16_t* OF = B_OF(F); const bf16_t* R = F.Z3; unsigned char* BIN = (unsigned char*)B_BIN(F);
    float* BS = F.VS + 110592;
    for (int row = F.bid * 8 + F.wave; row < T; row += F.nb * 8) {
        float y[4][8]; float am = 0.f;
#pragma unroll
        for (int hh = 0; hh < 4; ++hh) {
            const int col = hh * 512 + F.lane * 8;
            const u32x4 a = *(const u32x4*)(OF + (size_t)row * D + col), r = *(const u32x4*)(R + (size_t)row * D + col);
            float o[8]; float ss = 0.f;
#pragma unroll
            for (int j = 0; j < 4; ++j) { o[2 * j] = bf_lo(a[j]); o[2 * j + 1] = bf_hi(a[j]); ss += o[2 * j] * o[2 * j] + o[2 * j + 1] * o[2 * j + 1]; }
            const float rn = rsqrtf(wsum(ss) * (1.f / 512.f) + LN_EPS);
            const float4 g0 = *(const float4*)(F.w_gn + (size_t)l * D + col), g1 = *(const float4*)(F.w_gn + (size_t)l * D + col + 4);
            const float gn[8] = {g0.x, g0.y, g0.z, g0.w, g1.x, g1.y, g1.z, g1.w};
#pragma unroll
            for (int j = 0; j < 4; ++j) { y[hh][2 * j] = o[2 * j] * rn * gn[2 * j] * siluf_(bf_lo(r[j])); y[hh][2 * j + 1] = o[2 * j + 1] * rn * gn[2 * j + 1] * siluf_(bf_hi(r[j]));
                am = fmaxf(am, fmaxf(fabsf(y[hh][2 * j]), fabsf(y[hh][2 * j + 1]))); }
        }
        am = wmax(am);
        const float bs = am > 0.f ? am * (1.f / 127.f) : 1.f, binv = 1.f / bs;
#pragma unroll
        for (int hh = 0; hh < 4; ++hh) { u32x2 w; w.x = pack_i8(y[hh][0] * binv, y[hh][1] * binv, y[hh][2] * binv, y[hh][3] * binv); w.y = pack_i8(y[hh][4] * binv, y[hh][5] * binv, y[hh][6] * binv, y[hh][7] * binv);
            *(u32x2*)(BIN + (size_t)row * D + hh * 512 + F.lane * 8) = w; }
        if (F.lane == 0) BS[row] = bs;
    }
}

__device__ __forceinline__ void phase_ln2(const Frame0& F0, int l) {
    PHASE_IDS(F0);
    const float* lg = F.ln_g + (size_t)(l * 2 + 0) * D; const float* lb = F.ln_b + (size_t)(l * 2 + 0) * D;
    const int stride = F.nb * 8;
    int row = F.bid * 8 + F.wave;
    unsigned char* H8 = (unsigned char*)F.Z3 + ((size_t)64 << 20);
    float4 v[8], lgv[8], lbv[8], shv[8], scv[8]; int cci = -1;
#pragma unroll
    for (int i = 0; i < 8; ++i) { lgv[i] = *(const float4*)(lg + i * 256 + F.lane * 4); lbv[i] = *(const float4*)(lb + i * 256 + F.lane * 4); }
    if (row < T) {
#pragma unroll
        for (int i = 0; i < 8; ++i) v[i] = ld_bf4(B_T1(F) + (size_t)row * D + i * 256 + F.lane * 4); }
    for (; row < T; row += stride) {
        float4 vn[8];
        const int nrow = row + stride;
        if (nrow < T) {
#pragma unroll
            for (int i = 0; i < 8; ++i) vn[i] = ld_bf4(B_T1(F) + (size_t)nrow * D + i * 256 + F.lane * 4); }
        else {
#pragma unroll
            for (int i = 0; i < 8; ++i) vn[i] = v[i]; }
        const int ci = cond_of(row);
        if (ci != cci) { const float* md = F.MOD + (size_t)(l * 9 + ci) * NADA; cci = ci;
#pragma unroll
            for (int i = 0; i < 8; ++i) { shv[i] = *(const float4*)(md + 3 * 2048 + i * 256 + F.lane * 4); scv[i] = *(const float4*)(md + 4 * 2048 + i * 256 + F.lane * 4); } }
        float s = 0.f;
#pragma unroll
        for (int i = 0; i < 8; ++i) s += (v[i].x + v[i].y) + (v[i].z + v[i].w);
        float mean = wsum(s) * (1.f / 2048.f); float q = 0.f;
#pragma unroll
        for (int i = 0; i < 8; ++i) { const float a = v[i].x - mean, b = v[i].y - mean, c = v[i].z - mean, d = v[i].w - mean; q += (a * a + b * b) + (c * c + d * d); }
        float rstd = rsqrtf(wsum(q) * (1.f / 2048.f) + LN_EPS);
        s = 0.f;
#pragma unroll
        for (int i = 0; i < 8; ++i) { const float4 g = lgv[i], bb = lbv[i];
            v[i].x = (v[i].x - mean) * rstd * g.x + bb.x; v[i].y = (v[i].y - mean) * rstd * g.y + bb.y; v[i].z = (v[i].z - mean) * rstd * g.z + bb.z; v[i].w = (v[i].w - mean) * rstd * g.w + bb.w;
            s += (v[i].x + v[i].y) + (v[i].z + v[i].w); }
        mean = wsum(s) * (1.f / 2048.f); q = 0.f;
#pragma unroll
        for (int i = 0; i < 8; ++i) { const float a = v[i].x - mean, b = v[i].y - mean, c = v[i].z - mean, d = v[i].w - mean; q += (a * a + b * b) + (c * c + d * d); }
        rstd = rsqrtf(wsum(q) * (1.f / 2048.f) + LN_EPS);
        float am = 0.f;
#pragma unroll
        for (int i = 0; i < 8; ++i) { const int col = i * 256 + F.lane * 4;
            const float4 sh = shv[i], sc = scv[i]; float4 h;
            h.x = (v[i].x - mean) * rstd * (1.f + sc.x) + sh.x; h.y = (v[i].y - mean) * rstd * (1.f + sc.y) + sh.y; h.z = (v[i].z - mean) * rstd * (1.f + sc.z) + sh.z; h.w = (v[i].w - mean) * rstd * (1.f + sc.w) + sh.w;
            u32x2 o; o.x = cvt_pk_bf16(h.x, h.y); o.y = cvt_pk_bf16(h.z, h.w);
            *(u32x2*)(F.H + (size_t)row * D + col) = o;
            v[i] = h; am = fmaxf(am, fmaxf(fmaxf(fabsf(h.x), fabsf(h.y)), fmaxf(fabsf(h.z), fabsf(h.w)))); }
        am = wmax(am);
        const float hs = am > 0.f ? am * (1.f / 127.f) : 1.f, hinv = 1.f / hs;
#pragma unroll
        for (int i = 0; i < 8; ++i) *(unsigned*)(H8 + (size_t)row * D + i * 256 + F.lane * 4) = pack_i8(v[i].x * hinv, v[i].y * hinv, v[i].z * hinv, v[i].w * hinv);
        if (F.lane == 0) F.VS[32768 + row] = hs;
#pragma unroll
        for (int i = 0; i < 8; ++i) v[i] = vn[i];
    }
}

__device__ __forceinline__ unsigned ord_u32(float f) { const unsigned u = __float_as_uint(f); return (u & 0x80000000u) ? ~u : (u | 0x80000000u); }
__device__ __forceinline__ float unord_f32(unsigned u) { return (u & 0x80000000u) ? __uint_as_float(u & 0x7fffffffu) : __uint_as_float(~u); }
__device__ __forceinline__ unsigned umax_(unsigned a, unsigned b) { return a > b ? a : b; }
__device__ __forceinline__ unsigned xmax4(unsigned m) { m = umax_(m, (unsigned)__shfl_xor((int)m, 16)); m = umax_(m, (unsigned)__shfl_xor((int)m, 32)); return m; }
__device__ __forceinline__ void phase_peer_score(const Frame0& F0, int l) {
    PHASE_IDS(F0);
    LAS unsigned char* L = F.lds;
    constexpr int KL_ROW = 272, LW_OFF = 2 * 128 * KL_ROW;
    constexpr int CA[52] = {0, 0, 0, 0, 0, 0, 0, 0, 0, 0, 0, 0, 0, 0, 0, 0, 1, 1, 1, 1, 1, 1, 1, 1, 2, 2, 2, 2, 2, 3, 3, 3, 3, 4, 4, 4, 5, 5, 6, 6, 7, 7, 8, 9, 10, 11, 12, 13, 14, 15, 0, 0};
    constexpr int CB[52] = {0, 1, 2, 3, 4, 5, 6, 7, 8, 9, 10, 11, 12, 13, 14, 15, 0, 1, 2, 3, 4, 5, 6, 7, 0, 1, 2, 3, 4, 0, 1, 2, 3, 0, 1, 2, 0, 1, 0, 1, 0, 1, 0, 0, 0, 0, 0, 0, 0, 0, 0, 0};
    const int tid = F.tid, lane = F.lane, wave = F.wave, fr = lane & 15, fq = lane >> 4;
    const bf16_t* QQ = B_QQ(F);
    int* PIDX = (int*)F.Z3; float* PGATE = (float*)((unsigned char*)F.Z3 + (size_t)T * 128 * 4);
    for (int i = tid; i < 2 * 128 * 128 / 4; i += 512) {
        const int idx = i * 4, side = idx >> 14, n = (idx >> 7) & 127, dd = idx & 127;
        const float4 v = *(const float4*)(F.pkeys + (size_t)l * 2 * 128 * 128 + idx);
        u32x2 w; w.x = cvt_pk_bf16(v.x, v.y); w.y = cvt_pk_bf16(v.z, v.w);
        *(LAS u32x2*)(L + (side * 128 + n) * KL_ROW + dd * 2) = w;
    }
    __syncthreads();
    LAS int* nbuf = (LAS int*)(L + LW_OFF + wave * 4096);
    LAS float* vbuf = (LAS float*)(L + LW_OFF + wave * 4096 + 2048);
    bf16x8 bqn[2][4];
    { const int task0 = F.bid * 8 + wave; if (task0 < (T / 16) * 8) { const int tok0 = (task0 >> 3) * 16 + fr, h0 = task0 & 7;
#pragma unroll
        for (int side = 0; side < 2; ++side)
#pragma unroll
            for (int ks = 0; ks < 4; ++ks) bqn[side][ks] = *(const bf16x8*)(QQ + (size_t)tok0 * D + h0 * 256 + side * 128 + ks * 32 + fq * 8); } }
    for (int task = F.bid * 8 + wave; task < (T / 16) * 8; task += F.nb * 8) {
        const int tg = task >> 3, h = task & 7, tok = tg * 16 + fr;
        unsigned key0[32], key1[32];
#pragma unroll
        for (int side = 0; side < 2; ++side)
#pragma unroll
            for (int tile = 0; tile < 8; ++tile) {
                f32x4 s4 = {0.f, 0.f, 0.f, 0.f};
#pragma unroll
                for (int ks = 0; ks < 4; ++ks) {
                    const bf16x8 a = *(const LAS bf16x8*)(L + (side * 128 + tile * 16 + fr) * KL_ROW + ks * 64 + fq * 16);
                    s4 = __builtin_amdgcn_mfma_f32_16x16x32_bf16(a, bqn[side][ks], s4, 0, 0, 0);
                }
#pragma unroll
                for (int reg = 0; reg < 4; ++reg) { const unsigned kv = (ord_u32(s4[reg]) & ~127u) | (unsigned)(127 - (tile * 16 + 4 * fq + reg)); if (side == 0) key0[tile * 4 + reg] = kv; else key1[tile * 4 + reg] = kv; }
                if (tile & 1) __builtin_amdgcn_sched_barrier(0);
            }
        { const int ntask = task + F.nb * 8; if (ntask < (T / 16) * 8) { const int tokn = (ntask >> 3) * 16 + fr, hn = ntask & 7;
#pragma unroll
            for (int side = 0; side < 2; ++side)
#pragma unroll
                for (int ks = 0; ks < 4; ++ks) bqn[side][ks] = *(const bf16x8*)(QQ + (size_t)tokn * D + hn * 256 + side * 128 + ks * 32 + fq * 8); } }
        float v1[16], v2[16];
#pragma unroll
        for (int side = 0; side < 2; ++side) {
#pragma unroll
            for (int r = 0; r < 16; ++r) {
                unsigned m = side == 0 ? key0[0] : key1[0];
#pragma unroll
                for (int i = 1; i < 32; ++i) m = umax_(m, side == 0 ? key0[i] : key1[i]);
                m = xmax4(m);
#pragma unroll
                for (int i = 0; i < 32; ++i) { if (side == 0) key0[i] = (key0[i] == m) ? 0u : key0[i]; else key1[i] = (key1[i] == m) ? 0u : key1[i]; }
                const float val = unord_f32(m & ~127u);
                if (side == 0) v1[r] = val; else v2[r] = val;
                if (fq == 0) { nbuf[fr * 32 + side * 16 + r] = 127 - (int)(m & 127u); vbuf[fr * 32 + side * 16 + r] = val; }
            }
        }
        unsigned ck[13];
#pragma unroll
        for (int s = 0; s < 13; ++s) {
            const float x0 = v1[CA[4 * s]] + v2[CB[4 * s]], x1 = v1[CA[4 * s + 1]] + v2[CB[4 * s + 1]], x2 = v1[CA[4 * s + 2]] + v2[CB[4 * s + 2]], x3 = v1[CA[4 * s + 3]] + v2[CB[4 * s + 3]];
            const int c0 = CA[4 * s] * 16 + CB[4 * s], c1 = CA[4 * s + 1] * 16 + CB[4 * s + 1], c2 = CA[4 * s + 2] * 16 + CB[4 * s + 2], c3 = CA[4 * s + 3] * 16 + CB[4 * s + 3];
            const float xv = fq == 0 ? x0 : (fq == 1 ? x1 : (fq == 2 ? x2 : x3));
            const int cv = fq == 0 ? c0 : (fq == 1 ? c1 : (fq == 2 ? c2 : c3));
            const bool valid = (4 * s + fq) < 50;
            ck[s] = valid ? ((ord_u32(xv) & ~255u) | (unsigned)(255 - cv)) : 0u;
        }
        unsigned cw[16];
#pragma unroll
        for (int r = 0; r < 16; ++r) {
            unsigned m = ck[0];
#pragma unroll
            for (int i = 1; i < 13; ++i) m = umax_(m, ck[i]);
            m = xmax4(m);
#pragma unroll
            for (int i = 0; i < 13; ++i) ck[i] = (ck[i] == m) ? 0u : ck[i];
            cw[r] = m;
        }
        asm volatile("s_waitcnt lgkmcnt(0)" ::: "memory");
        __builtin_amdgcn_wave_barrier();
        float sv[4]; int ix[4];
#pragma unroll
        for (int i = 0; i < 4; ++i) {
            const unsigned m = fq == 0 ? cw[4 * i] : (fq == 1 ? cw[4 * i + 1] : (fq == 2 ? cw[4 * i + 2] : cw[4 * i + 3]));
            const int code = 255 - (int)(m & 255u), a = code >> 4, b = code & 15;
            ix[i] = nbuf[fr * 32 + a] * 128 + nbuf[fr * 32 + 16 + b];
            sv[i] = vbuf[fr * 32 + a] + vbuf[fr * 32 + 16 + b];
        }
        float mx = fmaxf(fmaxf(sv[0], sv[1]), fmaxf(sv[2], sv[3]));
        mx = fmaxf(mx, __shfl_xor(mx, 16)); mx = fmaxf(mx, __shfl_xor(mx, 32));
        float ev[4], es = 0.f;
#pragma unroll
        for (int i = 0; i < 4; ++i) { ev[i] = __expf(sv[i] - mx); es += ev[i]; }
        es += __shfl_xor(es, 16); es += __shfl_xor(es, 32);
        const float inv = 1.f / es;
#pragma unroll
        for (int i = 0; i < 4; ++i) { const size_t o = ((size_t)tok * 8 + h) * 16 + 4 * i + fq; PIDX[o] = ix[i]; PGATE[o] = ev[i] * inv; }
        asm volatile("s_waitcnt lgkmcnt(0)" ::: "memory");
        __builtin_amdgcn_wave_barrier();
    }
}

constexpr int PE_NG = 32, PE_NJ = 8, PE_NTB = T / 128, PE_BI = 16384;
constexpr size_t NPAIR = (size_t)T * 128;
constexpr size_t PE_ITEMS_OFF = 0, PE_VLIST_OFF = (size_t)32 << 20, PE_BLKOFF_OFF = (size_t)64 << 20, PE_GATES_OFF = (size_t)72 << 20;
__device__ __forceinline__ unsigned lds_add(LAS unsigned* p, unsigned v) { return __hip_atomic_fetch_add(p, v, __ATOMIC_RELAXED, __HIP_MEMORY_SCOPE_WORKGROUP); }
__device__ __forceinline__ void phase_peer_bucket(const Frame0& F0) {
    PHASE_IDS(F0);
    LAS unsigned* cnt = (LAS unsigned*)F.lds;
    LAS unsigned* base = cnt + 256;
    LAS unsigned* gstart = base + 256;
    const int* PIDX = (const int*)F.Z3;
    unsigned* ITEMS = (unsigned*)((unsigned char*)F.Z1 + PE_ITEMS_OFF); int* BLKOFF = (int*)((unsigned char*)F.Z1 + PE_BLKOFF_OFF);
    float* GATES = (float*)((unsigned char*)F.Z1 + PE_GATES_OFF); const float* PGATE = (const float*)((const unsigned char*)F.Z3 + (size_t)T * 128 * 4);
    const int tid = F.tid, lane = F.lane, wave = F.wave;
    for (int tb = F.bid; tb < PE_NTB; tb += F.nb) {
        if (tid < 256) cnt[tid] = 0u;
        __syncthreads();
        unsigned myidx[32];
#pragma unroll
        for (int k = 0; k < 32; ++k) { myidx[k] = (unsigned)PIDX[(size_t)tb * PE_BI + tid + 512 * k]; (void)lds_add(&cnt[wave * 32 + (myidx[k] >> 9)], 1u); }
        __syncthreads();
        if (tid < 64) {
            unsigned s = 0u;
            if (tid < 32) {
#pragma unroll
                for (int w = 0; w < 8; ++w) { const unsigned c = cnt[w * 32 + tid]; base[w * 32 + tid] = s; s += c; }
            }
            unsigned incl = s;
#pragma unroll
            for (int off = 1; off < 32; off <<= 1) { const unsigned v = (unsigned)__shfl_up((int)incl, off); if (lane >= off) incl += v; }
            if (tid < 32) {
                const unsigned excl = incl - s; gstart[tid] = excl; if (tid == 31) gstart[32] = incl;
#pragma unroll
                for (int w = 0; w < 8; ++w) base[w * 32 + tid] += excl;
            }
        }
        __syncthreads();
        if (tid < 33) BLKOFF[tb * 33 + tid] = (int)gstart[tid];
        if (tid < 256) cnt[tid] = 0u;
        __syncthreads();
#pragma unroll
        for (int k = 0; k < 32; ++k) { const int i = tid + 512 * k; const unsigned g = myidx[k] >> 9; const unsigned p = lds_add(&cnt[wave * 32 + g], 1u); const unsigned pos = base[wave * 32 + g] + p;
            ITEMS[(size_t)tb * PE_BI + pos] = ((unsigned)(i >> 7) << 21) | ((unsigned)(i & 127) << 14) | myidx[k]; }
        __syncthreads();
    }
}
__device__ __forceinline__ void phase_peer_u(const Frame0& F0, int l) {
    PHASE_IDS(F0);
    const float* PU = F.peer_u + (size_t)l * 16384 * D;
    LAS unsigned char* L = F.lds;
    constexpr int WROW = 272, P_OFF = 512 * WROW;
    LAS int* P = (LAS int*)(L + P_OFF);
    LAS int* B0 = P + 292;
    LAS int* WT = B0 + 288;
    const unsigned char* H2 = (const unsigned char*)F.Z3 + ((size_t)64 << 20);
    const unsigned* ITEMS = (const unsigned*)((unsigned char*)F.Z1 + PE_ITEMS_OFF); const int* BLKOFF = (const int*)((unsigned char*)F.Z1 + PE_BLKOFF_OFF);
    bf16_t* PART = (bf16_t*)F.Z2;
    const int tid = F.tid, lane = F.lane, wave = F.wave;
    for (int u = F.bid; u < PE_NG * PE_NJ; u += F.nb) {
        const int j = u & 7, g = u >> 3;
        __syncthreads();
        for (int i = tid; i < 512 * 16; i += 512) { const int row = i >> 4, c = i & 15;
            const float* sp = PU + (size_t)(g * 512 + row) * D + j * 256 + c * 16; const float4 a = ((const float4*)sp)[0], b = ((const float4*)sp)[1], cq = ((const float4*)sp)[2], dq = ((const float4*)sp)[3];
            const float ui = 1.f / F.VS[16384 + g * 512 + row];
            u32x4 v; v.x = pack_i8(a.x * ui, a.y * ui, a.z * ui, a.w * ui); v.y = pack_i8(b.x * ui, b.y * ui, b.z * ui, b.w * ui); v.z = pack_i8(cq.x * ui, cq.y * ui, cq.z * ui, cq.w * ui); v.w = pack_i8(dq.x * ui, dq.y * ui, dq.z * ui, dq.w * ui);
            *(LAS u32x4*)(L + row * WROW + c * 16) = v; }
        int c = 0;
        if (tid < PE_NTB) { const int b0 = BLKOFF[tid * 33 + g]; c = BLKOFF[tid * 33 + g + 1] - b0; B0[tid] = b0; }
        int incl = c;
#pragma unroll
        for (int off = 1; off < 64; off <<= 1) { const int v = __shfl_up(incl, off); if (lane >= off) incl += v; }
        if (lane == 63) WT[wave] = incl;
        __syncthreads();
        int woff = 0;
#pragma unroll
        for (int w = 0; w < 8; ++w) woff += (w < wave) ? WT[w] : 0;
        if (tid < PE_NTB) P[tid + 1] = incl + woff;
        if (tid == 0) P[0] = 0;
        __syncthreads();
        const int total = P[PE_NTB];
        const int sub = lane & 3;
        int tbw = 0;
        const unsigned char* hbase = H2 + j * 256 + sub * 16;
        const LAS unsigned char* wbase = L + sub * 16;
        bf16_t* partj = PART + (size_t)j * NPAIR;
#define PU_ISSUE(qb_, S) do { const int q_ = (qb_) + lane; S##ok = q_ < total; S##pp = 0; S##tb = 0; S##raw = 0u; \
            if (S##ok) { while (q_ >= P[tbw + 1]) ++tbw; S##pp = tbw * PE_BI + B0[tbw] + (q_ - P[tbw]); S##tb = tbw * 128; S##raw = ITEMS[S##pp]; } } while (0)
#define PU_BCAST(x_, r_) __builtin_amdgcn_update_dpp(0, (x_), (r_) * 0x55, 0xf, 0xf, true)
#define PU_LH1(TE_, H0_, H1_, r_) { const int bc_ = PU_BCAST(TE_, r_); TE_##e[r_] = bc_ & 511; const unsigned char* hp_ = hbase + (size_t)(bc_ >> 9) * D; H0_[2 * (r_)] = *(const u32x4*)(hp_); H0_[2 * (r_) + 1] = *(const u32x4*)(hp_ + 64); H1_[2 * (r_)] = *(const u32x4*)(hp_ + 128); H1_[2 * (r_) + 1] = *(const u32x4*)(hp_ + 192); }
#define PU_LOADH(S, TE_, H0_, H1_) do { TE_ = (int)(((unsigned)(S##tb + (int)(S##raw >> 21)) << 9) | (S##raw & 511u)); \
            PU_LH1(TE_, H0_, H1_, 0) PU_LH1(TE_, H0_, H1_, 1) PU_LH1(TE_, H0_, H1_, 2) PU_LH1(TE_, H0_, H1_, 3) } while (0)
#define PU_DPP_ADD(x_, ctrl_) ((x_) + __builtin_amdgcn_update_dpp(0, (x_), (ctrl_), 0xf, 0xf, true))
#define PU_D4(h_, w_) s0_ = __builtin_amdgcn_sdot4((int)(h_).x, (int)(w_).x, s0_, false); s1_ = __builtin_amdgcn_sdot4((int)(h_).y, (int)(w_).y, s1_, false); \
                s0_ = __builtin_amdgcn_sdot4((int)(h_).z, (int)(w_).z, s0_, false); s1_ = __builtin_amdgcn_sdot4((int)(h_).w, (int)(w_).w, s1_, false);
#define PU_C1(TE_, H0_, H1_, r_) { const LAS unsigned char* wp_ = wbase + TE_##e[r_] * WROW; \
                const u32x4 w0_ = *(const LAS u32x4*)(wp_), w1_ = *(const LAS u32x4*)(wp_ + 64), w2_ = *(const LAS u32x4*)(wp_ + 128), w3_ = *(const LAS u32x4*)(wp_ + 192); int s0_ = 0, s1_ = 0; \
                PU_D4(H0_[2 * (r_)], w0_) PU_D4(H0_[2 * (r_) + 1], w1_) PU_D4(H1_[2 * (r_)], w2_) PU_D4(H1_[2 * (r_) + 1], w3_) \
                int sm_ = s0_ + s1_; sm_ = PU_DPP_ADD(sm_, 0x4e); sm_ = PU_DPP_ADD(sm_, 0xb1);   \
                keep_ = (sub == r_) ? sm_ : keep_; }
#define PU_COMPUTE(S, TE_, H0_, H1_) do { int keep_ = 0; \
            PU_C1(TE_, H0_, H1_, 0) PU_C1(TE_, H0_, H1_, 1) PU_C1(TE_, H0_, H1_, 2) PU_C1(TE_, H0_, H1_, 3) \
            if (S##ok) partj[S##pp] = f2bf((float)keep_); } while (0)
        u32x4 hA0[8], hA1[8], hB0[8], hB1[8]; int teA, teB, teAe[8], teBe[8];
        bool s0ok, s1ok, s2ok, s3ok; int s0pp, s1pp, s2pp, s3pp, s0tb, s1tb, s2tb, s3tb; unsigned s0raw, s1raw, s2raw, s3raw;
        int qb = wave * 64;
        PU_ISSUE(qb, s0); PU_ISSUE(qb + 512, s1); PU_ISSUE(qb + 1024, s2);
        PU_LOADH(s0, teA, hA0, hA1);
        for (; qb < total; qb += 2048) {
            PU_ISSUE(qb + 1536, s3); PU_LOADH(s1, teB, hB0, hB1); PU_COMPUTE(s0, teA, hA0, hA1);
            PU_ISSUE(qb + 2048, s0); PU_LOADH(s2, teA, hA0, hA1); PU_COMPUTE(s1, teB, hB0, hB1);
            PU_ISSUE(qb + 2560, s1); PU_LOADH(s3, teB, hB0, hB1); PU_COMPUTE(s2, teA, hA0, hA1);
            PU_ISSUE(qb + 3072, s2); PU_LOADH(s0, teA, hA0, hA1); PU_COMPUTE(s3, teB, hB0, hB1);
        }
#undef PU_ISSUE
#undef PU_BCAST
#undef PU_LOADH
#undef PU_LH1
#undef PU_C1
#undef PU_D4
#undef PU_DPP_ADD
#undef PU_COMPUTE
    }
}
__device__ __forceinline__ void phase_peer_coef(const Frame0& F0) {
    PHASE_IDS(F0);
    const unsigned* ITEMS = (const unsigned*)((unsigned char*)F.Z1 + PE_ITEMS_OFF); unsigned* VLIST = (unsigned*)((unsigned char*)F.Z1 + PE_VLIST_OFF);
    const bf16_t* PART = (const bf16_t*)F.Z2; const float* PGATE = (const float*)((const unsigned char*)F.Z3 + (size_t)T * 128 * 4);
    for (int Lu = F.bid; Lu < PE_NTB * 8; Lu += F.nb) {
        int tb, su;
        if (F.nb == 256) { const int k = Lu >> 8, b = Lu & 255; tb = k * 32 + (b & 7) * 4 + (b >> 6); su = (b >> 3) & 7; } else { tb = Lu >> 3; su = Lu & 7; }
        const size_t p0 = (size_t)tb * PE_BI + su * 2048 + F.tid;
        unsigned item[4]; float s[4], gt[4], vs[4], qs[4];
#pragma unroll
        for (int r = 0; r < 4; ++r) { item[r] = ITEMS[p0 + r * 512]; s[r] = 0.f; }
#pragma unroll
        for (int r = 0; r < 4; ++r) { const size_t p = p0 + r * 512;
#pragma unroll
            for (int j = 0; j < PE_NJ; ++j) s[r] += bf1(PART[(size_t)j * NPAIR + p]); }
#pragma unroll
        for (int r = 0; r < 4; ++r) { const int t = tb * 128 + (int)(item[r] >> 21), slot = (int)((item[r] >> 14) & 127u);
            gt[r] = PGATE[(size_t)t * 128 + slot]; vs[r] = F.VS[item[r] & 16383u]; qs[r] = F.VS[16384 + (item[r] & 16383u)] * F.VS[32768 + t]; }
#pragma unroll
        for (int r = 0; r < 4; ++r) { const int t = tb * 128 + (int)(item[r] >> 21), slot = (int)((item[r] >> 14) & 127u); const unsigned idx = item[r] & 16383u;
            const float coef = gt[r] * gelu_tanh(s[r] * qs[r]) * vs[r];
            VLIST[((size_t)(t >> 6) * 128 + slot) * 64 + (t & 63)] = (idx << 16) | (unsigned)f2bf(coef); }
    }
}
constexpr size_t PE_PK_OFF = (size_t)80 << 20;
__device__ __forceinline__ void phase_peer_pack(const Frame0& F0) {
    PHASE_IDS(F0);
    const unsigned* VLIST = (const unsigned*)((unsigned char*)F.Z1 + PE_VLIST_OFF); unsigned* PK = (unsigned*)((unsigned char*)F.Z1 + PE_PK_OFF);
    float* CT = F.VS + 73728;
    for (int tw = F.bid + F.wave * F.nb; tw < T / 64; tw += 8 * F.nb) {
        const int t = tw * 64 + F.lane;
        const unsigned* vl = VLIST + (size_t)(t >> 6) * 8192 + (t & 63);
        float cm = 0.f;
#pragma unroll 1
        for (int kh = 0; kh < 2; ++kh) {
            unsigned it[64];
#pragma unroll
            for (int k = 0; k < 64; ++k) it[k] = vl[(kh * 64 + k) * 64];
#pragma unroll
            for (int k = 0; k < 64; ++k) cm = fmaxf(cm, fabsf(__uint_as_float(it[k] << 16)));
        }
        const float ct = cm > 0.f ? cm * (1.f / 127.f) : 1.f, cinv = 1.f / ct;
        unsigned* pk = PK + (size_t)(t >> 6) * (32 * 3 * 64) + (t & 63);
#pragma unroll 1
        for (int kh = 0; kh < 2; ++kh) {
            unsigned it[64];
#pragma unroll
            for (int k = 0; k < 64; ++k) it[k] = vl[(kh * 64 + k) * 64];
#pragma unroll
            for (int q = 0; q < 16; ++q) { const unsigned w0 = it[4 * q], w1 = it[4 * q + 1], w2 = it[4 * q + 2], w3 = it[4 * q + 3];
                unsigned* o = pk + (size_t)((kh * 16 + q) * 3) * 64;
                o[0] = (w0 >> 16) | (w1 & 0xffff0000u); o[64] = (w2 >> 16) | (w3 & 0xffff0000u);
                o[128] = pack_i8(__uint_as_float(w0 << 16) * cinv, __uint_as_float(w1 << 16) * cinv, __uint_as_float(w2 << 16) * cinv, __uint_as_float(w3 << 16) * cinv); }
        }
        CT[t] = ct;
    }
}
__device__ __forceinline__ void phase_peer_v(const Frame0& F0) {
    PHASE_IDS(F0);
    LAS unsigned char* L = F.lds;
    const unsigned char* V8 = F.V8; const unsigned* PK = (const unsigned*)((unsigned char*)F.Z1 + PE_PK_OFF);
    const float* CT = F.VS + 73728;
    float* FBUF = (float*)F.Z2;
    const int tid = F.tid;
    for (int u0 = F.bid; u0 < 256; u0 += F.nb) {
        const int u = (F.nb == 256) ? (u0 & 7) * 32 + (u0 >> 3) : u0;
        __syncthreads();
        for (int e = tid; e < 16384; e += 512) { const u32x2 v = *(const u32x2*)(V8 + (size_t)e * 2048 + u * 8); *(LAS u32x2*)(L + e * 8) = v; }
        __syncthreads();
        unsigned la[48], lb[48];
#define PV_LOAD(dst, t_, kb_) do { const unsigned* pk_ = PK + (size_t)((t_) >> 6) * (32 * 3 * 64) + ((t_) & 63) + (size_t)(kb_) * 48 * 64; \
            _Pragma("unroll") for (int i_ = 0; i_ < 48; ++i_) dst[i_] = pk_[i_ * 64]; } while (0)
#define PV_QUAD(src, q_) do { const unsigned d0_ = src[3 * (q_)], d1_ = src[3 * (q_) + 1], cq_ = src[3 * (q_) + 2]; \
            const u32x2 x0_ = *(const LAS u32x2*)(L + (d0_ & 0xffffu) * 8), x1_ = *(const LAS u32x2*)(L + (d0_ >> 16) * 8), x2_ = *(const LAS u32x2*)(L + (d1_ & 0xffffu) * 8), x3_ = *(const LAS u32x2*)(L + (d1_ >> 16) * 8); \
            { const unsigned tl01 = __builtin_amdgcn_perm(x1_.x, x0_.x, 0x05010400u), th01 = __builtin_amdgcn_perm(x1_.x, x0_.x, 0x07030602u), tl23 = __builtin_amdgcn_perm(x3_.x, x2_.x, 0x05010400u), th23 = __builtin_amdgcn_perm(x3_.x, x2_.x, 0x07030602u); \
              a0 = __builtin_amdgcn_sdot4((int)__builtin_amdgcn_perm(tl23, tl01, 0x05040100u), (int)cq_, a0, false); a1 = __builtin_amdgcn_sdot4((int)__builtin_amdgcn_perm(tl23, tl01, 0x07060302u), (int)cq_, a1, false); \
              a2 = __builtin_amdgcn_sdot4((int)__builtin_amdgcn_perm(th23, th01, 0x05040100u), (int)cq_, a2, false); a3 = __builtin_amdgcn_sdot4((int)__builtin_amdgcn_perm(th23, th01, 0x07060302u), (int)cq_, a3, false); } \
            { const unsigned tl01 = __builtin_amdgcn_perm(x1_.y, x0_.y, 0x05010400u), th01 = __builtin_amdgcn_perm(x1_.y, x0_.y, 0x07030602u), tl23 = __builtin_amdgcn_perm(x3_.y, x2_.y, 0x05010400u), th23 = __builtin_amdgcn_perm(x3_.y, x2_.y, 0x07030602u); \
              a4 = __builtin_amdgcn_sdot4((int)__builtin_amdgcn_perm(tl23, tl01, 0x05040100u), (int)cq_, a4, false); a5 = __builtin_amdgcn_sdot4((int)__builtin_amdgcn_perm(tl23, tl01, 0x07060302u), (int)cq_, a5, false); \
              a6 = __builtin_amdgcn_sdot4((int)__builtin_amdgcn_perm(th23, th01, 0x05040100u), (int)cq_, a6, false); a7 = __builtin_amdgcn_sdot4((int)__builtin_amdgcn_perm(th23, th01, 0x07060302u), (int)cq_, a7, false); } } while (0)
#define PV_BATCH(src) do { _Pragma("unroll") for (int q_ = 0; q_ < 16; ++q_) { PV_QUAD(src, q_); if ((q_ & 3) == 3) __builtin_amdgcn_sched_barrier(0); } } while (0)
        PV_LOAD(la, tid, 0);
        for (int t = tid; t < T; t += 512) {
            int a0 = 0, a1 = 0, a2 = 0, a3 = 0, a4 = 0, a5 = 0, a6 = 0, a7 = 0;
            const float ct = CT[t];
            const int tn = (t + 512 < T) ? t + 512 : t;
            PV_LOAD(lb, t, 1); PV_BATCH(la);
            PV_LOAD(la, tn, 0); PV_BATCH(lb);
            f32x4 o0 = {(float)a0 * ct, (float)a1 * ct, (float)a2 * ct, (float)a3 * ct}, o1 = {(float)a4 * ct, (float)a5 * ct, (float)a6 * ct, (float)a7 * ct};
            *(f32x4*)(FBUF + (size_t)t * D + u * 8) = o0; *(f32x4*)(FBUF + (size_t)t * D + u * 8 + 4) = o1;
        }
#undef PV_LOAD
#undef PV_QUAD
#undef PV_BATCH
    }
}
__device__ __forceinline__ void phase_peer_final(const Frame0& F0, int l) {
    PHASE_IDS(F0);
    const float* FBUF = (const float*)F.Z2;
    const float* lg = F.ln_g + (size_t)(l * 2 + 1) * D; const float* lb = F.ln_b + (size_t)(l * 2 + 1) * D;
    const float* lg0 = F.ln_g + (size_t)(l * 2 + 0) * D; const float* lb0 = F.ln_b + (size_t)(l * 2 + 0) * D;
    LAS float* PL = (LAS float*)F.lds;
    for (int i = F.tid; i < 2048; i += 512) { PL[i] = lg0[i]; PL[2048 + i] = lb0[i]; PL[4096 + i] = lg[i]; PL[6144 + i] = lb[i]; }
    __syncthreads();
    const int stride = F.nb * 8;
    int row = F.bid * 8 + F.wave;
    float4 xv[8], g2v[8]; int cci = -1;
    if (row < T) {
#pragma unroll
        for (int i = 0; i < 8; ++i) xv[i] = ld_bf4(B_T1(F) + (size_t)row * D + i * 256 + F.lane * 4); }
    for (; row < T; row += stride) {
        float4 xn[8], fv[8];
#pragma unroll
        for (int i = 0; i < 8; ++i) fv[i] = *(const float4*)(FBUF + (size_t)row * D + i * 256 + F.lane * 4);
        const int nrow = row + stride;
        if (nrow < T) {
#pragma unroll
            for (int i = 0; i < 8; ++i) xn[i] = ld_bf4(B_T1(F) + (size_t)nrow * D + i * 256 + F.lane * 4); }
        else {
#pragma unroll
            for (int i = 0; i < 8; ++i) xn[i] = xv[i]; }
        int lo4 = F.lane * 4; asm volatile("" : "+v"(lo4));
        {
            float s0 = 0.f;
#pragma unroll
            for (int i = 0; i < 8; ++i) s0 += (xv[i].x + xv[i].y) + (xv[i].z + xv[i].w);
            const float mean0 = wsum(s0) * (1.f / 2048.f); float q0 = 0.f;
#pragma unroll
            for (int i = 0; i < 8; ++i) { const float a = xv[i].x - mean0, b = xv[i].y - mean0, c = xv[i].z - mean0, d = xv[i].w - mean0; q0 += (a * a + b * b) + (c * c + d * d); }
            const float rstd0 = rsqrtf(wsum(q0) * (1.f / 2048.f) + LN_EPS);
#pragma unroll
            for (int i = 0; i < 8; ++i) { const f32x4 g = *(const LAS f32x4*)(PL + i * 256 + lo4), bb = *(const LAS f32x4*)(PL + 2048 + i * 256 + lo4);
                xv[i].x = (xv[i].x - mean0) * rstd0 * g.x + bb.x; xv[i].y = (xv[i].y - mean0) * rstd0 * g.y + bb.y; xv[i].z = (xv[i].z - mean0) * rstd0 * g.z + bb.z; xv[i].w = (xv[i].w - mean0) * rstd0 * g.w + bb.w; }
        }
        float* xr = F.XA + (size_t)row * D;
        const int ci = cond_of(row);
        if (ci != cci) { const float* g2 = F.MOD + (size_t)(l * 9 + ci) * NADA + 5 * 2048; cci = ci;
#pragma unroll
            for (int i = 0; i < 8; ++i) g2v[i] = *(const float4*)(g2 + i * 256 + F.lane * 4); }
        float4 v[8]; float s = 0.f;
#pragma unroll
        for (int i = 0; i < 8; ++i) { const float4 x = xv[i], g = g2v[i], f = fv[i];
            v[i].x = ALPHA * x.x + g.x * f.x; v[i].y = ALPHA * x.y + g.y * f.y; v[i].z = ALPHA * x.z + g.z * f.z; v[i].w = ALPHA * x.w + g.w * f.w; s += (v[i].x + v[i].y) + (v[i].z + v[i].w); }
        float mean = wsum(s) * (1.f / 2048.f); float q = 0.f;
#pragma unroll
        for (int i = 0; i < 8; ++i) { const float a = v[i].x - mean, b = v[i].y - mean, c = v[i].z - mean, d = v[i].w - mean; q += (a * a + b * b) + (c * c + d * d); }
        float rstd = rsqrtf(wsum(q) * (1.f / 2048.f) + LN_EPS);
        s = 0.f;
#pragma unroll
        for (int i = 0; i < 8; ++i) { const int col = i * 256 + F.lane * 4; const f32x4 g = *(const LAS f32x4*)(PL + 4096 + i * 256 + lo4), bb = *(const LAS f32x4*)(PL + 6144 + i * 256 + lo4);
            v[i].x = (v[i].x - mean) * rstd * g.x + bb.x; v[i].y = (v[i].y - mean) * rstd * g.y + bb.y; v[i].z = (v[i].z - mean) * rstd * g.z + bb.z; v[i].w = (v[i].w - mean) * rstd * g.w + bb.w;
            *(float4*)(xr + col) = v[i]; s += (v[i].x + v[i].y) + (v[i].z + v[i].w); }
        if (l == 0) {
            const float* md = F.MOD + (size_t)(9 + ci) * NADA;
            float4 shn[8], scn[8];
#pragma unroll
            for (int i = 0; i < 8; ++i) { shn[i] = *(const float4*)(md + i * 256 + F.lane * 4); scn[i] = *(const float4*)(md + 2048 + i * 256 + F.lane * 4); }
            mean = wsum(s) * (1.f / 2048.f); q = 0.f;
#pragma unroll
            for (int i = 0; i < 8; ++i) { const float a = v[i].x - mean, b = v[i].y - mean, c = v[i].z - mean, d = v[i].w - mean; q += (a * a + b * b) + (c * c + d * d); }
            rstd = rsqrtf(wsum(q) * (1.f / 2048.f) + LN_EPS);
            float am = 0.f;
#pragma unroll
            for (int i = 0; i < 8; ++i) { const int col = i * 256 + F.lane * 4;
                const float4 sh = shn[i], sc = scn[i];
                float4 h; h.x = (v[i].x - mean) * rstd * (1.f + sc.x) + sh.x; h.y = (v[i].y - mean) * rstd * (1.f + sc.y) + sh.y; h.z = (v[i].z - mean) * rstd * (1.f + sc.z) + sh.z; h.w = (v[i].w - mean) * rstd * (1.f + sc.w) + sh.w;
                if (row < TCTX) { u32x2 o; o.x = cvt_pk_bf16(h.x, h.y); o.y = cvt_pk_bf16(h.z, h.w); *(u32x2*)(F.H + (size_t)row * D + col) = o; }
                v[i] = h; am = fmaxf(am, fmaxf(fmaxf(fabsf(h.x), fabsf(h.y)), fmaxf(fabsf(h.z), fabsf(h.w)))); }
            am = wmax(am);
            const float hs = am > 0.f ? am * (1.f / 127.f) : 1.f, hinv = 1.f / hs;
#pragma unroll
            for (int i = 0; i < 8; ++i) *(unsigned*)(F.ws + WS_H8IN + (size_t)row * D + i * 256 + F.lane * 4) = pack_i8(v[i].x * hinv, v[i].y * hinv, v[i].z * hinv, v[i].w * hinv);
            if (F.lane == 0) ((float*)(F.ws + WS_HSIN))[row] = hs;
        }
#pragma unroll
        for (int i = 0; i < 8; ++i) xv[i] = xn[i];
    }
}

constexpr int N_PHASES = 25;
__global__ void __launch_bounds__(512, 2) hybrid_fwd(Args args) {
    extern __shared__ __attribute__((aligned(16))) unsigned char lds_raw[];
    Frame0 F; F.lds = (LAS unsigned char*)lds_raw;
    const int lo = args.ph_lo, hi = args.ph_hi;
#if MK_ONE_LAUNCH
    volatile LAS unsigned* misc = (volatile LAS unsigned*)(F.lds + MISC_OFF);
    if (threadIdx.x < 16) misc[threadIdx.x] = 0u;
    __syncthreads();
    XcdBarrier bar = xcd_barrier_post((unsigned*)(args.ws + WS_BAR), misc);
#define SEAM(k) do { xcd_barrier(bar); } while (0)
#else
#define SEAM(k) do { } while (0)
#endif
#define NREP(k) ((args.rep == (k)) ? 2 : 1)
#ifndef PH_ONLY
#define PH_ONLY -1
#endif
#define IN(k) (lo <= (k) && (k) < hi && (PH_ONLY < 0 || ((k) == 0 ? 0 : ((k) - 1) % 12 + 1) == PH_ONLY))
    if (IN(0)) { for (int r = NREP(13); r > 0; --r) { phase_prologue(F); SEAM(0); } }
    for (int l = 0; l < 2; ++l) {
        const int pb = 1 + 12 * l;
        if (IN(pb + 0) && l == 0) { for (int r = NREP(1); r > 0; --r) { phase_lnmod(F, l); SEAM(pb + 0); } }
        if (IN(pb + 1)) { for (int r = NREP(2); r > 0; --r) { phase_gemm_in(F, l); SEAM(pb + 1); } }
        if (IN(pb + 2)) { for (int r = NREP(3); r > 0; --r) { phase_conv(F, l); SEAM(pb + 2); } }
        if (IN(pb + 3)) { phase_gemm_a(F, l); SEAM(pb + 3); }
        if (IN(pb + 4)) {
#ifndef NO_PREP
            for (int r = NREP(4); r > 0; --r) { phase_gla_prep(F, l); SEAM(pb + 4); }
#endif
#ifndef NO_SCAN
            for (int r = NREP(5); r > 0; --r) { phase_gla_scan(F, l); SEAM(pb + 4); }
#endif
        }
        if (IN(pb + 5)) { for (int r = NREP(6); r > 0; --r) { phase_postgla(F, l); SEAM(pb + 5); } }
        if (IN(pb + 6)) { phase_gemm_b(F, l); SEAM(pb + 6); }
        if (IN(pb + 7)) { phase_quant_y(F); SEAM(pb + 7); phase_gemm_o(F, l); SEAM(pb + 7); }
        if (IN(pb + 8)) { phase_ln2(F, l); conv_tables(F, l); SEAM(pb + 8); }
        if (IN(pb + 9)) { for (int r = NREP(10); r > 0; --r) { phase_gemm_pq(F, l); SEAM(pb + 9); } }
        if (IN(pb + 10)) { for (int r = NREP(11); r > 0; --r) { phase_peer_score(F, l); SEAM(pb + 10); } }
        if (IN(pb + 11)) {
            for (int r = NREP(20); r > 0; --r) { phase_peer_bucket(F); SEAM(pb + 11); }
            for (int r = NREP(21); r > 0; --r) { phase_peer_u(F, l); SEAM(pb + 11); }
            for (int r = NREP(22); r > 0; --r) { phase_peer_coef(F); SEAM(pb + 11); }
            phase_peer_pack(F); SEAM(pb + 11);
            for (int r = NREP(23); r > 0; --r) { phase_peer_v(F); SEAM(pb + 11); }
            phase_peer_final(F, l); SEAM(pb + 11); }
    }
#undef IN
#undef SEAM
}

extern "C" void kernel_launch(void* const* d_in, const int* in_sizes, int n_in, void* d_out, int out_size, void* d_ws, size_t ws_size, hipStream_t stream) {
    static int grid = 0;
    if (grid == 0) {
        if (n_in != 21 || ws_size < WS_END) { fprintf(stderr, "kernel_launch: unexpected inputs (n_in %d) or workspace %zu < %zu\n", n_in, ws_size, (size_t)WS_END); grid = -1; return; }
        int dev = 0, cus = 0, per_cu = 0;
        if (hipGetDevice(&dev) != hipSuccess || hipDeviceGetAttribute(&cus, hipDeviceAttributeMultiprocessorCount, dev) != hipSuccess) { grid = -1; return; }
        if (hipFuncSetAttribute((const void*)hybrid_fwd, hipFuncAttributeMaxDynamicSharedMemorySize, LDS_TOTAL) != hipSuccess) { fprintf(stderr, "kernel_launch: hipFuncSetAttribute failed\n"); grid = -1; return; }
        if (hipOccupancyMaxActiveBlocksPerMultiprocessor(&per_cu, (const void*)hybrid_fwd, 512, LDS_TOTAL) != hipSuccess || per_cu < 1) { fprintf(stderr, "kernel_launch: occupancy query says %d\n", per_cu); }
        (void)hipGetLastError();
        grid = cus;
    }
    if (grid < 0) return;
    (void)hipMemsetAsync((char*)d_ws + WS_BAR, 0, 16384, stream);
    Args a{};
    for (int i = 0; i < 21; ++i) a.in[i] = (const float*)d_in[i];
    a.out = (float*)d_out; a.ws = (unsigned char*)d_ws;
#ifndef PROBE_REP
#define PROBE_REP 0
#endif
    a.rep = PROBE_REP; a.pad = 0;
#if MK_ONE_LAUNCH
    a.ph_lo = 0; a.ph_hi = N_PHASES;
    hipLaunchKernelGGL(hybrid_fwd, dim3(grid), dim3(512), LDS_TOTAL, stream, a);
#else
    for (int p = 0; p < N_PHASES; ++p) { a.ph_lo = p; a.ph_hi = p + 1; hipLaunchKernelGGL(hybrid_fwd, dim3(grid), dim3(512), LDS_TOTAL, stream, a); }
#endif
}
```
